# Optimizing an MI355X kernel written in HIP

```python
import math
import jax, jax.numpy as jnp
from jax import lax
import numpy as np

D_MODEL = 4096
BATCH = 8
SEQ = 2048
DEPTH = 2

GRID_W = 64
CTX_LEN = 256
HEAD_DIM = 128
A_WIDTH = (3 * D_MODEL) // 8
A_HEADS = A_WIDTH // HEAD_DIM
A_QK_DIM = HEAD_DIM // 2
A_V_DIM = HEAD_DIM
B_WIDTH = (3 * D_MODEL) // 8
B_HEADS = B_WIDTH // HEAD_DIM
B_HEAD_DIM = HEAD_DIM
C_WIDTH = D_MODEL - A_WIDTH - B_WIDTH
C_BLOCKS = 16
C_BLOCK_DIM = C_WIDTH // C_BLOCKS
MIX_WIDTH = A_WIDTH + B_WIDTH + C_WIDTH
SPLIT_SIZES = (A_WIDTH, A_WIDTH, A_WIDTH, A_WIDTH,
               B_WIDTH, B_WIDTH, B_WIDTH, B_WIDTH,
               C_WIDTH, C_WIDTH)
IN_WIDTH = 4 * A_WIDTH + 4 * B_WIDTH + 2 * C_WIDTH

NA_KH = 8
NA_KW = 16
ROPE_THETA = 10000.0
RGLRU_C = 8.0
CONV_W = 4
CONV_LEFT = 2
Q_BLOCK = 128
NORM_EPS = 1e-6
SUBLN_EPS = 1e-5
NEG_INF = -1e30

kernel_name = "hybrid_diffattn_natten_rglru_dit"


def rms_norm(x, w, eps=NORM_EPS):
    x32 = x.astype(jnp.float32)
    y = x32 * lax.rsqrt(jnp.mean(x32 * x32, axis=-1, keepdims=True) + eps)
    return (y * w.astype(jnp.float32)).astype(x.dtype)


def split_columns(p):
    points = [int(v) for v in np.cumsum(SPLIT_SIZES)[:-1]]
    return jnp.split(p, points, axis=-1)


def _rope_1d(x, pos):
    n = x.shape[-1] // 2
    freqs = ROPE_THETA ** (-jnp.arange(n, dtype=jnp.float32) / n)
    ang = pos.astype(jnp.float32)[:, None] * freqs[None, :]
    cos = jnp.cos(ang)[None, :, None, None, :]
    sin = jnp.sin(ang)[None, :, None, None, :]
    x32 = x.astype(jnp.float32)
    x1, x2 = x32[..., :n], x32[..., n:]
    return jnp.concatenate([x1 * cos - x2 * sin, x2 * cos + x1 * sin], axis=-1).astype(x.dtype)


def axial_rope(x, rows, cols):
    half = x.shape[-1] // 2
    return jnp.concatenate([_rope_1d(x[..., :half], rows), _rope_1d(x[..., half:], cols)], axis=-1)


def diff_softmax_attn(q, k, v, lam):
    s = jnp.einsum('bqhnd,bkhnd->nbhqk', q, k).astype(jnp.float32) * (A_QK_DIM ** -0.5)
    p = jax.nn.softmax(s, axis=-1)
    attn = (p[0] - lam * p[1]).astype(v.dtype)
    return jnp.einsum('bhqk,bkhe->bqhe', attn, v)


def diff_attention_latent(q, k_all, v_all, lam):
    bn, s = q.shape[:2]
    nqb = s // Q_BLOCK
    qb = q.reshape(bn, nqb, Q_BLOCK, *q.shape[2:]).swapaxes(0, 1)
    o = lax.map(lambda q_blk: diff_softmax_attn(q_blk, k_all, v_all, lam), qb)
    return o.swapaxes(0, 1).reshape(bn, s, *o.shape[3:])


def dense_attn(q, k, v):
    s = jnp.einsum('bqhd,bkhd->bhqk', q, k).astype(jnp.float32) * (q.shape[-1] ** -0.5)
    p = jax.nn.softmax(s, axis=-1).astype(v.dtype)
    return jnp.einsum('bhqk,bkhd->bqhd', p, v)


def neighbourhood_attention(q, k, v, k_ctx, v_ctx, rpb):
    bn, s, h, dh = q.shape
    rows_n = s // GRID_W
    kh = min(NA_KH, rows_n)
    w = GRID_W
    scale = dh ** -0.5
    n_ctx = k_ctx.shape[1]
    q_rows = q.reshape(bn, rows_n, w, h, dh).swapaxes(0, 1)
    k_grid = k.reshape(bn, rows_n, w, h, dh)
    v_grid = v.reshape(bn, rows_n, w, h, dh)
    cq = jnp.arange(w)
    c0 = jnp.clip(cq - NA_KW // 2, 0, w - NA_KW)
    ck = jnp.arange(w)
    col_valid = (ck[None, :] >= c0[:, None]) & (ck[None, :] < c0[:, None] + NA_KW)
    dc_idx = jnp.clip(ck[None, :] - cq[:, None] + NA_KW - 1, 0, 2 * NA_KW - 2)
    rpb_col = rpb[:, :, dc_idx].astype(jnp.float32)

    def row_block(args):
        r, q_row = args
        r0 = jnp.clip(r - kh // 2, 0, rows_n - kh)
        k_slab = lax.dynamic_slice_in_dim(k_grid, r0, kh, axis=1)
        v_slab = lax.dynamic_slice_in_dim(v_grid, r0, kh, axis=1)
        dr_idx = r0 + jnp.arange(kh) - r + NA_KH - 1
        bias = jnp.transpose(rpb_col[:, dr_idx], (0, 2, 1, 3))
        s_nb = jnp.einsum('bqhd,bikhd->bhqik', q_row, k_slab).astype(jnp.float32) * scale + bias[None]
        s_nb = jnp.where(col_valid[:, None, :], s_nb, NEG_INF)
        s_ctx = jnp.einsum('bqhd,bkhd->bhqk', q_row, k_ctx).astype(jnp.float32) * scale
        p = jax.nn.softmax(jnp.concatenate([s_ctx, s_nb.reshape(bn, h, w, kh * w)], axis=-1),
                           axis=-1).astype(v.dtype)
        p_nb = p[..., n_ctx:].reshape(bn, h, w, kh, w)
        return (jnp.einsum('bhqk,bkhd->bqhd', p[..., :n_ctx], v_ctx)
                + jnp.einsum('bhqik,bikhd->bqhd', p_nb, v_slab))

    o = lax.map(row_block, (jnp.arange(rows_n), q_rows))
    return o.swapaxes(0, 1).reshape(bn, s, h * dh)


def dwconv_centred(u, w, b):
    s = u.shape[1]
    up = jnp.pad(u, ((0, 0), (CONV_LEFT, CONV_W - 1 - CONV_LEFT), (0, 0)))
    acc = b
    for j in range(CONV_W):
        acc = acc + w[j] * up[:, j:j + s]
    return acc


def linear_scan(a, b, h0, reverse):
    if reverse:
        a = jnp.flip(a, axis=1)
        b = jnp.flip(b, axis=1)
    b = b.at[:, 0].add(a[:, 0] * h0)

    def combine(e1, e2):
        a1, b1 = e1
        a2, b2 = e2
        return a1 * a2, a2 * b1 + b2

    _, h = lax.associative_scan(combine, (a, b), axis=1)
    final = h[:, -1]
    if reverse:
        h = jnp.flip(h, axis=1)
    return h, final


def rglru_gates(u32, wa, ba, wx, bx, lam):
    bn, s, _ = u32.shape
    ub = u32.reshape(bn, s, C_BLOCKS, C_BLOCK_DIM)
    r = jax.nn.sigmoid(jnp.einsum('bsni,nij->bsnj', ub, wa.astype(jnp.float32)).reshape(bn, s, C_WIDTH)
                       + ba.astype(jnp.float32))
    i = jax.nn.sigmoid(jnp.einsum('bsni,nij->bsnj', ub, wx.astype(jnp.float32)).reshape(bn, s, C_WIDTH)
                       + bx.astype(jnp.float32))
    log_a = -RGLRU_C * r * jax.nn.softplus(-lam.astype(jnp.float32))
    a = jnp.exp(log_a)
    b = jnp.sqrt(-jnp.expm1(2.0 * log_a)) * (i * u32)
    return a, b


def rglru_bidirectional(u_lat, u_ctx, wa, ba, wx, bx, lam, need_ctx):
    bn = u_lat.shape[0]
    ul32 = u_lat.astype(jnp.float32)
    uc32 = u_ctx.astype(jnp.float32)
    y_lat = []
    y_ctx = []
    for d in range(2):
        rev = d == 1
        a_c, b_c = rglru_gates(uc32, wa[d], ba[d], wx[d], bx[d], lam[d])
        h_c, fin_c = linear_scan(a_c, b_c, jnp.zeros((bn, C_WIDTH), jnp.float32), rev)
        a_l, b_l = rglru_gates(ul32, wa[d], ba[d], wx[d], bx[d], lam[d])
        h_l, _ = linear_scan(a_l, b_l, fin_c, rev)
        y_lat.append(h_l)
        y_ctx.append(h_c)
    out_lat = (y_lat[0] + y_lat[1]).astype(u_lat.dtype)
    out_ctx = (y_ctx[0] + y_ctx[1]).astype(u_ctx.dtype) if need_ctx else None
    return out_lat, out_ctx


def hybrid_layer(l, x, ctx, c, c_ctx, ada_w, ada_b, norm_w, w_in, w_out, lambda_qk, subln_w, rpb,
                 conv_w, conv_b, rg_wa, rg_ba, rg_wx, rg_bx, rg_lambda, need_ctx):
    bn, s, d = x.shape
    n_ctx = ctx.shape[1]
    t = jnp.arange(s)
    rows = t // GRID_W
    cols = t % GRID_W

    mod = jax.nn.silu(c) @ ada_w + ada_b
    shift, scale, gate = jnp.split(mod[:, None, :], 3, axis=-1)
    mod_c = jax.nn.silu(c_ctx) @ ada_w + ada_b
    shift_c, scale_c, gate_c = jnp.split(mod_c, 3, axis=-1)
    hx = rms_norm(x, norm_w) * (1.0 + scale) + shift
    hc = rms_norm(ctx, norm_w) * (1.0 + scale_c) + shift_c

    qa, ka, va, ga, qb, kb, vb, gb, xc, gc = split_columns(hx @ w_in)
    qa_c, ka_c, va_c, ga_c, qb_c, kb_c, vb_c, gb_c, xc_c, gc_c = split_columns(hc @ w_in)

    lam_init = 0.8 - 0.6 * math.exp(-0.3 * l)
    lq = lambda_qk.astype(jnp.float32)
    lam = jnp.exp(jnp.sum(lq[0] * lq[1])) - jnp.exp(jnp.sum(lq[2] * lq[3])) + lam_init
    qa_l = axial_rope(qa.reshape(bn, s, A_HEADS, 2, A_QK_DIM), rows, cols)
    ka_l = axial_rope(ka.reshape(bn, s, A_HEADS, 2, A_QK_DIM), rows, cols)
    va_l = va.reshape(bn, s, A_HEADS, A_V_DIM)
    ka_cx = ka_c.reshape(bn, n_ctx, A_HEADS, 2, A_QK_DIM)
    va_cx = va_c.reshape(bn, n_ctx, A_HEADS, A_V_DIM)
    k_all = jnp.concatenate([ka_cx, ka_l], axis=1)
    v_all = jnp.concatenate([va_cx, va_l], axis=1)
    oa = diff_attention_latent(qa_l, k_all, v_all, lam)
    oa = (rms_norm(oa, subln_w, SUBLN_EPS) * (1.0 - lam_init)).reshape(bn, s, A_WIDTH)

    kb_cx = kb_c.reshape(bn, n_ctx, B_HEADS, B_HEAD_DIM)
    vb_cx = vb_c.reshape(bn, n_ctx, B_HEADS, B_HEAD_DIM)
    ob = neighbourhood_attention(qb.reshape(bn, s, B_HEADS, B_HEAD_DIM),
                                 kb.reshape(bn, s, B_HEADS, B_HEAD_DIM),
                                 vb.reshape(bn, s, B_HEADS, B_HEAD_DIM), kb_cx, vb_cx, rpb)

    u_l = dwconv_centred(xc, conv_w, conv_b)
    u_c = dwconv_centred(xc_c, conv_w, conv_b)
    oc, oc_c = rglru_bidirectional(u_l, u_c, rg_wa, rg_ba, rg_wx, rg_bx, rg_lambda, need_ctx)

    merged = jnp.concatenate([oa * jax.nn.silu(ga), ob * jax.nn.silu(gb), oc * jax.nn.silu(gc)], axis=-1)
    x = x + gate * (merged @ w_out)

    if need_ctx:
        oa_c = diff_softmax_attn(qa_c.reshape(bn, n_ctx, A_HEADS, 2, A_QK_DIM), ka_cx, va_cx, lam)
        oa_c = (rms_norm(oa_c, subln_w, SUBLN_EPS) * (1.0 - lam_init)).reshape(bn, n_ctx, A_WIDTH)
        ob_c = dense_attn(qb_c.reshape(bn, n_ctx, B_HEADS, B_HEAD_DIM), kb_cx, vb_cx).reshape(bn, n_ctx, B_WIDTH)
        merged_c = jnp.concatenate([oa_c * jax.nn.silu(ga_c), ob_c * jax.nn.silu(gb_c),
                                    oc_c * jax.nn.silu(gc_c)], axis=-1)
        ctx = ctx + gate_c * (merged_c @ w_out)
    return x, ctx


def setup_inputs(seed: int = 0) -> dict:
    key = jax.random.key(seed)
    ks = jax.random.split(key, 20)
    f32 = jnp.float32
    x = jax.random.normal(ks[0], (BATCH, SEQ, D_MODEL), f32)
    c = jax.random.normal(ks[1], (BATCH, D_MODEL), f32)
    ctx = jax.random.normal(ks[2], (BATCH, CTX_LEN, D_MODEL), f32)
    c_ctx = jax.random.normal(ks[3], (D_MODEL,), f32)
    ada_w = jax.random.normal(ks[4], (DEPTH, D_MODEL, 3 * D_MODEL), f32) * (0.5 * D_MODEL ** -0.5)
    ada_b = jax.random.normal(ks[5], (DEPTH, 3 * D_MODEL), f32) * 0.02
    norm_w = 1.0 + 0.02 * jax.random.normal(ks[6], (DEPTH, D_MODEL), f32)
    w_in = jax.random.normal(ks[7], (DEPTH, D_MODEL, IN_WIDTH), f32) * (D_MODEL ** -0.5)
    w_out = jax.random.normal(ks[8], (DEPTH, MIX_WIDTH, D_MODEL), f32) * (MIX_WIDTH ** -0.5)
    lambda_qk = jax.random.normal(ks[9], (DEPTH, 4, A_QK_DIM), f32) * 0.1
    subln_w = 1.0 + 0.02 * jax.random.normal(ks[10], (DEPTH, A_V_DIM), f32)
    rpb = jax.random.normal(ks[11], (DEPTH, B_HEADS, 2 * NA_KH - 1, 2 * NA_KW - 1), f32) * 0.1
    conv_w = jax.random.normal(ks[12], (DEPTH, CONV_W, C_WIDTH), f32) * (CONV_W ** -0.5)
    conv_b = jax.random.normal(ks[13], (DEPTH, C_WIDTH), f32) * 0.02
    rg_wa = jax.random.normal(ks[14], (DEPTH, 2, C_BLOCKS, C_BLOCK_DIM, C_BLOCK_DIM), f32) * (C_BLOCK_DIM ** -0.5)
    rg_ba = jax.random.normal(ks[15], (DEPTH, 2, C_WIDTH), f32) * 0.02
    rg_wx = jax.random.normal(ks[16], (DEPTH, 2, C_BLOCKS, C_BLOCK_DIM, C_BLOCK_DIM), f32) * (C_BLOCK_DIM ** -0.5)
    rg_bx = jax.random.normal(ks[17], (DEPTH, 2, C_WIDTH), f32) * 0.02
    a_base = jax.random.uniform(ks[18], (DEPTH, 2, C_WIDTH), f32, minval=0.9, maxval=0.999) ** (1.0 / RGLRU_C)
    rg_lambda = jnp.log(a_base) - jnp.log1p(-a_base)
    final_norm_w = 1.0 + 0.02 * jax.random.normal(ks[19], (D_MODEL,), f32)
    return {"x": x, "c": c, "ctx": ctx, "c_ctx": c_ctx, "ada_w": ada_w, "ada_b": ada_b,
            "norm_w": norm_w, "w_in": w_in, "w_out": w_out, "lambda_qk": lambda_qk,
            "subln_w": subln_w, "rpb": rpb, "conv_w": conv_w, "conv_b": conv_b,
            "rg_wa": rg_wa, "rg_ba": rg_ba, "rg_wx": rg_wx, "rg_bx": rg_bx,
            "rg_lambda": rg_lambda, "final_norm_w": final_norm_w}


def reference(x, c, ctx, c_ctx, ada_w, ada_b, norm_w, w_in, w_out, lambda_qk, subln_w, rpb,
              conv_w, conv_b, rg_wa, rg_ba, rg_wx, rg_bx, rg_lambda, final_norm_w):
    for l in range(DEPTH):
        x, ctx = hybrid_layer(l, x, ctx, c, c_ctx, ada_w[l], ada_b[l], norm_w[l], w_in[l], w_out[l],
                              lambda_qk[l], subln_w[l], rpb[l], conv_w[l], conv_b[l],
                              rg_wa[l], rg_ba[l], rg_wx[l], rg_bx[l], rg_lambda[l],
                              need_ctx=(l < DEPTH - 1))
    return rms_norm(x, final_norm_w)
```

```cpp
#include <hip/hip_runtime.h>
#include <cstdio>
#include <cstdint>
#include <cmath>
namespace pg8 {
#define PG8_LAS __attribute__((address_space(3)))
typedef unsigned short bf16_t;
typedef short bf16x8 __attribute__((ext_vector_type(8)));
typedef float f32x4 __attribute__((ext_vector_type(4)));
typedef unsigned u32x4 __attribute__((ext_vector_type(4)));
constexpr int BM = 256, BK = 64, HALF = 128, HTB = HALF * BK * 2  , STAGE_BYTES = 8 * HTB, NXCD = 8, WGM = 8;

__host__ __device__ __forceinline__ int lds_byte(int r, int c) { const int st = (r >> 4) * 2 + (c >> 5), rr = r & 15, cc = c & 31, ob = rr * 64 + cc * 2; return st * 1024 + (ob ^ (((ob >> 9) & 1) << 5)); }
__host__ __device__ __forceinline__ void stage_rc(int b, int& R, int& C) { const int st = b / 1024, sb = b % 1024, swz = sb ^ (((sb >> 9) & 1) << 5); R = (st >> 1) * 16 + swz / 64; C = (st & 1) * 32 + (swz % 64) / 2; }
__host__ __device__ __forceinline__ int perm32(int rho) { const int n = rho >> 4, i = rho & 15; return 8 * (i >> 2) + 4 * n + (i & 3); }

struct Unit { int pm, pn; };
struct Gemm { const bf16_t* A; const bf16_t* Bt; int M, N, K, pad; };

struct StaticOrder {
    int nM, nN, nwg, G, c;
    __host__ __device__ void init(int M, int N, int G_, int c_) { nM = M / BM; nN = N / BM; nwg = nM * nN; G = G_; c = c_; }
    __host__ __device__ bool next(int i, Unit& u) const {
        const long L = (long)i * G + c; if (L >= nwg) return false;
        int wgid = (int)L; { const int q = nwg / NXCD, r = nwg % NXCD, xcd = wgid % NXCD, off = wgid / NXCD; wgid = (xcd < r ? xcd * (q + 1) : r * (q + 1) + (xcd - r) * q) + off; }
        const int nig = WGM * nN, gid = wgid / nig, fm = gid * WGM, gsz = (nM - fm) < WGM ? (nM - fm) : WGM;
        u.pm = fm + ((wgid % nig) % gsz); u.pn = (wgid % nig) / gsz; return true;
    }
    __device__ __forceinline__ void a_ready(const Unit&) const {}
    __device__ __forceinline__ void done(const Unit&) const {}
};
__device__ __forceinline__ unsigned cvt_pk_bf16(float lo, float hi) { unsigned r; asm volatile("v_cvt_pk_bf16_f32 %0, %1, %2" : "=v"(r) : "v"(lo), "v"(hi)); return r; }

struct EpiP {
    static constexpr bool PERM = true, AFTER_DRAIN = false;
    bf16_t* O; int ldc, pad;
    __device__ __forceinline__ void operator()(const f32x4 (&acc)[2][2][4][2], const Unit& u, int wr, int wc, int fr, int fq) const {
        const int row0 = u.pm * BM + wr * 64 + fr, col0 = u.pn * BM + wc * 32 + 8 * fq;
#pragma unroll
        for (int ai = 0; ai < 2; ++ai)
#pragma unroll
            for (int m = 0; m < 4; ++m) { bf16_t* rowp = O + (size_t)(row0 + ai * HALF + m * 16) * ldc + col0;
#pragma unroll
                for (int bj = 0; bj < 2; ++bj) { const f32x4 v0 = acc[ai][bj][m][0], v1 = acc[ai][bj][m][1];
                    u32x4 w; w.x = cvt_pk_bf16(v0[0], v0[1]); w.y = cvt_pk_bf16(v0[2], v0[3]); w.z = cvt_pk_bf16(v1[0], v1[1]); w.w = cvt_pk_bf16(v1[2], v1[3]);
                    *(u32x4*)(rowp + bj * HALF) = w; } }
    }
};
struct EpiRes {
    static constexpr bool PERM = false, AFTER_DRAIN = false;
    const float* res_lat; const float* res_ctx; float* out_lat; float* out_ctx; const float* gate; int nlat, pad;
    __device__ __forceinline__ void operator()(const f32x4 (&acc)[2][2][4][2], const Unit& u, int wr, int wc, int fr, int fq) const {
        const int rowt = u.pm * BM; const bool isctx = rowt >= nlat; const int gr = isctx ? 8 : (rowt >> 11);
        const float* res = isctx ? res_ctx : res_lat; float* out = isctx ? out_ctx : out_lat;
        const int lrow0 = (isctx ? rowt - nlat : rowt) + wr * 64 + fr, col0 = u.pn * BM + wc * 32 + 4 * fq;
        f32x4 gv[2][2];
#pragma unroll
        for (int bj = 0; bj < 2; ++bj)
#pragma unroll
            for (int n = 0; n < 2; ++n) gv[bj][n] = *(const f32x4*)(gate + (size_t)gr * 12288 + col0 + bj * HALF + n * 16);
#pragma unroll
        for (int ai = 0; ai < 2; ++ai)
#pragma unroll
            for (int m = 0; m < 4; ++m) { const size_t off = (size_t)(lrow0 + ai * HALF + m * 16) * 4096 + col0;
#pragma unroll
                for (int bj = 0; bj < 2; ++bj)
#pragma unroll
                    for (int n = 0; n < 2; ++n) { const f32x4 rs = *(const f32x4*)(res + off + bj * HALF + n * 16);
                        *(f32x4*)(out + off + bj * HALF + n * 16) = rs + gv[bj][n] * acc[ai][bj][m][n]; } }
    }
};
template <class Epi, class Sched, bool ALIGN_EPI = false, bool SP2 = false>
__device__ __forceinline__ void gemm_phase(PG8_LAS unsigned char* lds, const Gemm g, const Sched& S, const Epi& E) {
    const int tid = threadIdx.x, wid = __builtin_amdgcn_readfirstlane(tid >> 6), lane = tid & 63, wr = wid >> 2, wc = wid & 3, fr = lane & 15, fq = lane >> 4;
    const int K = g.K, nt = K / BK;
    unsigned voffA[2], voffB[2];
#pragma unroll
    for (int i = 0; i < 2; ++i) { int R, C; stage_rc(tid * 16 + i * 8192, R, C); const int Rb = Epi::PERM ? ((R & ~31) + perm32(R & 31)) : R;
        voffA[i] = (unsigned)(R * K + C) * 2u; voffB[i] = (unsigned)(Rb * K + C) * 2u; }
    const size_t kstep = (size_t)(BK * 2);
    const size_t hstep = (size_t)HALF * K * 2;
    const size_t tstep = 2 * hstep;
    const unsigned ldsw = (unsigned)wid * 1024u;
    const int aoff = lds_byte(wr * 64 + fr, fq * 8), boff = lds_byte(wc * 32 + fr, fq * 8);
#define PG8_SA(b, h) (((b) * 2 + (h)) * HTB)
#define PG8_SB(b, h) ((4 + (b) * 2 + (h)) * HTB)
#define PG8_STAGE(bufoff, gbase, voff) do { _Pragma("unroll") for (int _i = 0; _i < 2; ++_i) \
        __builtin_amdgcn_global_load_lds((const unsigned*)((const char*)(gbase) + (voff)[_i]), (PG8_LAS unsigned*)(lds + (bufoff) + ldsw + _i * 8192), 16, 0, 0); } while (0)
#define PG8_LDA(dst, b, h) do { _Pragma("unroll") for (int m = 0; m < 4; ++m) _Pragma("unroll") for (int k = 0; k < 2; ++k) dst[m][k] = *(const PG8_LAS bf16x8*)(lds + PG8_SA(b, h) + aoff + m * 2048 + k * 1024); } while (0)
#define PG8_LDB(dst, b, h) do { _Pragma("unroll") for (int n = 0; n < 2; ++n) _Pragma("unroll") for (int k = 0; k < 2; ++k) dst[n][k] = *(const PG8_LAS bf16x8*)(lds + PG8_SB(b, h) + boff + n * 2048 + k * 1024); } while (0)
#define PG8_MMA(ai, bj, At, Bt) do { __builtin_amdgcn_s_setprio(1); _Pragma("unroll") for (int m = 0; m < 4; ++m) _Pragma("unroll") for (int n = 0; n < 2; ++n) _Pragma("unroll") for (int k = 0; k < 2; ++k) \
        acc[ai][bj][m][n] = __builtin_amdgcn_mfma_f32_16x16x32_bf16(Bt[n][k], At[m][k], acc[ai][bj][m][n], 0, 0, 0); __builtin_amdgcn_s_setprio(0); } while (0)
#define PG8_WAIT_V(n) asm volatile("s_waitcnt vmcnt(" #n ")" ::: "memory")
#define PG8_WAIT_L(n) asm volatile("s_waitcnt lgkmcnt(" #n ")" ::: "memory")
#define PG8_BAR __builtin_amdgcn_s_barrier()
#define PG8_SCHED __builtin_amdgcn_sched_barrier(0)
    Unit cur, nxt; int ui = 0;
    if (!S.next(0, cur)) return;
    f32x4 acc[2][2][4][2];
#pragma unroll
    for (int a = 0; a < 2; ++a)
#pragma unroll
        for (int b = 0; b < 2; ++b)
#pragma unroll
            for (int m = 0; m < 4; ++m)
#pragma unroll
                for (int n = 0; n < 2; ++n) acc[a][b][m][n] = (f32x4){0.f, 0.f, 0.f, 0.f};
    bf16x8 At[4][2], B0[2][2], B1[2][2];
    const char* cA = (const char*)g.A + (size_t)cur.pm * tstep; const char* cB = (const char*)g.Bt + (size_t)cur.pn * tstep;
    S.a_ready(cur);
    if constexpr (SP2) {
        PG8_STAGE(PG8_SB(0, 0), cB, voffB); PG8_STAGE(PG8_SB(0, 1), cB + hstep, voffB); PG8_STAGE(PG8_SA(0, 0), cA, voffA); PG8_STAGE(PG8_SA(0, 1), cA + hstep, voffA);
        if (wr == 1) PG8_BAR;
        PG8_WAIT_V(2); PG8_BAR;
        PG8_STAGE(PG8_SB(1, 0), cB + kstep, voffB); PG8_STAGE(PG8_SA(1, 0), cA + kstep, voffA); PG8_STAGE(PG8_SB(1, 1), cB + hstep + kstep, voffB);
        PG8_WAIT_V(6); PG8_BAR;
    } else {
        PG8_STAGE(PG8_SB(0, 0), cB, voffB); PG8_STAGE(PG8_SA(0, 0), cA, voffA); PG8_STAGE(PG8_SB(0, 1), cB + hstep, voffB); PG8_STAGE(PG8_SA(0, 1), cA + hstep, voffA);
        if (wr == 1) PG8_BAR;
        PG8_WAIT_V(4); PG8_BAR;
        PG8_STAGE(PG8_SB(1, 0), cB + kstep, voffB); PG8_STAGE(PG8_SA(1, 0), cA + kstep, voffA); PG8_STAGE(PG8_SB(1, 1), cB + hstep + kstep, voffB);
        PG8_WAIT_V(6); PG8_BAR;
    }
    for (;;) {
        const bool has_next = S.next(ui + 1, nxt);
        const char* nA = has_next ? (const char*)g.A + (size_t)nxt.pm * tstep : cA; const char* nB = has_next ? (const char*)g.Bt + (size_t)nxt.pn * tstep : cB;
        for (int t = 0; t < nt; t += 2) {
            const bool last = (t == nt - 2);
            const char* a1 = cA + (size_t)(t + 1) * kstep;
            const char* a2 = last ? nA : cA + (size_t)(t + 2) * kstep; const char* b2 = last ? nB : cB + (size_t)(t + 2) * kstep;
            const char* a3 = a2 + kstep; const char* b3 = b2 + kstep;
            if (last && has_next) S.a_ready(nxt);
            if constexpr (SP2) {
            PG8_LDB(B0, 0, 0); PG8_LDB(B1, 0, 1); PG8_SCHED; PG8_LDA(At, 0, 0); PG8_STAGE(PG8_SA(1, 1), a1 + hstep, voffA);
            PG8_WAIT_V(8); PG8_WAIT_L(0); PG8_BAR; PG8_MMA(0, 0, At, B0); PG8_MMA(0, 1, At, B1); PG8_BAR; PG8_SCHED;
            PG8_LDA(At, 0, 1); PG8_STAGE(PG8_SB(0, 0), b2, voffB); PG8_STAGE(PG8_SB(0, 1), b2 + hstep, voffB); PG8_STAGE(PG8_SA(0, 0), a2, voffA);
            PG8_WAIT_V(8); PG8_WAIT_L(0); PG8_BAR; PG8_MMA(1, 0, At, B0); PG8_MMA(1, 1, At, B1); PG8_BAR; PG8_SCHED;
            PG8_LDB(B0, 1, 0); PG8_LDB(B1, 1, 1); PG8_SCHED; PG8_LDA(At, 1, 0); PG8_STAGE(PG8_SA(0, 1), a2 + hstep, voffA);
            PG8_WAIT_V(8); PG8_WAIT_L(0); PG8_BAR; PG8_MMA(0, 0, At, B0); PG8_MMA(0, 1, At, B1); PG8_BAR; PG8_SCHED;
            PG8_LDA(At, 1, 1); PG8_STAGE(PG8_SB(1, 0), b3, voffB); PG8_STAGE(PG8_SB(1, 1), b3 + hstep, voffB); PG8_STAGE(PG8_SA(1, 0), a3, voffA);
            PG8_WAIT_V(8); PG8_WAIT_L(0); PG8_BAR; PG8_MMA(1, 0, At, B0); PG8_MMA(1, 1, At, B1); PG8_BAR; PG8_SCHED;
            } else {
            PG8_LDB(B0, 0, 0); PG8_SCHED; PG8_LDA(At, 0, 0); PG8_STAGE(PG8_SA(1, 1), a1 + hstep, voffA);
            PG8_WAIT_L(8); PG8_BAR; PG8_WAIT_L(0); PG8_MMA(0, 0, At, B0); PG8_BAR; PG8_SCHED;
            PG8_LDB(B1, 0, 1); PG8_STAGE(PG8_SB(0, 0), b2, voffB);
            PG8_BAR; PG8_WAIT_L(0); PG8_MMA(0, 1, At, B1); PG8_BAR;
            PG8_LDA(At, 0, 1); PG8_STAGE(PG8_SA(0, 0), a2, voffA);
            PG8_BAR; PG8_WAIT_L(0); PG8_MMA(1, 0, At, B0); PG8_BAR; PG8_SCHED;
            PG8_STAGE(PG8_SB(0, 1), b2 + hstep, voffB);
            PG8_WAIT_V(6); PG8_BAR; PG8_MMA(1, 1, At, B1); PG8_BAR;
            PG8_LDB(B0, 1, 0); PG8_SCHED; PG8_LDA(At, 1, 0); PG8_STAGE(PG8_SA(0, 1), a2 + hstep, voffA);
            PG8_WAIT_L(8); PG8_BAR; PG8_WAIT_L(0); PG8_MMA(0, 0, At, B0); PG8_BAR; PG8_SCHED;
            PG8_LDB(B1, 1, 1); PG8_STAGE(PG8_SB(1, 0), b3, voffB);
            PG8_BAR; PG8_WAIT_L(0); PG8_MMA(0, 1, At, B1); PG8_BAR;
            PG8_LDA(At, 1, 1); PG8_STAGE(PG8_SA(1, 0), a3, voffA);
            PG8_BAR; PG8_WAIT_L(0); PG8_MMA(1, 0, At, B0); PG8_BAR; PG8_SCHED;
            PG8_STAGE(PG8_SB(1, 1), b3 + hstep, voffB);
            PG8_WAIT_V(6); PG8_BAR; PG8_MMA(1, 1, At, B1); PG8_BAR;
            }
        }
        if constexpr (ALIGN_EPI) { if (wr == 0) PG8_BAR; }
        if constexpr (!Epi::AFTER_DRAIN) { E(acc, cur, wr, wc, fr, fq); S.done(cur); }
        if (!has_next) break;
#pragma unroll
        for (int a = 0; a < 2; ++a)
#pragma unroll
            for (int b = 0; b < 2; ++b)
#pragma unroll
                for (int m = 0; m < 4; ++m)
#pragma unroll
                    for (int n = 0; n < 2; ++n) acc[a][b][m][n] = (f32x4){0.f, 0.f, 0.f, 0.f};
        cur = nxt; cA = nA; cB = nB; ++ui;
        if constexpr (ALIGN_EPI) { if (wr == 1) PG8_BAR; }
    }
    PG8_WAIT_V(0);
    if constexpr (!ALIGN_EPI) { if (wr == 0) PG8_BAR; }
    PG8_BAR;
    if constexpr (Epi::AFTER_DRAIN) { E.fused(acc, cur, wr, wc, fr, fq, lds, wid, lane); S.done(cur); }
#undef PG8_SA
#undef PG8_SB
#undef PG8_STAGE
#undef PG8_LDA
#undef PG8_LDB
#undef PG8_MMA
#undef PG8_WAIT_V
#undef PG8_WAIT_L
#undef PG8_BAR
#undef PG8_SCHED
}
}

constexpr int DM = 4096, NB = 8, SEQ = 2048, NCTX = 256, INW = 14336, NLAT = NB * SEQ, NROW = NLAT + NB * NCTX;
constexpr int HEADS = 12;
constexpr int C_QA = 0, C_KA = 1536, C_VA = 3072, C_GA = 4608, C_QB = 6144, C_KB = 7680, C_VB = 9216, C_GB = 10752, C_XC = 12288, C_GC = 13312;
constexpr size_t MiB = 1u << 20;
constexpr size_t WS_CTL = 0, WS_MOD = 1 * MiB, WS_ROPE = 2 * MiB, WS_LAM = 2 * MiB + 65536, WS_WIN = 4 * MiB, WS_WOUT = 228 * MiB, WS_HX = 292 * MiB, WS_P = 436 * MiB,
                 WS_MG = 940 * MiB, WS_CTXRES = 1084 * MiB, WS_AA = 1116 * MiB, WS_BB = 1260 * MiB, WS_HH = 1404 * MiB, WS_END = 1548 * MiB;
typedef unsigned short bf16_t;
typedef float f32x4 __attribute__((ext_vector_type(4)));
#define GAS __attribute__((address_space(1)))
#define LAS __attribute__((address_space(3)))
typedef unsigned v4u __attribute__((ext_vector_type(4)));
#define LDS_WAIT() asm volatile("s_waitcnt lgkmcnt(0)" ::: "memory")

__device__ __forceinline__ float bf2f(bf16_t b) { return __uint_as_float(((unsigned)b) << 16); }
__device__ __forceinline__ unsigned f2bf(float f) { unsigned u = __float_as_uint(f); return (u + 0x7fffu + ((u >> 16) & 1u)) >> 16; }
__device__ __forceinline__ unsigned pk2(float lo, float hi) { return f2bf(lo) | (f2bf(hi) << 16); }
__device__ __forceinline__ float wave_sum(float v) {
#pragma unroll
    for (int o = 1; o < 64; o <<= 1) v += __shfl_xor(v, o);
    return v;
}
__device__ __forceinline__ float wave_max(float v) {
#pragma unroll
    for (int o = 1; o < 64; o <<= 1) v = fmaxf(v, __shfl_xor(v, o));
    return v;
}
__device__ __forceinline__ float silu_f(float v) { return v / (1.f + expf(-v)); }
__device__ __forceinline__ float sigmoid_f(float v) { return 1.f / (1.f + expf(-v)); }

__device__ __forceinline__ void p0_transpose_item(const float* W, int K, int N, bf16_t* WT, int row_off, LAS float* scr, int item, int lane) {
    const int nblk = N / 32, kb = item / nblk, nb = item % nblk, k0 = 64 * kb, n0 = 32 * nb;
#pragma unroll 8
    for (int i = 0; i < 32; ++i) { const int kk = 2 * i + (lane >> 5); scr[kk * 33 + (lane & 31)] = W[(size_t)(k0 + kk) * N + n0 + (lane & 31)]; }
    LDS_WAIT(); asm volatile("" ::: "memory");
    const int c = lane & 7;
#pragma unroll
    for (int j = 0; j < 4; ++j) { const int n = (lane >> 3) + 8 * j; const LAS float* s = scr + (8 * c) * 33 + n;
        v4u o; o.x = pk2(s[0 * 33], s[1 * 33]); o.y = pk2(s[2 * 33], s[3 * 33]); o.z = pk2(s[4 * 33], s[5 * 33]); o.w = pk2(s[6 * 33], s[7 * 33]);
        *(GAS v4u*)(WT + (size_t)(row_off + n0 + n) * K + k0 + 8 * c) = o; }
    LDS_WAIT(); asm volatile("" ::: "memory");
}

__global__ __launch_bounds__(512) void k_transpose(const float* w_in, const float* w_out, bf16_t* WinT, bf16_t* WoutT) {
    __shared__ float scr_all[8 * 64 * 33];
    const int wave = threadIdx.x >> 6, lane = threadIdx.x & 63;
    LAS float* scr = (LAS float*)scr_all + wave * 64 * 33;
    constexpr int I_IN = (DM / 64) * (INW / 32), I_OUT = (DM / 64) * (DM / 32), I_L = I_IN + I_OUT;
    const int gw = blockIdx.x * 8 + wave, NGW = gridDim.x * 8;
    for (int it = gw; it < 2 * I_L; it += NGW) {
        const int l = it / I_L, r = it % I_L;
        if (r < I_IN) p0_transpose_item(w_in + (size_t)l * DM * INW, DM, INW, WinT + (size_t)l * INW * DM, 0, scr, r, lane);
        else p0_transpose_item(w_out + (size_t)l * DM * DM, DM, DM, WoutT + (size_t)l * DM * DM, 0, scr, r - I_IN, lane);
    }
}

__global__ void k_small(const float* lambda_qk, float* rope, float* lam) {
    const int i = blockIdx.x * blockDim.x + threadIdx.x;
    if (i < 1024) { const int pos = i >> 4, f = i & 15; const double fr = pow(10000.0, -(double)f / 16.0), ang = (double)pos * fr; rope[2 * i] = (float)cos(ang); rope[2 * i + 1] = (float)sin(ang); }
    if (i < 2) { const float* lq = lambda_qk + i * 256; double s01 = 0, s23 = 0; for (int d = 0; d < 64; ++d) { s01 += (double)lq[d] * lq[64 + d]; s23 += (double)lq[128 + d] * lq[192 + d]; }
        const double lam_init = 0.8 - 0.6 * exp(-0.3 * (double)i); lam[i] = (float)(exp(s01) - exp(s23) + lam_init); lam[2 + i] = (float)(1.0 - lam_init); }
}

__global__ __launch_bounds__(512) void k_mod(const float* c, const float* c_ctx, const float* ada_w, const float* ada_b, float* mod) {
    __shared__ float sl[9 * 1024];
    __shared__ float red[16 * 9 * 32];
    const int tid = threadIdx.x, kg = tid >> 5, cj = tid & 31;
    for (int item = blockIdx.x; item < 2 * 384; item += gridDim.x) {
        const int l = item / 384, j0 = (item % 384) * 32;
        float acc[9];
#pragma unroll
        for (int r = 0; r < 9; ++r) acc[r] = 0.f;
        const float* W = ada_w + (size_t)l * DM * 12288 + j0 + cj;
        for (int ch = 0; ch < 4; ++ch) {
            __syncthreads();
            for (int idx = tid; idx < 9 * 1024; idx += 512) { const int r = idx >> 10, kk = idx & 1023; const float v = (r < 8) ? c[r * DM + ch * 1024 + kk] : c_ctx[ch * 1024 + kk]; sl[idx] = silu_f(v); }
            __syncthreads();
#pragma unroll 4
            for (int i = 0; i < 64; ++i) { const int kk = kg + 16 * i; const float w = W[(size_t)(ch * 1024 + kk) * 12288];
#pragma unroll
                for (int r = 0; r < 9; ++r) acc[r] += sl[r * 1024 + kk] * w; }
        }
#pragma unroll
        for (int r = 0; r < 9; ++r) red[(kg * 9 + r) * 32 + cj] = acc[r];
        __syncthreads();
        if (tid < 288) { const int r = tid >> 5, c2 = tid & 31; float s = ada_b[l * 12288 + j0 + c2];
            for (int g = 0; g < 16; ++g) s += red[(g * 9 + r) * 32 + c2];
            mod[(size_t)(l * 9 + r) * 12288 + j0 + c2] = s; }
    }
}

__global__ __launch_bounds__(512) void k_norm(const float* xlat, const float* xctx, const float* norm_w, const float* mod, bf16_t* HX) {
    const int wave = threadIdx.x >> 6, lane = threadIdx.x & 63, gw = blockIdx.x * 8 + wave, NGW = gridDim.x * 8;
    for (int row = gw; row < NROW; row += NGW) {
        const bool isctx = row >= NLAT; const int r = isctx ? 8 : (row >> 11);
        const f32x4* xr = (const f32x4*)(isctx ? xctx + (size_t)(row - NLAT) * DM : xlat + (size_t)row * DM) + lane;
        f32x4 v[16]; float s = 0.f;
#pragma unroll
        for (int j = 0; j < 16; ++j) { v[j] = xr[64 * j]; s += (v[j].x * v[j].x + v[j].y * v[j].y) + (v[j].z * v[j].z + v[j].w * v[j].w); }
        const float rstd = 1.f / sqrtf(wave_sum(s) * (1.f / DM) + 1e-6f);
        const f32x4* nw = (const f32x4*)norm_w + lane; const f32x4* sh = (const f32x4*)(mod + (size_t)r * 12288) + lane; const f32x4* sc = (const f32x4*)(mod + (size_t)r * 12288 + 4096) + lane;
        unsigned long long* o8 = (unsigned long long*)(HX + (size_t)row * DM) + lane;
#pragma unroll
        for (int j = 0; j < 16; ++j) { const f32x4 w = nw[64 * j], a = sc[64 * j], b = sh[64 * j]; const f32x4 y = v[j] * rstd * w; const f32x4 o = y * (a + 1.f) + b;
            o8[64 * j] = (unsigned long long)pk2(o.x, o.y) | ((unsigned long long)pk2(o.z, o.w) << 32); }
    }
}

template <class Epi> __global__ __launch_bounds__(512, 2) void k_gemm(pg8::Gemm g, Epi E) {
    extern __shared__ __attribute__((aligned(16))) unsigned char shm[];
    pg8::StaticOrder S; S.init(g.M, g.N, (int)gridDim.x, (int)blockIdx.x);
    pg8::gemm_phase<Epi, pg8::StaticOrder, true, true>((PG8_LAS unsigned char*)shm, g, S, E);
}

__global__ __launch_bounds__(256) void k_rope(bf16_t* P, const float* rope) {
    const size_t gid = (size_t)blockIdx.x * 256 + threadIdx.x;
    const int row = (int)(gid / 1536), p = (int)(gid % 1536);
    if (row >= NLAT) return;
    const int i = p & 15, half = (p >> 4) & 1, sub = (p >> 5) & 1, h = (p >> 6) % 12, tens = p / 768;
    const int t = row & 2047, pos = half ? (t & 63) : (t >> 6);
    const float cs = rope[2 * (pos * 16 + i)], sn = rope[2 * (pos * 16 + i) + 1];
    bf16_t* x = P + (size_t)row * INW + tens * 1536 + h * 128 + sub * 64 + half * 32 + i;
    const float x1 = bf2f(x[0]), x2 = bf2f(x[16]);
    x[0] = (bf16_t)f2bf(x1 * cs - x2 * sn); x[16] = (bf16_t)f2bf(x2 * cs + x1 * sn);
}

template <bool LAT> __global__ __launch_bounds__(256) void k_attnA(const bf16_t* P, bf16_t* MG, const float* subln_w, const float* lamp, int layer) {
    constexpr int NQ = LAT ? SEQ : NCTX, NK = LAT ? (NCTX + SEQ) : NCTX;
    __shared__ float qs[4][128];
    __shared__ float sc[4][2][NK];
    const int wave = threadIdx.x >> 6, lane = threadIdx.x & 63;
    const int gq = blockIdx.x * 4 + wave;
    const int b = gq / (HEADS * NQ), h = (gq / NQ) % HEADS, t = gq % NQ;
    const int qrow = LAT ? b * SEQ + t : NLAT + b * NCTX + t;
    const float lam = lamp[layer], oml = lamp[2 + layer];
    qs[wave][lane] = bf2f(P[(size_t)qrow * INW + C_QA + h * 128 + lane]); qs[wave][lane + 64] = bf2f(P[(size_t)qrow * INW + C_QA + h * 128 + 64 + lane]);
    __syncthreads();
    float m0 = -3e38f, m1 = -3e38f;
    for (int k = lane; k < NK; k += 64) {
        const int krow = k < NCTX ? NLAT + b * NCTX + k : b * SEQ + (k - NCTX);
        const unsigned* kp = (const unsigned*)(P + (size_t)krow * INW + C_KA + h * 128);
        float s0 = 0.f, s1 = 0.f;
#pragma unroll 8
        for (int d = 0; d < 32; ++d) { const unsigned w0 = kp[d], w1 = kp[32 + d];
            s0 += qs[wave][2 * d] * __uint_as_float(w0 << 16) + qs[wave][2 * d + 1] * __uint_as_float(w0 & 0xffff0000u);
            s1 += qs[wave][64 + 2 * d] * __uint_as_float(w1 << 16) + qs[wave][64 + 2 * d + 1] * __uint_as_float(w1 & 0xffff0000u); }
        s0 *= 0.125f; s1 *= 0.125f; sc[wave][0][k] = s0; sc[wave][1][k] = s1; m0 = fmaxf(m0, s0); m1 = fmaxf(m1, s1);
    }
    m0 = wave_max(m0); m1 = wave_max(m1);
    float l0 = 0.f, l1 = 0.f;
    for (int k = lane; k < NK; k += 64) { const float e0 = expf(sc[wave][0][k] - m0), e1 = expf(sc[wave][1][k] - m1); sc[wave][0][k] = e0; sc[wave][1][k] = e1; l0 += e0; l1 += e1; }
    l0 = wave_sum(l0); l1 = wave_sum(l1);
    const float i0 = 1.f / l0, i1 = lam / l1;
    for (int k = lane; k < NK; k += 64) sc[wave][0][k] = sc[wave][0][k] * i0 - sc[wave][1][k] * i1;
    __syncthreads();
    float o0 = 0.f, o1 = 0.f;
    for (int k = 0; k < NK; ++k) {
        const int krow = k < NCTX ? NLAT + b * NCTX + k : b * SEQ + (k - NCTX);
        const unsigned w = *(const unsigned*)(P + (size_t)krow * INW + C_VA + h * 128 + 2 * lane); const float p = sc[wave][0][k];
        o0 += p * __uint_as_float(w << 16); o1 += p * __uint_as_float(w & 0xffff0000u);
    }
    const float ss = wave_sum(o0 * o0 + o1 * o1), rn = 1.f / sqrtf(ss * (1.f / 128.f) + 1e-5f);
    const unsigned g = *(const unsigned*)(P + (size_t)qrow * INW + C_GA + h * 128 + 2 * lane);
    const float r0 = o0 * rn * subln_w[2 * lane] * oml * silu_f(__uint_as_float(g << 16)), r1 = o1 * rn * subln_w[2 * lane + 1] * oml * silu_f(__uint_as_float(g & 0xffff0000u));
    *(unsigned*)(MG + (size_t)qrow * DM + h * 128 + 2 * lane) = pk2(r0, r1);
}

template <bool LAT> __global__ __launch_bounds__(256) void k_attnB(const bf16_t* P, bf16_t* MG, const float* rpb) {
    constexpr int NQ = LAT ? SEQ : NCTX, NK = LAT ? (NCTX + 128) : NCTX, NJ = NK / 64;
    __shared__ float qs[4][128];
    __shared__ float pw[4][NK];
    const int wave = threadIdx.x >> 6, lane = threadIdx.x & 63;
    const int gq = blockIdx.x * 4 + wave;
    const int b = gq / (HEADS * NQ), h = (gq / NQ) % HEADS, t = gq % NQ;
    const int qrow = LAT ? b * SEQ + t : NLAT + b * NCTX + t;
    const int r = t >> 6, cq = t & 63;
    const int r0 = min(max(r - 4, 0), 24), c0 = min(max(cq - 8, 0), 48);
    qs[wave][lane] = bf2f(P[(size_t)qrow * INW + C_QB + h * 128 + lane]); qs[wave][lane + 64] = bf2f(P[(size_t)qrow * INW + C_QB + h * 128 + 64 + lane]);
    __syncthreads();
    float s[NJ]; int krows[NJ]; float m = -3e38f;
#pragma unroll
    for (int j = 0; j < NJ; ++j) {
        const int k = lane + 64 * j; int krow; float bias = 0.f;
        if (k < NCTX) krow = NLAT + b * NCTX + k;
        else { const int w = k - NCTX, i = w >> 4, cc = w & 15, R = r0 + i, ck = c0 + cc; krow = b * SEQ + R * 64 + ck;
               const int dr = R - r + 7, dc = min(max(ck - cq + 15, 0), 30); bias = rpb[(h * 15 + dr) * 31 + dc]; }
        krows[j] = krow;
        const unsigned* kp = (const unsigned*)(P + (size_t)krow * INW + C_KB + h * 128);
        float a = 0.f;
#pragma unroll 8
        for (int d = 0; d < 64; ++d) { const unsigned w0 = kp[d]; a += qs[wave][2 * d] * __uint_as_float(w0 << 16) + qs[wave][2 * d + 1] * __uint_as_float(w0 & 0xffff0000u); }
        s[j] = a * 0.08838834764831845f + bias; m = fmaxf(m, s[j]);
    }
    m = wave_max(m);
    float l = 0.f;
#pragma unroll
    for (int j = 0; j < NJ; ++j) { s[j] = expf(s[j] - m); l += s[j]; }
    l = wave_sum(l); const float il = 1.f / l;
#pragma unroll
    for (int j = 0; j < NJ; ++j) pw[wave][lane + 64 * j] = s[j] * il;
    __syncthreads();
    float o0 = 0.f, o1 = 0.f;
    for (int k = 0; k < NK; ++k) {
        int krow;
        if (k < NCTX) krow = NLAT + b * NCTX + k; else { const int w = k - NCTX; krow = b * SEQ + (r0 + (w >> 4)) * 64 + c0 + (w & 15); }
        const unsigned w = *(const unsigned*)(P + (size_t)krow * INW + C_VB + h * 128 + 2 * lane); const float p = pw[wave][k];
        o0 += p * __uint_as_float(w << 16); o1 += p * __uint_as_float(w & 0xffff0000u);
    }
    const unsigned g = *(const unsigned*)(P + (size_t)qrow * INW + C_GB + h * 128 + 2 * lane);
    *(unsigned*)(MG + (size_t)qrow * DM + 1536 + h * 128 + 2 * lane) = pk2(o0 * silu_f(__uint_as_float(g << 16)), o1 * silu_f(__uint_as_float(g & 0xffff0000u)));
}

__global__ __launch_bounds__(256) void k_convgate(const bf16_t* P, const float* conv_w, const float* conv_b, const float* wa, const float* ba, const float* wx, const float* bx, const float* rlam, float* AA, float* BB) {
    __shared__ float us[4][64];
    const int rr = threadIdx.x >> 6, j = threadIdx.x & 63, n = blockIdx.y, row = blockIdx.x * 4 + rr, ch = n * 64 + j;
    const bool isctx = row >= NLAT; const int t = isctx ? ((row - NLAT) & 255) : (row & 2047), len = isctx ? NCTX : SEQ, rb = row - t;
    float u = conv_b[ch];
#pragma unroll
    for (int jj = 0; jj < 4; ++jj) { const int tt = t + jj - 2; if (tt >= 0 && tt < len) u += conv_w[jj * 1024 + ch] * bf2f(P[(size_t)(rb + tt) * INW + C_XC + ch]); }
    us[rr][j] = u;
    __syncthreads();
#pragma unroll
    for (int d = 0; d < 2; ++d) {
        float pr = ba[d * 1024 + ch], pi = bx[d * 1024 + ch];
        const float* wap = wa + (size_t)((d * 16 + n) * 64) * 64 + j; const float* wxp = wx + (size_t)((d * 16 + n) * 64) * 64 + j;
#pragma unroll 8
        for (int i = 0; i < 64; ++i) { const float uu = us[rr][i]; pr += uu * wap[i * 64]; pi += uu * wxp[i * 64]; }
        const float rg = sigmoid_f(pr), ig = sigmoid_f(pi), x = -rlam[d * 1024 + ch], sp = x > 20.f ? x : log1pf(expf(x));
        const float log_a = -8.f * rg * sp, a = expf(log_a), bb = sqrtf(-expm1f(2.f * log_a)) * (ig * u);
        AA[((size_t)d * NROW + row) * 1024 + ch] = a; BB[((size_t)d * NROW + row) * 1024 + ch] = bb;
    }
}
__global__ __launch_bounds__(256) void k_scan(const float* AA, const float* BB, float* HH) {
    const int idx = blockIdx.x * 256 + threadIdx.x, ch = idx & 1023, d = (idx >> 10) & 1, b = idx >> 11;
    float h = 0.f;
    for (int s = 0; s < NCTX; ++s) { const int j = d ? NCTX - 1 - s : s; const size_t o = ((size_t)d * NROW + NLAT + b * NCTX + j) * 1024 + ch; h = AA[o] * h + BB[o]; HH[o] = h; }
    for (int s = 0; s < SEQ; ++s) { const int t = d ? SEQ - 1 - s : s; const size_t o = ((size_t)d * NROW + b * SEQ + t) * 1024 + ch; h = AA[o] * h + BB[o]; HH[o] = h; }
}
__global__ __launch_bounds__(256) void k_mergeC(const bf16_t* P, const float* HH, bf16_t* MG) {
    const size_t gid = (size_t)blockIdx.x * 256 + threadIdx.x; const int row = (int)(gid >> 10), ch = (int)(gid & 1023);
    const float o = HH[(size_t)row * 1024 + ch] + HH[((size_t)NROW + row) * 1024 + ch];
    MG[(size_t)row * DM + 3072 + ch] = (bf16_t)f2bf(o * silu_f(bf2f(P[(size_t)row * INW + C_GC + ch])));
}
__global__ __launch_bounds__(512) void k_final(float* X, const float* w) {
    const int wave = threadIdx.x >> 6, lane = threadIdx.x & 63, gw = blockIdx.x * 8 + wave, NGW = gridDim.x * 8;
    for (int row = gw; row < NLAT; row += NGW) {
        f32x4* xr = (f32x4*)(X + (size_t)row * DM) + lane; f32x4 v[16]; float s = 0.f;
#pragma unroll
        for (int j = 0; j < 16; ++j) { v[j] = xr[64 * j]; s += (v[j].x * v[j].x + v[j].y * v[j].y) + (v[j].z * v[j].z + v[j].w * v[j].w); }
        const float rstd = 1.f / sqrtf(wave_sum(s) * (1.f / DM) + 1e-6f);
#pragma unroll
        for (int j = 0; j < 16; ++j) xr[64 * j] = v[j] * rstd * ((const f32x4*)w)[lane + 64 * j];
    }
}

extern "C" void kernel_launch(void* const* d_in, const int* in_sizes, int n_in, void* d_out, int out_size, void* d_ws, size_t ws_size, hipStream_t stream) {
    static int ok = 0;
    if (ok == 0) {
        if (n_in != 20 || in_sizes[0] != NLAT * DM || out_size != NLAT * DM || ws_size < WS_END) { fprintf(stderr, "kernel_launch: shape/workspace mismatch: n_in %d in0 %d out %d ws %zu (need %zu)\n", n_in, n_in > 0 ? in_sizes[0] : -1, out_size, ws_size, (size_t)WS_END); ok = -1; return; }
        if (hipFuncSetAttribute((const void*)k_gemm<pg8::EpiP>, hipFuncAttributeMaxDynamicSharedMemorySize, pg8::STAGE_BYTES) != hipSuccess ||
            hipFuncSetAttribute((const void*)k_gemm<pg8::EpiRes>, hipFuncAttributeMaxDynamicSharedMemorySize, pg8::STAGE_BYTES) != hipSuccess) { fprintf(stderr, "kernel_launch: hipFuncSetAttribute failed\n"); ok = -1; return; }
        ok = 1;
    }
    if (ok < 0) return;
    const float* x = (const float*)d_in[0]; const float* c = (const float*)d_in[1]; const float* ctx = (const float*)d_in[2]; const float* c_ctx = (const float*)d_in[3];
    const float* ada_w = (const float*)d_in[4]; const float* ada_b = (const float*)d_in[5]; const float* norm_w = (const float*)d_in[6]; const float* w_in = (const float*)d_in[7];
    const float* w_out = (const float*)d_in[8]; const float* lambda_qk = (const float*)d_in[9]; const float* subln_w = (const float*)d_in[10]; const float* rpb = (const float*)d_in[11];
    const float* conv_w = (const float*)d_in[12]; const float* conv_b = (const float*)d_in[13]; const float* rg_wa = (const float*)d_in[14]; const float* rg_ba = (const float*)d_in[15];
    const float* rg_wx = (const float*)d_in[16]; const float* rg_bx = (const float*)d_in[17]; const float* rg_lambda = (const float*)d_in[18]; const float* final_norm_w = (const float*)d_in[19];
    unsigned char* ws = (unsigned char*)d_ws; float* out = (float*)d_out;
    float* mod = (float*)(ws + WS_MOD); float* rope = (float*)(ws + WS_ROPE); float* lam = (float*)(ws + WS_LAM);
    bf16_t* WinT = (bf16_t*)(ws + WS_WIN); bf16_t* WoutT = (bf16_t*)(ws + WS_WOUT); bf16_t* HX = (bf16_t*)(ws + WS_HX); bf16_t* P = (bf16_t*)(ws + WS_P); bf16_t* MG = (bf16_t*)(ws + WS_MG);
    float* CTXRES = (float*)(ws + WS_CTXRES); float* AA = (float*)(ws + WS_AA); float* BB = (float*)(ws + WS_BB); float* HH = (float*)(ws + WS_HH);

    hipLaunchKernelGGL(k_transpose, dim3(1024), dim3(512), 0, stream, w_in, w_out, WinT, WoutT);
    hipLaunchKernelGGL(k_small, dim3(4), dim3(256), 0, stream, lambda_qk, rope, lam);
    hipLaunchKernelGGL(k_mod, dim3(768), dim3(512), 0, stream, c, c_ctx, ada_w, ada_b, mod);
    for (int l = 0; l < 2; ++l) {
        const float* xl = l == 0 ? x : out; const float* xc = l == 0 ? ctx : CTXRES; const float* modl = mod + (size_t)l * 9 * 12288;
        hipLaunchKernelGGL(k_norm, dim3(1024), dim3(512), 0, stream, xl, xc, norm_w + l * DM, modl, HX);
        { pg8::Gemm g{HX, WinT + (size_t)l * INW * DM, NROW, INW, DM, 0}; pg8::EpiP E{P, INW, 0};
          hipLaunchKernelGGL((k_gemm<pg8::EpiP>), dim3(256), dim3(512), pg8::STAGE_BYTES, stream, g, E); }
        hipLaunchKernelGGL(k_rope, dim3((unsigned)((size_t)NLAT * 1536 / 256)), dim3(256), 0, stream, P, rope);
        hipLaunchKernelGGL((k_attnA<true>), dim3(NB * HEADS * SEQ / 4), dim3(256), 0, stream, P, MG, subln_w + l * 128, lam, l);
        hipLaunchKernelGGL((k_attnB<true>), dim3(NB * HEADS * SEQ / 4), dim3(256), 0, stream, P, MG, rpb + (size_t)l * 12 * 15 * 31);
        if (l == 0) {
            hipLaunchKernelGGL((k_attnA<false>), dim3(NB * HEADS * NCTX / 4), dim3(256), 0, stream, P, MG, subln_w + l * 128, lam, l);
            hipLaunchKernelGGL((k_attnB<false>), dim3(NB * HEADS * NCTX / 4), dim3(256), 0, stream, P, MG, rpb + (size_t)l * 12 * 15 * 31);
        }
        hipLaunchKernelGGL(k_convgate, dim3(NROW / 4, 16), dim3(256), 0, stream, P, conv_w + l * 4096, conv_b + l * 1024, rg_wa + (size_t)l * 2 * 16 * 4096, rg_ba + l * 2048, rg_wx + (size_t)l * 2 * 16 * 4096, rg_bx + l * 2048, rg_lambda + l * 2048, AA, BB);
        hipLaunchKernelGGL(k_scan, dim3(64), dim3(256), 0, stream, AA, BB, HH);
        hipLaunchKernelGGL(k_mergeC, dim3(NROW * 1024 / 256), dim3(256), 0, stream, P, HH, MG);
        { const int M = l == 0 ? NROW : NLAT; pg8::Gemm g{MG, WoutT + (size_t)l * DM * DM, M, DM, DM, 0}; pg8::EpiRes E{xl, xc, out, CTXRES, modl + 8192, NLAT, 0};
          hipLaunchKernelGGL((k_gemm<pg8::EpiRes>), dim3(256), dim3(512), pg8::STAGE_BYTES, stream, g, E); }
    }
    hipLaunchKernelGGL(k_final, dim3(1024), dim3(512), 0, stream, out, final_norm_w);
}
```

```cpp
#include <hip/hip_runtime.h>
#include <cstdio>
#include <cstdint>
#include <cmath>
namespace pg8 {
#define PG8_LAS __attribute__((address_space(3)))
typedef unsigned short bf16_t;
typedef short bf16x8 __attribute__((ext_vector_type(8)));
typedef float f32x4 __attribute__((ext_vector_type(4)));
typedef unsigned u32x4 __attribute__((ext_vector_type(4)));
constexpr int BM = 256, BK = 64, HALF = 128, HTB = HALF * BK * 2  , STAGE_BYTES = 8 * HTB, NXCD = 8, WGM = 8;

__host__ __device__ __forceinline__ int lds_byte(int r, int c) { const int st = (r >> 4) * 2 + (c >> 5), rr = r & 15, cc = c & 31, ob = rr * 64 + cc * 2; return st * 1024 + (ob ^ (((ob >> 9) & 1) << 5)); }
__host__ __device__ __forceinline__ void stage_rc(int b, int& R, int& C) { const int st = b / 1024, sb = b % 1024, swz = sb ^ (((sb >> 9) & 1) << 5); R = (st >> 1) * 16 + swz / 64; C = (st & 1) * 32 + (swz % 64) / 2; }
__host__ __device__ __forceinline__ int perm32(int rho) { const int n = rho >> 4, i = rho & 15; return 8 * (i >> 2) + 4 * n + (i & 3); }

struct Unit { int pm, pn; };
struct Gemm { const bf16_t* A; const bf16_t* Bt; int M, N, K, pad; };

struct StaticOrder {
    int nM, nN, nwg, G, c;
    __host__ __device__ void init(int M, int N, int G_, int c_) { nM = M / BM; nN = N / BM; nwg = nM * nN; G = G_; c = c_; }
    __host__ __device__ bool next(int i, Unit& u) const {
        const long L = (long)i * G + c; if (L >= nwg) return false;
        int wgid = (int)L; { const int q = nwg / NXCD, r = nwg % NXCD, xcd = wgid % NXCD, off = wgid / NXCD; wgid = (xcd < r ? xcd * (q + 1) : r * (q + 1) + (xcd - r) * q) + off; }
        const int nig = WGM * nN, gid = wgid / nig, fm = gid * WGM, gsz = (nM - fm) < WGM ? (nM - fm) : WGM;
        u.pm = fm + ((wgid % nig) % gsz); u.pn = (wgid % nig) / gsz; return true;
    }
    __device__ __forceinline__ void a_ready(const Unit&) const {}
    __device__ __forceinline__ void done(const Unit&) const {}
};

struct PrunedOrder {
    StaticOrder S; int n_main, n_x;
    __host__ __device__ void init(int M_main, int N, int G_, int c_, int n_x_) { S.init(M_main, N, G_, c_); n_main = S.nwg; n_x = n_x_; }
    __host__ __device__ bool next(int i, Unit& u) const {
        const long L = (long)i * S.G + S.c;
        if (L < n_main) return S.next(i, u);
        const int k = (int)(L - n_main); if (k >= n_x * 28) return false;
        const int idx = k % 28; u.pm = S.nM + k / 28; u.pn = idx < 12 ? 6 + idx : (idx < 24 ? 30 + (idx - 12) : 48 + (idx - 24)); return true;
    }
    __device__ __forceinline__ void a_ready(const Unit&) const {}
    __device__ __forceinline__ void done(const Unit&) const {}
};
__device__ __forceinline__ unsigned cvt_pk_bf16(float lo, float hi) { unsigned r; asm volatile("v_cvt_pk_bf16_f32 %0, %1, %2" : "=v"(r) : "v"(lo), "v"(hi)); return r; }

struct EpiP {
    static constexpr bool PERM = true, AFTER_DRAIN = false; static constexpr int NVM = 16;
    bf16_t* O; int ldc, pad; const float* rope;
    bf16_t* QKV;
    __device__ __forceinline__ void operator()(const f32x4 (&acc)[2][2][4][2], const Unit& u, int wr, int wc, int fr_, int fq_) const {
        int lid; asm volatile("v_mbcnt_lo_u32_b32 %0, -1, 0\n\tv_mbcnt_hi_u32_b32 %0, -1, %0" : "=v"(lid)); const int fr = lid & 15, fq = lid >> 4;
        const int rowt = u.pm * BM, colt = u.pn * BM;
        const int row0 = rowt + wr * 64 + fr, col0 = colt + wc * 32 + 8 * fq;
        const bool do_rope = (rowt < 16384) && (colt < 3072);
        const bool hm = (colt < 4608) || (colt >= 6144 && colt < 10752); const int th0 = colt < 4608 ? colt / 128 : 36 + (colt - 6144) / 128; const size_t bjs = hm ? (size_t)18432 * 128 : (size_t)HALF;
        const float sgn = (fq < 2) ? -1.f : 1.f;
        const int ln = fr + 16 * fq, sfr = ln >> 2, sfq = ln & 3, ssrc = (sfr + 16 * sfq) * 4;
        const int srow0 = rowt + wr * 64 + sfr;
#pragma unroll
        for (int ai = 0; ai < 2; ++ai)
#pragma unroll
            for (int m = 0; m < 4; ++m) { const int row = row0 + ai * HALF + m * 16; const int srow = srow0 + ai * HALF + m * 16;
                bf16_t* rowp = hm ? QKV + ((size_t)th0 * 18432 + srow) * 128 + wc * 32 + 8 * sfq : O + (size_t)srow * ldc + colt + wc * 32 + 8 * sfq;
                f32x4 cs[4] = {};
                if (do_rope) { const int pos = (wc & 1) ? (row & 63) : ((row & 2047) >> 6); const f32x4* tp = (const f32x4*)(rope + (pos * 16 + 8 * (fq & 1)) * 2);
#pragma unroll
                    for (int e = 0; e < 4; ++e) cs[e] = tp[e]; }
#pragma unroll
                for (int bj = 0; bj < 2; ++bj) { f32x4 v0 = acc[ai][bj][m][0], v1 = acc[ai][bj][m][1];
                    if (do_rope) {
                        f32x4 o0, o1;
#pragma unroll
                        for (int e = 0; e < 4; ++e) { o0[e] = __shfl_xor(v0[e], 32); o1[e] = __shfl_xor(v1[e], 32); }
                        v0[0] = v0[0] * cs[0][0] + sgn * o0[0] * cs[0][1]; v0[1] = v0[1] * cs[0][2] + sgn * o0[1] * cs[0][3];
                        v0[2] = v0[2] * cs[1][0] + sgn * o0[2] * cs[1][1]; v0[3] = v0[3] * cs[1][2] + sgn * o0[3] * cs[1][3];
                        v1[0] = v1[0] * cs[2][0] + sgn * o1[0] * cs[2][1]; v1[1] = v1[1] * cs[2][2] + sgn * o1[1] * cs[2][3];
                        v1[2] = v1[2] * cs[3][0] + sgn * o1[2] * cs[3][1]; v1[3] = v1[3] * cs[3][2] + sgn * o1[3] * cs[3][3];
                    }
                    u32x4 w; w.x = cvt_pk_bf16(v0[0], v0[1]); w.y = cvt_pk_bf16(v0[2], v0[3]); w.z = cvt_pk_bf16(v1[0], v1[1]); w.w = cvt_pk_bf16(v1[2], v1[3]);
                    u32x4 ws; ws.x = (unsigned)__builtin_amdgcn_ds_bpermute(ssrc, (int)w.x); ws.y = (unsigned)__builtin_amdgcn_ds_bpermute(ssrc, (int)w.y);
                    ws.z = (unsigned)__builtin_amdgcn_ds_bpermute(ssrc, (int)w.z); ws.w = (unsigned)__builtin_amdgcn_ds_bpermute(ssrc, (int)w.w);
                    *(u32x4*)(rowp + bj * bjs) = ws; } }
    }
};
struct EpiRes {
    static constexpr bool PERM = false, AFTER_DRAIN = false; static constexpr int NVM = 32;
    const float* res_lat; const float* res_ctx; float* out_lat; float* out_ctx; const float* gate; int nlat, pad;
    __device__ __forceinline__ void operator()(const f32x4 (&acc)[2][2][4][2], const Unit& u, int wr, int wc, int fr_, int fq_) const {
        int lid; asm volatile("v_mbcnt_lo_u32_b32 %0, -1, 0\n\tv_mbcnt_hi_u32_b32 %0, -1, %0" : "=v"(lid)); const int fr = lid & 15, fq = lid >> 4;
        const int rowt = u.pm * BM; const bool isctx = rowt >= nlat; const int gr = isctx ? 8 : (rowt >> 11);
        const float* res = isctx ? res_ctx : res_lat; float* out = isctx ? out_ctx : out_lat;
        const int lrow0 = (isctx ? rowt - nlat : rowt) + wr * 64 + fr, col0 = u.pn * BM + wc * 32 + 4 * fq;
        f32x4 gv[2][2];
#pragma unroll
        for (int bj = 0; bj < 2; ++bj)
#pragma unroll
            for (int n = 0; n < 2; ++n) gv[bj][n] = *(const f32x4*)(gate + (size_t)gr * 12288 + col0 + bj * HALF + n * 16);
#pragma unroll
        for (int ai = 0; ai < 2; ++ai)
#pragma unroll
            for (int m = 0; m < 4; ++m) { const size_t off = (size_t)(lrow0 + ai * HALF + m * 16) * 4096 + col0;
#pragma unroll
                for (int bj = 0; bj < 2; ++bj)
#pragma unroll
                    for (int n = 0; n < 2; ++n) { const f32x4 rs = *(const f32x4*)(res + off + bj * HALF + n * 16);
                        *(f32x4*)(out + off + bj * HALF + n * 16) = rs + gv[bj][n] * acc[ai][bj][m][n]; } }
    }
};
template <bool RB> struct EpiRes2 {
    static constexpr bool PERM = true, AFTER_DRAIN = false; static constexpr int NVM = 0;
    const void* res_lat; const float* res_ctx; bf16_t* out; const float* gate; int nlat, pad;
    __device__ __forceinline__ void operator()(const f32x4 (&acc)[2][2][4][2], const Unit& u, int wr, int wc, int fr_, int fq_) const {
        int lid; asm volatile("v_mbcnt_lo_u32_b32 %0, -1, 0\n\tv_mbcnt_hi_u32_b32 %0, -1, %0" : "=v"(lid)); const int fr = lid & 15, fq = lid >> 4;
        const int rowt = u.pm * BM, colt = u.pn * BM; const bool isctx = rowt >= nlat; const int gr = isctx ? 8 : (rowt >> 11);
        const int col0 = colt + wc * 32 + 8 * fq, row0 = rowt + wr * 64 + fr;
        const int sfr = lid >> 2, sfq = lid & 3, ssrc = (sfr + 16 * sfq) * 4, srow0 = rowt + wr * 64 + sfr, scol0 = colt + wc * 32 + 8 * sfq;
#pragma unroll
        for (int bj = 0; bj < 2; ++bj) {
            const f32x4 g0 = *(const f32x4*)(gate + (size_t)gr * 12288 + col0 + bj * HALF), g1 = *(const f32x4*)(gate + (size_t)gr * 12288 + col0 + bj * HALF + 4);
#pragma unroll
            for (int ai = 0; ai < 2; ++ai)
#pragma unroll
                for (int m = 0; m < 4; ++m) { const int row = row0 + ai * HALF + m * 16, srow = srow0 + ai * HALF + m * 16; f32x4 r0, r1;
                    if constexpr (RB) { const u32x4 rb = *(const u32x4*)((const bf16_t*)res_lat + (size_t)row * 4096 + col0 + bj * HALF);
                        r0 = (f32x4){__uint_as_float(rb.x << 16), __uint_as_float(rb.x & 0xffff0000u), __uint_as_float(rb.y << 16), __uint_as_float(rb.y & 0xffff0000u)};
                        r1 = (f32x4){__uint_as_float(rb.z << 16), __uint_as_float(rb.z & 0xffff0000u), __uint_as_float(rb.w << 16), __uint_as_float(rb.w & 0xffff0000u)}; }
                    else { const float* rp = (isctx ? res_ctx + (size_t)(row - nlat) * 4096 : (const float*)res_lat + (size_t)row * 4096) + col0 + bj * HALF; r0 = *(const f32x4*)rp; r1 = *(const f32x4*)(rp + 4); }
                    const f32x4 v0 = r0 + g0 * acc[ai][bj][m][0], v1 = r1 + g1 * acc[ai][bj][m][1];
                    u32x4 w; w.x = cvt_pk_bf16(v0[0], v0[1]); w.y = cvt_pk_bf16(v0[2], v0[3]); w.z = cvt_pk_bf16(v1[0], v1[1]); w.w = cvt_pk_bf16(v1[2], v1[3]);
                    u32x4 ws; ws.x = (unsigned)__builtin_amdgcn_ds_bpermute(ssrc, (int)w.x); ws.y = (unsigned)__builtin_amdgcn_ds_bpermute(ssrc, (int)w.y);
                    ws.z = (unsigned)__builtin_amdgcn_ds_bpermute(ssrc, (int)w.z); ws.w = (unsigned)__builtin_amdgcn_ds_bpermute(ssrc, (int)w.w);
                    *(u32x4*)(out + (size_t)srow * 4096 + scol0 + bj * HALF) = ws;
                }
        }
    }
};
template <class Epi, class Sched, bool ALIGN_EPI = false, bool SP2 = false>
__device__ __forceinline__ void gemm_phase(PG8_LAS unsigned char* lds, const Gemm g, const Sched& S, const Epi& E, int wave0) {
    int tid; asm volatile("v_mbcnt_lo_u32_b32 %0, -1, 0\n\tv_mbcnt_hi_u32_b32 %0, -1, %0" : "=v"(tid)); tid |= (wave0 << 6);
    const int wid = __builtin_amdgcn_readfirstlane(tid >> 6), lane = tid & 63, wr = wid >> 2, wc = wid & 3, fr = lane & 15, fq = lane >> 4;
    const int K = g.K, nt = K / BK;
    unsigned voffA[2], voffB[2];
#pragma unroll
    for (int i = 0; i < 2; ++i) { int R, C; stage_rc(tid * 16 + i * 8192, R, C); const int Rb = Epi::PERM ? ((R & ~31) + perm32(R & 31)) : R;
        voffA[i] = (unsigned)(R * K + C) * 2u; voffB[i] = (unsigned)(Rb * K + C) * 2u; }
    const size_t kstep = (size_t)(BK * 2);
    const size_t hstep = (size_t)HALF * K * 2;
    const size_t tstep = 2 * hstep;
    const unsigned ldsw = (unsigned)wid * 1024u;
    const int aoff = lds_byte(wr * 64 + fr, fq * 8), boff = lds_byte(wc * 32 + fr, fq * 8);
#define PG8_SA(b, h) (((b) * 2 + (h)) * HTB)
#define PG8_SB(b, h) ((4 + (b) * 2 + (h)) * HTB)
#define PG8_STAGE(bufoff, gbase, voff) do { _Pragma("unroll") for (int _i = 0; _i < 2; ++_i) \
        __builtin_amdgcn_global_load_lds((const unsigned*)((const char*)(gbase) + (voff)[_i]), (PG8_LAS unsigned*)(lds + (bufoff) + ldsw + _i * 8192), 16, 0, 0); } while (0)
#define PG8_LDA(dst, b, h) do { _Pragma("unroll") for (int m = 0; m < 4; ++m) _Pragma("unroll") for (int k = 0; k < 2; ++k) dst[m][k] = *(const PG8_LAS bf16x8*)(lds + PG8_SA(b, h) + aoff + m * 2048 + k * 1024); } while (0)
#define PG8_LDB(dst, b, h) do { _Pragma("unroll") for (int n = 0; n < 2; ++n) _Pragma("unroll") for (int k = 0; k < 2; ++k) dst[n][k] = *(const PG8_LAS bf16x8*)(lds + PG8_SB(b, h) + boff + n * 2048 + k * 1024); } while (0)
#define PG8_MMA(ai, bj, At, Bt) do { __builtin_amdgcn_s_setprio(1); _Pragma("unroll") for (int m = 0; m < 4; ++m) _Pragma("unroll") for (int n = 0; n < 2; ++n) _Pragma("unroll") for (int k = 0; k < 2; ++k) \
        acc[ai][bj][m][n] = __builtin_amdgcn_mfma_f32_16x16x32_bf16(Bt[n][k], At[m][k], acc[ai][bj][m][n], 0, 0, 0); __builtin_amdgcn_s_setprio(0); } while (0)
#define PG8_WAIT_V(n) asm volatile("s_waitcnt vmcnt(" #n ")" ::: "memory")
#define PG8_WAIT_L(n) asm volatile("s_waitcnt lgkmcnt(" #n ")" ::: "memory")
#define PG8_BAR __builtin_amdgcn_s_barrier()
#define PG8_SCHED __builtin_amdgcn_sched_barrier(0)
    Unit cur, nxt; int ui = 0;
    if (!S.next(0, cur)) return;
    f32x4 acc[2][2][4][2];
#pragma unroll
    for (int a = 0; a < 2; ++a)
#pragma unroll
        for (int b = 0; b < 2; ++b)
#pragma unroll
            for (int m = 0; m < 4; ++m)
#pragma unroll
                for (int n = 0; n < 2; ++n) acc[a][b][m][n] = (f32x4){0.f, 0.f, 0.f, 0.f};
    bf16x8 At[4][2], B0[2][2], B1[2][2];
    const char* cA = (const char*)g.A + (size_t)cur.pm * tstep; const char* cB = (const char*)g.Bt + (size_t)cur.pn * tstep;
    S.a_ready(cur);
    {
        PG8_STAGE(PG8_SB(0, 0), cB, voffB); PG8_STAGE(PG8_SB(0, 1), cB + hstep, voffB); PG8_STAGE(PG8_SA(0, 0), cA, voffA); PG8_STAGE(PG8_SA(0, 1), cA + hstep, voffA);
        PG8_STAGE(PG8_SB(1, 0), cB + kstep, voffB); PG8_STAGE(PG8_SA(1, 0), cA + kstep, voffA); PG8_STAGE(PG8_SB(1, 1), cB + hstep + kstep, voffB); PG8_STAGE(PG8_SA(1, 1), cA + hstep + kstep, voffA);
        if (wr == 1) PG8_BAR;
        PG8_WAIT_V(0); PG8_BAR; PG8_BAR;
    }
    for (;;) {
        const bool has_next = S.next(ui + 1, nxt);
        const char* nA = has_next ? (const char*)g.A + (size_t)nxt.pm * tstep : cA; const char* nB = has_next ? (const char*)g.Bt + (size_t)nxt.pn * tstep : cB;
#define PG8_ITER(t, W, L2) do { \
            const bool last = (L2) && ((t) == nt - 2); \
            const char* a1 = cA + (size_t)((t) + 1) * kstep; \
            const char* a2 = last ? nA : cA + (size_t)((t) + 2) * kstep; const char* b2 = last ? nB : cB + (size_t)((t) + 2) * kstep; \
            const char* a3 = a2 + kstep; const char* b3 = b2 + kstep; \
            if (last && has_next) S.a_ready(nxt); \
            PG8_LDB(B0, 0, 0); PG8_LDB(B1, 0, 1); PG8_SCHED; PG8_LDA(At, 0, 0); if (L2) PG8_STAGE(PG8_SA(1, 1), a1 + hstep, voffA); \
            PG8_WAIT_V(W); PG8_WAIT_L(0); PG8_BAR; PG8_MMA(0, 0, At, B0); PG8_MMA(0, 1, At, B1); PG8_BAR; PG8_SCHED; \
            PG8_LDA(At, 0, 1); PG8_STAGE(PG8_SB(0, 0), b2, voffB); PG8_STAGE(PG8_SB(0, 1), b2 + hstep, voffB); PG8_STAGE(PG8_SA(0, 0), a2, voffA); \
            PG8_WAIT_V(W); PG8_WAIT_L(0); PG8_BAR; PG8_MMA(1, 0, At, B0); PG8_MMA(1, 1, At, B1); PG8_BAR; PG8_SCHED; \
            PG8_LDB(B0, 1, 0); PG8_LDB(B1, 1, 1); PG8_SCHED; PG8_LDA(At, 1, 0); PG8_STAGE(PG8_SA(0, 1), a2 + hstep, voffA); \
            PG8_WAIT_V(W); PG8_WAIT_L(0); PG8_BAR; PG8_MMA(0, 0, At, B0); PG8_MMA(0, 1, At, B1); PG8_BAR; PG8_SCHED; \
            PG8_LDA(At, 1, 1); PG8_STAGE(PG8_SB(1, 0), b3, voffB); PG8_STAGE(PG8_SB(1, 1), b3 + hstep, voffB); PG8_STAGE(PG8_SA(1, 0), a3, voffA); \
            PG8_WAIT_V(8); PG8_WAIT_L(0); PG8_BAR; PG8_MMA(1, 0, At, B0); PG8_MMA(1, 1, At, B1); PG8_BAR; PG8_SCHED; } while (0)
        static_assert(SP2, "only the super-phase schedule is kept");
        if constexpr (Epi::NVM == 16) PG8_ITER(0, 24, 0); else if constexpr (Epi::NVM == 32) PG8_ITER(0, 40, 0);
        for (int t = (Epi::NVM ? 2 : 0); t < nt; t += 2) PG8_ITER(t, 8, 1);
        if constexpr (Epi::NVM != 0) { if (has_next) PG8_STAGE(PG8_SA(1, 1), nA + kstep + hstep, voffA); }
        if constexpr (ALIGN_EPI) { if (wr == 0) PG8_BAR; }
        if constexpr (!Epi::AFTER_DRAIN) { E(acc, cur, wr, wc, fr, fq); S.done(cur); }
        if (!has_next) break;
#pragma unroll
        for (int a = 0; a < 2; ++a)
#pragma unroll
            for (int b = 0; b < 2; ++b)
#pragma unroll
                for (int m = 0; m < 4; ++m)
#pragma unroll
                    for (int n = 0; n < 2; ++n) acc[a][b][m][n] = (f32x4){0.f, 0.f, 0.f, 0.f};
        cur = nxt; cA = nA; cB = nB; ++ui;
        if constexpr (ALIGN_EPI) { if (wr == 1) PG8_BAR; }
    }
    PG8_WAIT_V(0);
    if constexpr (!ALIGN_EPI) { if (wr == 0) PG8_BAR; }
    PG8_BAR;
    if constexpr (Epi::AFTER_DRAIN) { E.fused(acc, cur, wr, wc, fr, fq, lds, wid, lane); S.done(cur); }
#undef PG8_SA
#undef PG8_SB
#undef PG8_STAGE
#undef PG8_LDA
#undef PG8_LDB
#undef PG8_MMA
#undef PG8_WAIT_V
#undef PG8_WAIT_L
#undef PG8_BAR
#undef PG8_SCHED
#undef PG8_ITER
}
}

constexpr int DM = 4096, NB = 8, SEQ = 2048, NCTX = 256, INW = 14336, NLAT = NB * SEQ, NROW = NLAT + NB * NCTX;
constexpr int HEADS = 12;
constexpr int C_QA = 0, C_KA = 1536, C_VA = 3072, C_GA = 4608, C_QB = 6144, C_KB = 7680, C_VB = 9216, C_GB = 10752, C_XC = 12288, C_GC = 13312;
constexpr size_t MiB = 1u << 20;
constexpr size_t WS_CTL = 0, WS_MOD = 1 * MiB, WS_ROPE = 2 * MiB, WS_LAM = 2 * MiB + 65536, WS_WIN = 4 * MiB, WS_WOUT = 228 * MiB, WS_HX = 292 * MiB, WS_P = 436 * MiB,
                 WS_MG = 940 * MiB, WS_CTXRES = 1084 * MiB, WS_HH = 1116 * MiB, WS_QKV = 1260 * MiB, WS_X1 = 1584 * MiB  , WS_END = 1728 * MiB;
constexpr size_t CTL_ZERO_BYTES = 1 * MiB;
constexpr int CW_BAR = 4096;
typedef unsigned short bf16_t;
typedef float f32x4 __attribute__((ext_vector_type(4)));
#define GAS __attribute__((address_space(1)))
typedef unsigned v4u __attribute__((ext_vector_type(4)));
#define LDS_WAIT() asm volatile("s_waitcnt lgkmcnt(0)" ::: "memory")

__device__ __forceinline__ float bf2f(bf16_t b) { return __uint_as_float(((unsigned)b) << 16); }
__device__ __forceinline__ unsigned f2bf(float f) { unsigned u = __float_as_uint(f); return (u + 0x7fffu + ((u >> 16) & 1u)) >> 16; }
__device__ __forceinline__ unsigned pk2(float lo, float hi) { return f2bf(lo) | (f2bf(hi) << 16); }
__device__ __forceinline__ float wave_sum(float v) {
#pragma unroll
    for (int o = 1; o < 64; o <<= 1) v += __shfl_xor(v, o);
    return v;
}
__device__ __forceinline__ float wave_max(float v) {
#pragma unroll
    for (int o = 1; o < 64; o <<= 1) v = fmaxf(v, __shfl_xor(v, o));
    return v;
}
__device__ __forceinline__ float silu_f(float v) { return v / (1.f + expf(-v)); }
__device__ __forceinline__ float sigmoid_f(float v) { return 1.f / (1.f + expf(-v)); }
__device__ __forceinline__ float silu_fast(float v) { return v * __builtin_amdgcn_rcpf(1.f + __builtin_amdgcn_exp2f(-1.4426950408889634f * v)); }
__device__ __forceinline__ float silu_e2(float v) { return v / (1.f + __builtin_amdgcn_exp2f(-1.4426950408889634f * v)); }
#define XB_TMO      128
#define XB_XCNT(j)  (256  + 64 * (j))
#define XB_XSUB(j)  (1280 + 64 * (j))
#define XB_XGEN(j)  (2304 + 64 * (j))
#define XB_TOP      3328
#define XB_TOPGEN   3392
#define XCD_BAR_WORDS 3456
#define XB_SPIN_CAP (1u << 18)
#define LAS __attribute__((address_space(3)))

__device__ __forceinline__ unsigned xb_ld(unsigned* p)              { return __hip_atomic_load(p, __ATOMIC_RELAXED, __HIP_MEMORY_SCOPE_AGENT); }
__device__ __forceinline__ unsigned xb_add(unsigned* p, unsigned v) { return __hip_atomic_fetch_add(p, v, __ATOMIC_RELAXED, __HIP_MEMORY_SCOPE_AGENT); }
__device__ __forceinline__ unsigned xb_xcc_id() { return (unsigned)__builtin_amdgcn_s_getreg((3 << 11) | 20) & 0xFu; }
#define XB_SPIN(cond, bar) do { unsigned _sp = 0; while (cond) { __builtin_amdgcn_s_sleep(1); \
    if ((++_sp & 255u) == 0u) { if (xb_ld(&(bar)[XB_TMO])) break; if (_sp > XB_SPIN_CAP) { atomicAdd(&(bar)[XB_TMO], 1u); break; } } } } while (0)

struct XcdBarrier {
    unsigned* bar; unsigned x;
    volatile LAS unsigned* st;
};

__device__ __forceinline__ XcdBarrier xcd_barrier_post(unsigned* bar, volatile LAS unsigned* st) {
    XcdBarrier b; b.bar = bar; b.x = xb_xcc_id(); b.st = st;
    if (threadIdx.x == 0) (void)xb_add(&bar[XB_XCNT(b.x)], 1u);
    return b;
}
__device__ __forceinline__ void xcd_barrier_complete(unsigned* bar, unsigned x, unsigned& nloc, unsigned& nx) {
    const unsigned G = gridDim.x * gridDim.y * gridDim.z;
    unsigned sum, cnt, mine, sp = 0u;
    for (;;) {
        sum = 0u; cnt = 0u; mine = 0u;
#pragma unroll
        for (unsigned j = 0; j < 16; ++j) { const unsigned c = xb_ld(&bar[XB_XCNT(j)]); sum += c; cnt += (c > 0u) ? 1u : 0u; mine = (j == x) ? c : mine; }
        if (sum == G) break;
        __builtin_amdgcn_s_sleep(1);
        if ((++sp & 255u) == 0u) { if (xb_ld(&bar[XB_TMO])) break; if (sp > XB_SPIN_CAP) { atomicAdd(&bar[XB_TMO], 1u); break; } }
    }
    nloc = mine > 0u ? mine : 1u; nx = cnt > 0u ? cnt : 1u;
}

__device__ __forceinline__ void xcd_barrier(const XcdBarrier& b) {
    asm volatile("s_waitcnt vmcnt(0)" ::: "memory");
    __syncthreads();
    if (threadIdx.x == 0) {
        unsigned* bar = b.bar;
        __builtin_amdgcn_s_waitcnt(0);
        unsigned nloc = b.st[0], nx = b.st[1];
        if (nloc == 0u) { xcd_barrier_complete(bar, b.x, nloc, nx); b.st[0] = nloc; b.st[1] = nx; }
        const unsigned old = xb_add(&bar[XB_XSUB(b.x)], 1u);
        const unsigned gen = old / nloc;
        if (old + 1u == (gen + 1u) * nloc) {
            __builtin_amdgcn_fence(__ATOMIC_RELEASE, "agent");
            asm volatile("s_waitcnt vmcnt(0)" ::: "memory");
            const unsigned og = xb_add(&bar[XB_TOP], 1u);
            const unsigned tg = og / nx;
            if (og + 1u == (tg + 1u) * nx) xb_add(&bar[XB_TOPGEN], 1u);
            else XB_SPIN(xb_ld(&bar[XB_TOPGEN]) == tg, bar);
            __builtin_amdgcn_fence(__ATOMIC_ACQUIRE, "agent");
            xb_add(&bar[XB_XGEN(b.x)], 1u);
            asm volatile("s_waitcnt vmcnt(0)" ::: "memory");
        } else {
            XB_SPIN(xb_ld(&bar[XB_XGEN(b.x)]) == gen, bar);
            __builtin_amdgcn_fence(__ATOMIC_ACQUIRE, "agent");
            asm volatile("s_waitcnt vmcnt(0)" ::: "memory");
        }
    }
    __syncthreads();
}
#define LAS __attribute__((address_space(3)))
constexpr int RING_BYTES = 131072, MISC_OFF = 143360, LDS_BYTES = 147456;

__device__ __forceinline__ void tr_load(float (&v)[32], const float* W, int N, int item, int lane) {
    const int nblk = N / 32, kb = item / nblk, nb = item % nblk, k0 = 64 * kb, n0 = 32 * nb;
#pragma unroll
    for (int i = 0; i < 32; ++i) v[i] = W[(size_t)(k0 + 2 * i + (lane >> 5)) * N + n0 + (lane & 31)];
}
__device__ __forceinline__ void tr_finish(const float (&v)[32], bf16_t* WT, int N, int item, LAS float* scr, int lane) {
    const int nblk = N / 32, kb = item / nblk, nb = item % nblk, k0 = 64 * kb, n0 = 32 * nb;
#pragma unroll
    for (int i = 0; i < 32; ++i) scr[(2 * i + (lane >> 5)) * 33 + (lane & 31)] = v[i];
    LDS_WAIT(); asm volatile("" ::: "memory");
    const int c = lane & 7;
#pragma unroll
    for (int j = 0; j < 4; ++j) { const int n = (lane >> 3) + 8 * j; const LAS float* s = scr + (8 * c) * 33 + n;
        v4u o; o.x = pk2(s[0 * 33], s[1 * 33]); o.y = pk2(s[2 * 33], s[3 * 33]); o.z = pk2(s[4 * 33], s[5 * 33]); o.w = pk2(s[6 * 33], s[7 * 33]);
        *(GAS v4u*)(WT + (size_t)(n0 + n) * DM + k0 + 8 * c) = o; }
    LDS_WAIT(); asm volatile("" ::: "memory");
}
constexpr int TR_IL = (DM / 64) * (INW / 32) + (DM / 64) * (DM / 32);
#define TR_RESOLVE(it, W, WT, N, r) do { constexpr int I_IN = (DM / 64) * (INW / 32); const int l_ = (it) / TR_IL; r = (it) % TR_IL; \
        if (r < I_IN) { W = w_in + (size_t)l_ * DM * INW; WT = WinT + (size_t)l_ * INW * DM; N = INW; } else { W = w_out + (size_t)l_ * DM * DM; WT = WoutT + (size_t)l_ * DM * DM; N = DM; r -= I_IN; } } while (0)
__device__ __forceinline__ void ph_transpose(const float* w_in, const float* w_out, bf16_t* WinT, bf16_t* WoutT, LAS unsigned char* lds, int wave, int lane, int lo, int hi, int gw, int NGW) {
    LAS float* scr = (LAS float*)lds + wave * 64 * 33;
    int it = lo + gw; if (it >= hi) return;
    float va[32], vb[32]; const float* Wa; const float* Wb; bf16_t* Ta; bf16_t* Tb; int Na, Nb, ra, rb;
    TR_RESOLVE(it, Wa, Ta, Na, ra); tr_load(va, Wa, Na, ra, lane);
    for (;;) {
        const int it2 = it + NGW; const bool h2 = it2 < hi;
        if (h2) { TR_RESOLVE(it2, Wb, Tb, Nb, rb); tr_load(vb, Wb, Nb, rb, lane); }
        tr_finish(va, Ta, Na, ra, scr, lane);
        if (!h2) break;
        const int it3 = it2 + NGW; const bool h3 = it3 < hi;
        if (h3) { TR_RESOLVE(it3, Wa, Ta, Na, ra); tr_load(va, Wa, Na, ra, lane); }
        tr_finish(vb, Tb, Nb, rb, scr, lane);
        if (!h3) break;
        it = it3;
    }
}
__device__ __forceinline__ void ph_small(const float* lambda_qk, float* rope, float* lam, int tid) {
    for (int i = tid; i < 1024; i += 512) { const int pos = i >> 4, f = i & 15; const float fr = exp2f(-(float)f * (13.287712379549449f / 16.f)), ang = (float)pos * fr; float sn, cs; sincosf(ang, &sn, &cs); rope[2 * i] = cs; rope[2 * i + 1] = sn; }
    if (tid < 2) { const float* lq = lambda_qk + tid * 256; float s01 = 0.f, s23 = 0.f; for (int d = 0; d < 64; ++d) { s01 += lq[d] * lq[64 + d]; s23 += lq[128 + d] * lq[192 + d]; }
        const float lam_init = 0.8f - 0.6f * expf(-0.3f * (float)tid); lam[tid] = expf(s01) - expf(s23) + lam_init; lam[2 + tid] = 1.f - lam_init; }
}
__device__ __forceinline__ void ph_mod(const float* c, const float* c_ctx, const float* ada_w, const float* ada_b, float* mod, LAS unsigned char* lds, int tid, int bid, int G) {
    LAS float* sl = (LAS float*)lds; LAS float* red = (LAS float*)(lds + 9 * 1024 * 4);
    const int kg = tid >> 5, cj = tid & 31;
    for (int item = bid; item < 2 * 384; item += G) {
        const int l = item / 384, j0 = (item % 384) * 32;
        float acc[9];
#pragma unroll
        for (int r = 0; r < 9; ++r) acc[r] = 0.f;
        const float* W = ada_w + (size_t)l * DM * 12288 + j0 + cj;
        for (int ch = 0; ch < 4; ++ch) {
            __syncthreads();
            for (int idx = tid; idx < 9 * 1024; idx += 512) { const int r = idx >> 10, kk = idx & 1023; const float v = (r < 8) ? c[r * DM + ch * 1024 + kk] : c_ctx[ch * 1024 + kk]; sl[idx] = silu_f(v); }
            __syncthreads();
#pragma unroll 4
            for (int i = 0; i < 64; ++i) { const int kk = kg + 16 * i; const float w = W[(size_t)(ch * 1024 + kk) * 12288];
#pragma unroll
                for (int r = 0; r < 9; ++r) acc[r] += sl[r * 1024 + kk] * w; }
        }
#pragma unroll
        for (int r = 0; r < 9; ++r) red[(kg * 9 + r) * 32 + cj] = acc[r];
        __syncthreads();
        if (tid < 288) { const int r = tid >> 5, c2 = tid & 31; float s = ada_b[l * 12288 + j0 + c2];
            for (int g = 0; g < 16; ++g) s += red[(g * 9 + r) * 32 + c2];
            mod[(size_t)(l * 9 + r) * 12288 + j0 + c2] = s; }
    }
    __syncthreads();
}
template <bool BF> __device__ __forceinline__ void ph_norm(const void* xlat, const float* xctx, const float* norm_w, const float* mod, bf16_t* HX, int wave, int lane, int bid, int G) {
    const int gw = bid * 8 + wave, NGW = G * 8;
    for (int row = gw; row < NROW; row += NGW) {
        const bool isctx = row >= NLAT; const int r = isctx ? 8 : (row >> 11);
        f32x4 v[16]; float s = 0.f;
        if constexpr (BF) { const unsigned long long* xr = (const unsigned long long*)((const bf16_t*)xlat + (size_t)row * DM) + lane;
#pragma unroll
            for (int j = 0; j < 16; ++j) { const unsigned long long q = xr[64 * j]; const unsigned lo = (unsigned)q, hi = (unsigned)(q >> 32);
                v[j] = (f32x4){__uint_as_float(lo << 16), __uint_as_float(lo & 0xffff0000u), __uint_as_float(hi << 16), __uint_as_float(hi & 0xffff0000u)}; }
        } else { const f32x4* xr = (const f32x4*)(isctx ? xctx + (size_t)(row - NLAT) * DM : (const float*)xlat + (size_t)row * DM) + lane;
#pragma unroll
            for (int j = 0; j < 16; ++j) v[j] = xr[64 * j]; }
#pragma unroll
        for (int j = 0; j < 16; ++j) s += (v[j].x * v[j].x + v[j].y * v[j].y) + (v[j].z * v[j].z + v[j].w * v[j].w);
        const float rstd = 1.f / sqrtf(wave_sum(s) * (1.f / DM) + 1e-6f);
        const f32x4* nw = (const f32x4*)norm_w + lane; const f32x4* sh = (const f32x4*)(mod + (size_t)r * 12288) + lane; const f32x4* sc = (const f32x4*)(mod + (size_t)r * 12288 + 4096) + lane;
        unsigned long long* o8 = (unsigned long long*)(HX + (size_t)row * DM) + lane;
#pragma unroll
        for (int j = 0; j < 16; ++j) { const f32x4 w = nw[64 * j], a = sc[64 * j], b = sh[64 * j]; const f32x4 y = v[j] * rstd * w; const f32x4 o = y * (a + 1.f) + b;
            o8[64 * j] = (unsigned long long)pk2(o.x, o.y) | ((unsigned long long)pk2(o.z, o.w) << 32); }
    }
}
namespace att {
using bf16x8 = __attribute__((ext_vector_type(8))) short;
using s16x4  = __attribute__((ext_vector_type(4))) short;
using f32x16 = __attribute__((ext_vector_type(16))) float;
using u32x4  = __attribute__((ext_vector_type(4))) unsigned;
constexpr int SHM_V = 16384, SHM_K = 16384, OFF_K = 2 * SHM_V, OFF_BIAS = OFF_K + 2 * SHM_K, ATT_LDS = OFF_BIAS + 2048;
#define KSWZ(row, colB) ((row) * 256 + ((colB) ^ (((row) & 7) << 4)))
#define SBAR() __builtin_amdgcn_sched_barrier(0)
__device__ __forceinline__ int crow(int r, int hi) { return (r & 3) + 8 * (r >> 2) + 4 * hi; }
__device__ __forceinline__ unsigned cvtpk(float lo, float hi) { unsigned r; asm("v_cvt_pk_bf16_f32 %0, %1, %2" : "=v"(r) : "v"(lo), "v"(hi)); return r; }
__device__ __forceinline__ int v_st(int k, int c) { const int kk = (k & ~0xC) | ((k & 4) << 1) | ((k & 8) >> 1); return ((kk >> 3) * 4 + (c >> 5)) * 512 + ((kk & 7) * 32 + (c & 31)) * 2; }
__device__ __forceinline__ int v_rd_base(int lane) { return ((lane & 3) << 3) | (((lane >> 2) & 3) << 6) | (((lane >> 4) & 1) << 5) | (((lane >> 5) & 1) << 8); }
constexpr int v_rd_off(int d0, int ks, int half) { return d0 * 512 + ks * 4096 + half * 2048; }
template <int OFF> __device__ __forceinline__ s16x4 tr_read(int vb) { return __builtin_amdgcn_ds_read_tr16_b64_v4i16((LAS s16x4*)(unsigned)(vb + OFF)); }
template <int D0> __device__ __forceinline__ void pv_one(f32x16& od, int vb, bf16x8 pa0, bf16x8 pa1, bf16x8 pa2, bf16x8 pa3) {
  s16x4 l0 = tr_read<v_rd_off(D0, 0, 0)>(vb), h0 = tr_read<v_rd_off(D0, 0, 1)>(vb), l1 = tr_read<v_rd_off(D0, 1, 0)>(vb), h1 = tr_read<v_rd_off(D0, 1, 1)>(vb);
  s16x4 l2 = tr_read<v_rd_off(D0, 2, 0)>(vb), h2 = tr_read<v_rd_off(D0, 2, 1)>(vb), l3 = tr_read<v_rd_off(D0, 3, 0)>(vb), h3 = tr_read<v_rd_off(D0, 3, 1)>(vb);
#define PK(L, H) (bf16x8){L[0], L[1], L[2], L[3], H[0], H[1], H[2], H[3]}
  od = __builtin_amdgcn_mfma_f32_32x32x16_bf16(pa0, PK(l0, h0), od, 0, 0, 0);
  od = __builtin_amdgcn_mfma_f32_32x32x16_bf16(pa1, PK(l1, h1), od, 0, 0, 0);
  od = __builtin_amdgcn_mfma_f32_32x32x16_bf16(pa2, PK(l2, h2), od, 0, 0, 0);
  od = __builtin_amdgcn_mfma_f32_32x32x16_bf16(pa3, PK(l3, h3), od, 0, 0, 0);
#undef PK
}
__device__ __forceinline__ void pv_d0(f32x16* o, int vb, bf16x8 pa0, bf16x8 pa1, bf16x8 pa2, bf16x8 pa3) {
  pv_one<0>(o[0], vb, pa0, pa1, pa2, pa3); pv_one<1>(o[1], vb, pa0, pa1, pa2, pa3); pv_one<2>(o[2], vb, pa0, pa1, pa2, pa3); pv_one<3>(o[3], vb, pa0, pa1, pa2, pa3);
}
#define PK4(P, BASE, OUT) do { unsigned a0 = cvtpk(P[BASE + 0], P[BASE + 1]), a1 = cvtpk(P[BASE + 2], P[BASE + 3]);   \
    unsigned b0 = cvtpk(P[BASE + 4], P[BASE + 5]), b1 = cvtpk(P[BASE + 6], P[BASE + 7]);                              \
    auto r0 = __builtin_amdgcn_permlane32_swap(a0, b0, false, false); auto r1 = __builtin_amdgcn_permlane32_swap(a1, b1, false, false); \
    u32x4 w = {r0[0], r1[0], r0[1], r1[1]}; OUT = *reinterpret_cast<bf16x8*>(&w); } while (0)
template <int D_LO, int D_HI> __device__ __forceinline__ void qkt(f32x16& x0, f32x16& x1, const LAS unsigned char* Ks, const bf16x8* qr, int r32, int hi) {
  x0 = f32x16{}; x1 = f32x16{};
#pragma unroll
  for (int d0 = D_LO; d0 < D_HI; ++d0) { const int cb = (d0 * 16 + hi * 8) * 2;
    const bf16x8 b0 = *reinterpret_cast<const LAS bf16x8*>(Ks + KSWZ(r32, cb));
    const bf16x8 b1 = *reinterpret_cast<const LAS bf16x8*>(Ks + KSWZ(32 + r32, cb));
    x0 = __builtin_amdgcn_mfma_f32_32x32x16_bf16(b0, qr[d0], x0, 0, 0, 0);
    x1 = __builtin_amdgcn_mfma_f32_32x32x16_bf16(b1, qr[d0], x1, 0, 0, 0); }
}
struct UnitDesc {
  int qrow0;
  int krow_ctx;
  int krow_lat;
  int lt0, nlt;
  int tq, tk, tv;
  int cg, co;
  int na;
};
constexpr float LOG2E = 1.4426950408889634f;
template <bool DIFF>
__device__ __forceinline__ void attn_unit(const bf16_t* __restrict__ P, const bf16_t* __restrict__ QKV, bf16_t* __restrict__ MG, LAS unsigned char* lds, int tid, const UnitDesc u,
                                          float lam, float oml, const float* __restrict__ subln_w, const float* __restrict__ rpb_h) {
  asm volatile("" : "+v"(tid));
  const int wid = __builtin_amdgcn_readfirstlane(tid >> 6), lane = tid & 63, r32 = lane & 31, hi = lane >> 5;
  LAS unsigned char* V_lds = lds; LAS unsigned char* K_lds = lds + OFF_K; LAS float* bias_l = (LAS float*)(lds + OFF_BIAS);
  constexpr float CS = (DIFF ? 0.125f : 0.08838834764831845f) * LOG2E;
  bf16x8 qr[8];
  { const bf16_t* Qw = QKV + ((size_t)u.tq * NROW + u.qrow0 + wid * 32 + r32) * 128 + hi * 8;
#pragma unroll
    for (int d0 = 0; d0 < 8; ++d0) qr[d0] = *reinterpret_cast<const bf16x8*>(Qw + d0 * 16); }
  const int grow = ((u.qrow0 & 2047) >> 6) + (wid >> 1), cqx = 32 * (wid & 1) + r32;
  const int r0 = min(max(grow - 4, 0), 24), c0 = min(max(cqx - 8, 0), 48);
  if (!DIFF && u.na) { __syncthreads(); if (tid < 465) bias_l[tid] = rpb_h[tid] * LOG2E; }
  const int sr = tid >> 4, sc = (tid & 15) * 8, vst0 = v_st(sr, sc), vst1 = v_st(32 + sr, sc), kst0 = KSWZ(sr, sc * 2), kst1 = KSWZ(32 + sr, sc * 2);
  const int vb0 = (int)(uintptr_t)V_lds + v_rd_base(lane);
  const int NT = 4 + u.nlt;
  bf16x8 ks0, ks1, vs0, vs1;
#define TROW(j) ((j) < 4 ? u.krow_ctx + 64 * (j) : u.krow_lat + 64 * (u.lt0 + (j) - 4))
#define KLOAD(j) do { const bf16_t* kp_ = QKV + ((size_t)u.tk * NROW + TROW(j) + sr) * 128 + sc; ks0 = *reinterpret_cast<const bf16x8*>(kp_); ks1 = *reinterpret_cast<const bf16x8*>(kp_ + 32 * 128); } while (0)
#define VLOAD(j) do { const bf16_t* vp_ = QKV + ((size_t)u.tv * NROW + TROW(j) + sr) * 128 + sc; vs0 = *reinterpret_cast<const bf16x8*>(vp_); vs1 = *reinterpret_cast<const bf16x8*>(vp_ + 32 * 128); } while (0)
#define KWRITE(b) do { *reinterpret_cast<LAS bf16x8*>(K_lds + (b) * SHM_K + kst0) = ks0; *reinterpret_cast<LAS bf16x8*>(K_lds + (b) * SHM_K + kst1) = ks1; } while (0)
#define VWRITE(b) do { *reinterpret_cast<LAS bf16x8*>(V_lds + (b) * SHM_V + vst0) = vs0; *reinterpret_cast<LAS bf16x8*>(V_lds + (b) * SHM_V + vst1) = vs1; } while (0)
#define NA_FIX(X0, X1, j) do { if (!DIFF && u.na && (j) >= 4) { const int R_ = u.lt0 + (j) - 4; const int bb_ = (R_ - grow + 7) * 31 + 15 - cqx; \
    _Pragma("unroll") for (int r = 0; r < 16; ++r) { const int ck0_ = crow(r, hi), ck1_ = 32 + ck0_; \
      const bool v0_ = (ck0_ >= c0) && (ck0_ < c0 + 16), v1_ = (ck1_ >= c0) && (ck1_ < c0 + 16); \
      const float b0_ = bias_l[v0_ ? bb_ + ck0_ : 0], b1_ = bias_l[v1_ ? bb_ + ck1_ : 0]; \
      X0[r] = v0_ ? X0[r] * CS + b0_ : -1e30f; X1[r] = v1_ ? X1[r] * CS + b1_ : -1e30f; } } \
    else { _Pragma("unroll") for (int r = 0; r < 16; ++r) { X0[r] *= CS; X1[r] *= CS; } } } while (0)
#define PART(j) (DIFF || !u.na || (j) < 4 || ((u.lt0 + (j) - 4) >= r0 && (u.lt0 + (j) - 4) < r0 + 8))
  float m0 = -1e30f, l0 = 0.f, m1 = -1e30f, l1 = 0.f;
  __syncthreads();
  KLOAD(0); KWRITE(0);
  __syncthreads();
  for (int j = 0; j < NT; ++j) {
    const LAS unsigned char* Kb = K_lds + (j & 1) * SHM_K;
    if (j + 1 < NT) KLOAD(j + 1);
    if (PART(j)) {
      f32x16 sx0, sx1;
      if (DIFF) {
        qkt<0, 4>(sx0, sx1, Kb, qr, r32, hi);
        { float tm = -1e30f;
#pragma unroll
          for (int r = 0; r < 16; ++r) { sx0[r] *= CS; sx1[r] *= CS; tm = fmaxf(tm, fmaxf(sx0[r], sx1[r])); }
          const float mn = fmaxf(m0, tm); float s = 0.f;
#pragma unroll
          for (int r = 0; r < 16; ++r) s += __builtin_amdgcn_exp2f(sx0[r] - mn) + __builtin_amdgcn_exp2f(sx1[r] - mn);
          l0 = l0 * __builtin_amdgcn_exp2f(m0 - mn) + s; m0 = mn; }
        qkt<4, 8>(sx0, sx1, Kb, qr, r32, hi);
        { float tm = -1e30f;
#pragma unroll
          for (int r = 0; r < 16; ++r) { sx0[r] *= CS; sx1[r] *= CS; tm = fmaxf(tm, fmaxf(sx0[r], sx1[r])); }
          const float mn = fmaxf(m1, tm); float s = 0.f;
#pragma unroll
          for (int r = 0; r < 16; ++r) s += __builtin_amdgcn_exp2f(sx0[r] - mn) + __builtin_amdgcn_exp2f(sx1[r] - mn);
          l1 = l1 * __builtin_amdgcn_exp2f(m1 - mn) + s; m1 = mn; }
      } else {
        qkt<0, 8>(sx0, sx1, Kb, qr, r32, hi);
        NA_FIX(sx0, sx1, j);
        float tm = -1e30f;
#pragma unroll
        for (int r = 0; r < 16; ++r) tm = fmaxf(tm, fmaxf(sx0[r], sx1[r]));
        const float mn = fmaxf(m0, tm); float s = 0.f;
#pragma unroll
        for (int r = 0; r < 16; ++r) s += __builtin_amdgcn_exp2f(sx0[r] - mn) + __builtin_amdgcn_exp2f(sx1[r] - mn);
        l0 = l0 * __builtin_amdgcn_exp2f(m0 - mn) + s; m0 = mn;
      }
    }
    if (j + 1 < NT) KWRITE((j + 1) & 1);
    __syncthreads();
  }
  float K0, K1 = 0.f, c1 = 0.f;
  { const float mo = __shfl_xor(m0, 32), lo = __shfl_xor(l0, 32), M = fmaxf(m0, mo), L = l0 * __builtin_amdgcn_exp2f(m0 - M) + lo * __builtin_amdgcn_exp2f(mo - M); K0 = M + __builtin_amdgcn_logf(L); }
  if (DIFF) { const float mo = __shfl_xor(m1, 32), lo = __shfl_xor(l1, 32), M = fmaxf(m1, mo), L = l1 * __builtin_amdgcn_exp2f(m1 - M) + lo * __builtin_amdgcn_exp2f(mo - M); K1 = M; c1 = lam * __builtin_amdgcn_rcpf(L); }
  f32x16 o[4] = {};
  KLOAD(0); VLOAD(0); KWRITE(0); VWRITE(0);
  __syncthreads();
  for (int j = 0; j < NT; ++j) {
    const LAS unsigned char* Kb = K_lds + (j & 1) * SHM_K;
    if (j + 1 < NT) { KLOAD(j + 1); VLOAD(j + 1); }
    if (PART(j)) {
      f32x16 sx0, sx1; bf16x8 pa0, pa1, pa2, pa3;
      if (DIFF) {
        f32x16 sy0, sy1;
        qkt<0, 4>(sx0, sx1, Kb, qr, r32, hi);
        qkt<4, 8>(sy0, sy1, Kb, qr, r32, hi);
#pragma unroll
        for (int r = 0; r < 16; ++r) {
          const float e0 = __builtin_amdgcn_exp2f(sx0[r] * CS - K0), e1 = __builtin_amdgcn_exp2f(sx1[r] * CS - K0);
          const float f0 = __builtin_amdgcn_exp2f(sy0[r] * CS - K1), f1 = __builtin_amdgcn_exp2f(sy1[r] * CS - K1);
          sx0[r] = e0 - c1 * f0; sx1[r] = e1 - c1 * f1; }
      } else {
        qkt<0, 8>(sx0, sx1, Kb, qr, r32, hi);
        NA_FIX(sx0, sx1, j);
#pragma unroll
        for (int r = 0; r < 16; ++r) { sx0[r] = __builtin_amdgcn_exp2f(sx0[r] - K0); sx1[r] = __builtin_amdgcn_exp2f(sx1[r] - K0); }
      }
      PK4(sx0, 0, pa0); PK4(sx0, 8, pa1); PK4(sx1, 0, pa2); PK4(sx1, 8, pa3);
      pv_d0(o, vb0 + (j & 1) * SHM_V, pa0, pa1, pa2, pa3);
    }
    if (j + 1 < NT) { KWRITE((j + 1) & 1); VWRITE((j + 1) & 1); }
    __syncthreads();
  }
  const int orow0 = u.qrow0 + wid * 32;
  float sw[4];
#pragma unroll
  for (int d0 = 0; d0 < 4; ++d0) sw[d0] = DIFF ? subln_w[32 * d0 + r32] * oml : 1.f;
#pragma unroll
  for (int r = 0; r < 16; ++r) {
    const int row = orow0 + crow(r, hi);
    float rn = 1.f;
    if (DIFF) { float ss = (o[0][r] * o[0][r] + o[1][r] * o[1][r]) + (o[2][r] * o[2][r] + o[3][r] * o[3][r]);
      ss += __shfl_xor(ss, 1); ss += __shfl_xor(ss, 2); ss += __shfl_xor(ss, 4); ss += __shfl_xor(ss, 8); ss += __shfl_xor(ss, 16);
      rn = __builtin_amdgcn_rsqf(ss * (1.f / 128.f) + 1e-5f); }
#pragma unroll
    for (int d0 = 0; d0 < 4; ++d0) {
      const float g = bf2f(P[(size_t)row * INW + u.cg + 32 * d0 + r32]);
      MG[(size_t)row * DM + u.co + 32 * d0 + r32] = (bf16_t)f2bf(o[d0][r] * rn * sw[d0] * silu_e2(g)); }
  }
#undef TROW
#undef KLOAD
#undef VLOAD
#undef KWRITE
#undef VWRITE
#undef NA_FIX
#undef PART
}

constexpr float DIFF_THR = 8.f;
__device__ __forceinline__ void attn_unit_diff1p(const bf16_t* __restrict__ P, const bf16_t* __restrict__ QKV, bf16_t* __restrict__ MG, LAS unsigned char* lds, int tid, const UnitDesc u,
                                                 const float* __restrict__ lamp, const float* __restrict__ subln_w) {
  asm volatile("" : "+v"(tid));
  const int wid = __builtin_amdgcn_readfirstlane(tid >> 6), lane = tid & 63, r32 = lane & 31, hi = lane >> 5, sub = wid & 1, rb = wid >> 1;
  LAS unsigned char* V_lds = lds; LAS unsigned char* K_lds = lds + 2 * SHM_V;
  LAS float* sc_l = (LAS float*)(lds + 4 * SHM_V) + wid * 64;
  constexpr float CS = 0.125f * LOG2E;
  bf16x8 qr[2][4];
#pragma unroll
  for (int a_ = 0; a_ < 2; ++a_) { const bf16_t* Qw = QKV + ((size_t)u.tq * NROW + u.qrow0 + rb * 64 + a_ * 32 + r32) * 128 + sub * 64 + hi * 8;
#pragma unroll
    for (int d = 0; d < 4; ++d) qr[a_][d] = *reinterpret_cast<const bf16x8*>(Qw + d * 16); }
  const int vb0 = (int)(uintptr_t)V_lds + v_rd_base(lane);
  const int NT = 4 + u.nlt;
  unsigned gk[2], gv[2];
#pragma unroll
  for (int i = 0; i < 2; ++i) { const int q = 64 * wid + 512 * i + lane, row = q >> 4, cx_ = (q & 15) ^ (row & 7); gk[i] = (unsigned)(row * 128 + cx_ * 8) * 2u;
    const int st = q >> 5, kk = 8 * (st >> 2) + ((q & 31) >> 2), c = 32 * (st & 3) + 8 * (q & 3), k = (kk & ~0xC) | ((kk & 4) << 1) | ((kk & 8) >> 1); gv[i] = (unsigned)(k * 128 + c) * 2u; }
#define TROW(j) ((j) < 4 ? u.krow_ctx + 64 * (j) : u.krow_lat + 64 * (u.lt0 + (j) - 4))
#define KVDMA(j, b) do { const char* kb_ = (const char*)(QKV + ((size_t)u.tk * NROW + TROW(j)) * 128); const char* vb_ = (const char*)(QKV + ((size_t)u.tv * NROW + TROW(j)) * 128); _Pragma("unroll") for (int i = 0; i < 2; ++i) { \
    __builtin_amdgcn_global_load_lds((const unsigned*)(kb_ + gk[i]), (LAS unsigned*)(K_lds + (b) * SHM_K + wid * 1024 + i * 8192), 16, 0, 0); \
    __builtin_amdgcn_global_load_lds((const unsigned*)(vb_ + gv[i]), (LAS unsigned*)(V_lds + (b) * SHM_V + wid * 1024 + i * 8192), 16, 0, 0); } } while (0)
#define DMA_WAIT_BAR() do { asm volatile("s_waitcnt vmcnt(0)" ::: "memory"); __syncthreads(); } while (0)
  f32x16 o[2][4] = {};
  float mrun[2] = {-1e30f, -1e30f}, lsum[2] = {0.f, 0.f};
  __syncthreads();
  KVDMA(0, 0);
  DMA_WAIT_BAR();
  for (int j = 0; j < NT; ++j) {
    if (j + 1 < NT) KVDMA(j + 1, (j + 1) & 1);
    const LAS unsigned char* Kb = K_lds + (j & 1) * SHM_K;
    const int vb = vb0 + (j & 1) * SHM_V;
#pragma unroll
    for (int hf = 0; hf < 2; ++hf) {
      f32x16 s0 = {}, s1 = {};
#pragma unroll
      for (int d = 0; d < 4; ++d) { const bf16x8 kf = *reinterpret_cast<const LAS bf16x8*>(Kb + KSWZ(32 * hf + r32, sub * 128 + (d * 16 + hi * 8) * 2));
        s0 = __builtin_amdgcn_mfma_f32_32x32x16_bf16(kf, qr[0][d], s0, 0, 0, 0);
        s1 = __builtin_amdgcn_mfma_f32_32x32x16_bf16(kf, qr[1][d], s1, 0, 0, 0); }
      bf16x8 pl0, ph0, pl1, ph1;
#define SOFTMAX(S, A, PL, PH) do { float tm_ = S[0]; _Pragma("unroll") for (int r = 1; r < 16; ++r) tm_ = fmaxf(tm_, S[r]); tm_ *= CS; \
      { const auto sw_ = __builtin_amdgcn_permlane32_swap(__float_as_uint(tm_), __float_as_uint(tm_), false, false); tm_ = fmaxf(__uint_as_float(sw_[0]), __uint_as_float(sw_[1])); } \
      if (__builtin_expect(__any(tm_ > mrun[A] + DIFF_THR), 0)) { const float mn_ = fmaxf(mrun[A], tm_), al_ = __builtin_amdgcn_exp2f(mrun[A] - mn_); mrun[A] = mn_; lsum[A] *= al_; \
        if (hi == 0) sc_l[r32] = al_; asm volatile("s_waitcnt lgkmcnt(0)" ::: "memory"); \
        _Pragma("unroll") for (int rq = 0; rq < 4; ++rq) { _Pragma("unroll") for (int ri = 0; ri < 4; ++ri) { const float f_ = sc_l[crow(4 * rq + ri, hi)]; _Pragma("unroll") for (int d0 = 0; d0 < 4; ++d0) o[A][d0][4 * rq + ri] *= f_; } \
          asm volatile("" ::: "memory"); } } \
      { const float nm_ = -mrun[A]; float su_ = 0.f; _Pragma("unroll") for (int r = 0; r < 16; ++r) { S[r] = __builtin_amdgcn_exp2f(fmaf(S[r], CS, nm_)); su_ += S[r]; } lsum[A] += su_; } \
      PK4(S, 0, PL); PK4(S, 8, PH); } while (0)
      SOFTMAX(s0, 0, pl0, ph0);
      SOFTMAX(s1, 1, pl1, ph1);
#pragma unroll
      for (int d0 = 0; d0 < 4; ++d0) {
        const s16x4 l0 = __builtin_amdgcn_ds_read_tr16_b64_v4i16((LAS s16x4*)(unsigned)(vb + d0 * 512 + (2 * hf) * 4096)), h0 = __builtin_amdgcn_ds_read_tr16_b64_v4i16((LAS s16x4*)(unsigned)(vb + d0 * 512 + (2 * hf) * 4096 + 2048));
        const s16x4 l1 = __builtin_amdgcn_ds_read_tr16_b64_v4i16((LAS s16x4*)(unsigned)(vb + d0 * 512 + (2 * hf + 1) * 4096)), h1 = __builtin_amdgcn_ds_read_tr16_b64_v4i16((LAS s16x4*)(unsigned)(vb + d0 * 512 + (2 * hf + 1) * 4096 + 2048));
        const bf16x8 v0 = (bf16x8){l0[0], l0[1], l0[2], l0[3], h0[0], h0[1], h0[2], h0[3]}, v1 = (bf16x8){l1[0], l1[1], l1[2], l1[3], h1[0], h1[1], h1[2], h1[3]};
        o[0][d0] = __builtin_amdgcn_mfma_f32_32x32x16_bf16(pl0, v0, o[0][d0], 0, 0, 0); o[1][d0] = __builtin_amdgcn_mfma_f32_32x32x16_bf16(pl1, v0, o[1][d0], 0, 0, 0);
        o[0][d0] = __builtin_amdgcn_mfma_f32_32x32x16_bf16(ph0, v1, o[0][d0], 0, 0, 0); o[1][d0] = __builtin_amdgcn_mfma_f32_32x32x16_bf16(ph1, v1, o[1][d0], 0, 0, 0);
      }
#undef SOFTMAX
    }
    DMA_WAIT_BAR();
  }
  const float lamv = sub ? lamp[0] : 1.f;
#pragma unroll
  for (int a_ = 0; a_ < 2; ++a_) { const float lt = lsum[a_] + __shfl_xor(lsum[a_], 32), f = lamv * __builtin_amdgcn_rcpf(lt);
    if (hi == 0) sc_l[r32] = f; asm volatile("s_waitcnt lgkmcnt(0)" ::: "memory");
#pragma unroll
    for (int rq = 0; rq < 4; ++rq) {
#pragma unroll
      for (int ri = 0; ri < 4; ++ri) { const float f_ = sc_l[crow(4 * rq + ri, hi)];
#pragma unroll
        for (int d0 = 0; d0 < 4; ++d0) o[a_][d0][4 * rq + ri] *= f_; }
      asm volatile("" ::: "memory"); }
    asm volatile("s_waitcnt lgkmcnt(0)" ::: "memory"); }
  LAS float* xs = (LAS float*)lds;
  __syncthreads();
#pragma unroll
  for (int d0 = 0; d0 < 4; ++d0)
#pragma unroll
    for (int r = 0; r < 16; ++r) xs[wid * 4096 + (d0 * 16 + r) * 64 + lane] = sub ? o[0][d0][r] : o[1][d0][r];
  __syncthreads();
  f32x16 fo[4];
#pragma unroll
  for (int d0 = 0; d0 < 4; ++d0)
#pragma unroll
    for (int r = 0; r < 16; ++r) { const float pv_ = xs[(wid ^ 1) * 4096 + (d0 * 16 + r) * 64 + lane]; fo[d0][r] = sub ? (pv_ - o[1][d0][r]) : (o[0][d0][r] - pv_); }
  __syncthreads();
  int tid2 = tid; asm volatile("" : "+v"(tid2));
  const int lane2 = tid2 & 63, c32 = lane2 & 31, h2 = lane2 >> 5;
  const int orow0 = u.qrow0 + rb * 64 + sub * 32;
  float sw[4]; const float oml = lamp[2];
#pragma unroll
  for (int d0 = 0; d0 < 4; ++d0) sw[d0] = subln_w[32 * d0 + c32] * oml;
#pragma unroll
  for (int r = 0; r < 16; ++r) {
    const int row = orow0 + crow(r, h2);
    float ss = (fo[0][r] * fo[0][r] + fo[1][r] * fo[1][r]) + (fo[2][r] * fo[2][r] + fo[3][r] * fo[3][r]);
    ss += __shfl_xor(ss, 1); ss += __shfl_xor(ss, 2); ss += __shfl_xor(ss, 4); ss += __shfl_xor(ss, 8); ss += __shfl_xor(ss, 16);
    const float rn = __builtin_amdgcn_rsqf(ss * (1.f / 128.f) + 1e-5f);
#pragma unroll
    for (int d0 = 0; d0 < 4; ++d0) {
      const float g = bf2f(P[(size_t)row * INW + u.cg + 32 * d0 + c32]);
      MG[(size_t)row * DM + u.co + 32 * d0 + c32] = (bf16_t)f2bf(fo[d0][r] * rn * sw[d0] * silu_e2(g)); }
  }
#undef TROW
#undef KVDMA
#undef DMA_WAIT_BAR
}

__device__ __forceinline__ void attn_unit_na1p(const bf16_t* __restrict__ P, const bf16_t* __restrict__ QKV, bf16_t* __restrict__ MG, LAS unsigned char* lds, int tid, const UnitDesc u,
                                               const float* __restrict__ rpb_h) {
  asm volatile("" : "+v"(tid));
  const int wid = __builtin_amdgcn_readfirstlane(tid >> 6), lane = tid & 63, r32 = lane & 31, hi = lane >> 5;
  LAS unsigned char* V_lds = lds; LAS unsigned char* K_lds = lds + 2 * SHM_V; LAS float* bias_l = (LAS float*)(lds + 4 * SHM_V);
  LAS float* sc_l = (LAS float*)(lds + 4 * SHM_V + 2048) + wid * 64;
  constexpr float CS = 0.08838834764831845f * LOG2E;
  bf16x8 qr[8];
  { const bf16_t* Qw = QKV + ((size_t)u.tq * NROW + u.qrow0 + wid * 32 + r32) * 128 + hi * 8;
#pragma unroll
    for (int d0 = 0; d0 < 8; ++d0) qr[d0] = *reinterpret_cast<const bf16x8*>(Qw + d0 * 16); }
  const int grow = ((u.qrow0 & 2047) >> 6) + (wid >> 1), cqx = 32 * (wid & 1) + r32;
  const int r0 = min(max(grow - 4, 0), 24), c0 = min(max(cqx - 8, 0), 48);
  const bool na = u.na != 0;
  __syncthreads();
  if (na && tid < 465) bias_l[tid] = rpb_h[tid] * LOG2E;
  const int vb0 = (int)(uintptr_t)V_lds + v_rd_base(lane);
  const int NT = 4 + u.nlt;
  unsigned gk[2], gv[2];
#pragma unroll
  for (int i = 0; i < 2; ++i) { const int q = 64 * wid + 512 * i + lane, row = q >> 4, cx_ = (q & 15) ^ (row & 7); gk[i] = (unsigned)(row * 128 + cx_ * 8) * 2u;
    const int st = q >> 5, kk = 8 * (st >> 2) + ((q & 31) >> 2), c = 32 * (st & 3) + 8 * (q & 3), k = (kk & ~0xC) | ((kk & 4) << 1) | ((kk & 8) >> 1); gv[i] = (unsigned)(k * 128 + c) * 2u; }
#define TROW(j) ((j) < 4 ? u.krow_ctx + 64 * (j) : u.krow_lat + 64 * (u.lt0 + (j) - 4))
#define KVDMA(j, b) do { const char* kb_ = (const char*)(QKV + ((size_t)u.tk * NROW + TROW(j)) * 128); const char* vb_ = (const char*)(QKV + ((size_t)u.tv * NROW + TROW(j)) * 128); _Pragma("unroll") for (int i = 0; i < 2; ++i) { \
    __builtin_amdgcn_global_load_lds((const unsigned*)(kb_ + gk[i]), (LAS unsigned*)(K_lds + (b) * SHM_K + wid * 1024 + i * 8192), 16, 0, 0); \
    __builtin_amdgcn_global_load_lds((const unsigned*)(vb_ + gv[i]), (LAS unsigned*)(V_lds + (b) * SHM_V + wid * 1024 + i * 8192), 16, 0, 0); } } while (0)
#define DMA_WAIT_BAR() do { asm volatile("s_waitcnt vmcnt(0)" ::: "memory"); __syncthreads(); } while (0)
  f32x16 o[4] = {};
  float mrun = -1e30f, lsum = 0.f;
  KVDMA(0, 0);
  DMA_WAIT_BAR();
  for (int j = 0; j < NT; ++j) {
    if (j + 1 < NT) KVDMA(j + 1, (j + 1) & 1);
    const int R = u.lt0 + j - 4;
    if (!na || j < 4 || (R >= r0 && R < r0 + 8)) {
      const LAS unsigned char* Kb = K_lds + (j & 1) * SHM_K; const int vb = vb0 + (j & 1) * SHM_V;
      f32x16 s0 = {}, s1 = {};
#pragma unroll
      for (int d0 = 0; d0 < 8; ++d0) { const int cb = (d0 * 16 + hi * 8) * 2;
        s0 = __builtin_amdgcn_mfma_f32_32x32x16_bf16(*reinterpret_cast<const LAS bf16x8*>(Kb + KSWZ(r32, cb)), qr[d0], s0, 0, 0, 0);
        s1 = __builtin_amdgcn_mfma_f32_32x32x16_bf16(*reinterpret_cast<const LAS bf16x8*>(Kb + KSWZ(32 + r32, cb)), qr[d0], s1, 0, 0, 0); }
      if (na && j >= 4) { const int bb = (R - grow + 7) * 31 + 15 - cqx;
#pragma unroll
        for (int r = 0; r < 16; ++r) { const int ck0 = crow(r, hi), ck1 = 32 + ck0; const bool v0 = (ck0 >= c0) && (ck0 < c0 + 16), v1 = (ck1 >= c0) && (ck1 < c0 + 16);
          const float b0 = bias_l[v0 ? bb + ck0 : 0], b1 = bias_l[v1 ? bb + ck1 : 0];
          s0[r] = v0 ? fmaf(s0[r], CS, b0) : -1e30f; s1[r] = v1 ? fmaf(s1[r], CS, b1) : -1e30f; } }
      else {
#pragma unroll
        for (int r = 0; r < 16; ++r) { s0[r] *= CS; s1[r] *= CS; } }
      float tm = s0[0];
#pragma unroll
      for (int r = 1; r < 16; ++r) tm = fmaxf(tm, s0[r]);
#pragma unroll
      for (int r = 0; r < 16; ++r) tm = fmaxf(tm, s1[r]);
      { const auto sw_ = __builtin_amdgcn_permlane32_swap(__float_as_uint(tm), __float_as_uint(tm), false, false); tm = fmaxf(__uint_as_float(sw_[0]), __uint_as_float(sw_[1])); }
      if (__builtin_expect(__any(tm > mrun + DIFF_THR), 0)) { const float mn = fmaxf(mrun, tm), al = __builtin_amdgcn_exp2f(mrun - mn); mrun = mn; lsum *= al;
        if (hi == 0) sc_l[r32] = al; asm volatile("s_waitcnt lgkmcnt(0)" ::: "memory");
#pragma unroll
        for (int rq = 0; rq < 4; ++rq) {
#pragma unroll
          for (int ri = 0; ri < 4; ++ri) { const float f_ = sc_l[crow(4 * rq + ri, hi)];
#pragma unroll
            for (int d0 = 0; d0 < 4; ++d0) o[d0][4 * rq + ri] *= f_; }
          asm volatile("" ::: "memory"); } }
      { float su = 0.f;
#pragma unroll
        for (int r = 0; r < 16; ++r) { s0[r] = __builtin_amdgcn_exp2f(s0[r] - mrun); s1[r] = __builtin_amdgcn_exp2f(s1[r] - mrun); su += s0[r] + s1[r]; }
        lsum += su; }
      bf16x8 pa0, pa1, pa2, pa3;
      PK4(s0, 0, pa0); PK4(s0, 8, pa1); PK4(s1, 0, pa2); PK4(s1, 8, pa3);
      pv_d0(o, vb, pa0, pa1, pa2, pa3);
    }
    DMA_WAIT_BAR();
  }
  { const float lt = lsum + __shfl_xor(lsum, 32), f = __builtin_amdgcn_rcpf(lt);
    if (hi == 0) sc_l[r32] = f; asm volatile("s_waitcnt lgkmcnt(0)" ::: "memory");
#pragma unroll
    for (int rq = 0; rq < 4; ++rq) {
#pragma unroll
      for (int ri = 0; ri < 4; ++ri) { const float f_ = sc_l[crow(4 * rq + ri, hi)];
#pragma unroll
        for (int d0 = 0; d0 < 4; ++d0) o[d0][4 * rq + ri] *= f_; }
      asm volatile("" ::: "memory"); } }
  int tid2 = tid; asm volatile("" : "+v"(tid2));
  const int lane2 = tid2 & 63, c32 = lane2 & 31, h2 = lane2 >> 5;
  const int orow0 = u.qrow0 + wid * 32;
#pragma unroll
  for (int r = 0; r < 16; ++r) {
    const int row = orow0 + crow(r, h2);
#pragma unroll
    for (int d0 = 0; d0 < 4; ++d0) {
      const float g = bf2f(P[(size_t)row * INW + u.cg + 32 * d0 + c32]);
      MG[(size_t)row * DM + u.co + 32 * d0 + c32] = (bf16_t)f2bf(o[d0][r] * silu_e2(g)); }
  }
#undef TROW
#undef KVDMA
#undef DMA_WAIT_BAR
}
}


__device__ __forceinline__ void ph_attn(const bf16_t* P, const bf16_t* QKV, bf16_t* MG, const float* subln_w, const float* rpb_l, const float* lamp, bool with_ctx, LAS unsigned char* lds, int wave0, int bid, int G) {
#define UNIT_TID() int tid; asm volatile("v_mbcnt_lo_u32_b32 %0, -1, 0\n\tv_mbcnt_hi_u32_b32 %0, -1, %0" : "=v"(tid)); tid |= (wave0 << 6)
    const int NU = with_ctx ? 864 : 768;
    for (int u = bid; u < NU; u += G) {
        att::UnitDesc d; int h;
        if (u < 768) { const int x = u & 7, j = (u >> 3) & 31, i = u >> 8, pl = (i * 32 + j) >> 3, p = pl * 8 + x, b = p / 12, qb = j & 7; h = p % 12;     d.qrow0 = b * SEQ + qb * 256; d.krow_ctx = NLAT + b * NCTX; d.krow_lat = b * SEQ; d.nlt = 32; }
        else { const int v = u - 768, b = v / 12; h = v % 12; d.qrow0 = NLAT + b * NCTX; d.krow_ctx = NLAT + b * NCTX; d.krow_lat = b * SEQ; d.nlt = 0; }
        d.lt0 = 0; d.tq = h; d.tk = 12 + h; d.tv = 24 + h; d.cg = C_GA + h * 128; d.co = h * 128; d.na = 0;
        UNIT_TID(); att::attn_unit_diff1p(P, QKV, MG, lds, tid, d, lamp, subln_w);
    }
    for (int u = bid; u < NU; u += G) {
        att::UnitDesc d; int h;
        if (u < 768) { const int x = u & 7, j = (u >> 3) & 31, i = u >> 8, pl = (i * 32 + j) >> 3, p = pl * 8 + x, b = p / 12, g = j & 7; h = p % 12; d.qrow0 = b * SEQ + g * 256; d.krow_ctx = NLAT + b * NCTX; d.krow_lat = b * SEQ;
                       d.lt0 = (g == 0) ? 0 : (g == 7 ? 24 : 4 * g - 4); d.nlt = (g == 0 || g == 7) ? 8 : 11; d.na = 1; }
        else { const int v = u - 768, b = v / 12; h = v % 12; d.qrow0 = NLAT + b * NCTX; d.krow_ctx = NLAT + b * NCTX; d.krow_lat = b * SEQ; d.lt0 = 0; d.nlt = 0; d.na = 0; }
        d.tq = 36 + h; d.tk = 48 + h; d.tv = 60 + h; d.cg = C_GB + h * 128; d.co = 1536 + h * 128;
        UNIT_TID(); att::attn_unit_na1p(P, QKV, MG, lds, tid, d, rpb_l + h * 465);
    }
    __syncthreads();
#undef UNIT_TID
}

__device__ __forceinline__ void ph_rglru(const bf16_t* __restrict__ P, const float* __restrict__ conv_w, const float* __restrict__ conv_b, const float* __restrict__ wa, const float* __restrict__ ba,
                                         const float* __restrict__ wx, const float* __restrict__ bx, const float* __restrict__ rlam, bf16_t* __restrict__ HH, LAS unsigned char* lds, int tid, int bid, int G) {
    using att::bf16x8; using att::f32x16;
    LAS float* U32 = (LAS float*)lds;
    LAS bf16_t* Ub = (LAS bf16_t*)(lds + 32768);
    LAS bf16_t* WTa = (LAS bf16_t*)(lds + 51200);
    LAS bf16_t* WTx = (LAS bf16_t*)(lds + 60416);
    LAS float* A_l = (LAS float*)(lds + 69632);
    LAS float* XP = (LAS float*)(lds + 102400);
    LAS float* XH = XP + 512;
    LAS float* CR = XH + 512;
    const int wid = __builtin_amdgcn_readfirstlane(tid >> 6), lane = tid & 63, r32 = lane & 31, hi = lane >> 5, ch = lane, rt = wid >> 1, ct = wid & 1;
    for (int it = bid; it < 256; it += G) {
        const int d = it & 1, n = (it >> 1) & 15, b = it >> 5;
        __syncthreads();
        { const float* wa_ = wa + (size_t)((d * 16 + n) * 64) * 64; const float* wx_ = wx + (size_t)((d * 16 + n) * 64) * 64;
          for (int e = tid; e < 4096; e += 512) { const int i = e >> 6, j = e & 63; WTa[j * 72 + i] = (bf16_t)f2bf(wa_[e]); WTx[j * 72 + i] = (bf16_t)f2bf(wx_[e]); } }
        if (tid < 64) CR[tid] = 0.f;
        const int cch = n * 64 + 32 * ct + r32;
        const float bav = ba[d * 1024 + cch], bxv = bx[d * 1024 + cch], xl = -rlam[d * 1024 + cch], ey = __builtin_amdgcn_exp2f(xl * 1.4426950408889634f), spv = xl > 20.f ? xl : (ey < 0.01f ? ey * (1.f + ey * (-0.5f + ey * 0.33333334f)) : __builtin_amdgcn_logf(1.f + ey) * 0.6931471805599453f);
        const float cw0 = conv_w[n * 64 + ch], cw1 = conv_w[1024 + n * 64 + ch], cw2 = conv_w[2048 + n * 64 + ch], cw3 = conv_w[3072 + n * 64 + ch], cbv = conv_b[n * 64 + ch];
        unsigned short xr[19];
#define RG_GEOM(cc_) const bool isctx = (cc_) < 2; const int nch = isctx ? 2 : 16, ci = isctx ? (cc_) : (cc_) - 2, c = d ? nch - 1 - ci : ci; \
            const int len = isctx ? NCTX : SEQ, rowbase = isctx ? NLAT + b * NCTX : b * SEQ, t0 = c * 128
#define RG_LOADX(cc_) do { RG_GEOM(cc_); const int tb = t0 + 16 * wid; _Pragma("unroll") for (int k = 0; k < 19; ++k) { const int t = tb + k - 2; \
            xr[k] = (t >= 0 && t < len) ? P[(size_t)(rowbase + t) * INW + C_XC + n * 64 + ch] : (unsigned short)0; } } while (0)
        RG_LOADX(0);
        for (int cc = 0; cc < 18; ++cc) {
            RG_GEOM(cc); (void)len;
            {
                float xv[19];
#pragma unroll
                for (int k = 0; k < 19; ++k) xv[k] = bf2f(xr[k]);
                if (cc + 1 < 18) RG_LOADX(cc + 1);
#pragma unroll
                for (int i = 0; i < 16; ++i) { const float u = cbv + cw0 * xv[i] + cw1 * xv[i + 1] + cw2 * xv[i + 2] + cw3 * xv[i + 3];
                    U32[(16 * wid + i) * 64 + ch] = u; Ub[(16 * wid + i) * 72 + ch] = (bf16_t)f2bf(u); }
            }
            __syncthreads();
            {
                f32x16 pr = {}, pi = {};
#pragma unroll
                for (int kk = 0; kk < 4; ++kk) {
                    const bf16x8 af = *reinterpret_cast<const LAS bf16x8*>(Ub + (32 * rt + r32) * 72 + kk * 16 + hi * 8);
                    const bf16x8 wf = *reinterpret_cast<const LAS bf16x8*>(WTa + (32 * ct + r32) * 72 + kk * 16 + hi * 8);
                    const bf16x8 xf = *reinterpret_cast<const LAS bf16x8*>(WTx + (32 * ct + r32) * 72 + kk * 16 + hi * 8);
                    pr = __builtin_amdgcn_mfma_f32_32x32x16_bf16(af, wf, pr, 0, 0, 0);
                    pi = __builtin_amdgcn_mfma_f32_32x32x16_bf16(af, xf, pi, 0, 0, 0); }
#pragma unroll
                for (int r = 0; r < 16; ++r) { const int idx = (32 * rt + att::crow(r, hi)) * 64 + 32 * ct + r32; const float u = U32[idx];
                    const float rg = __builtin_amdgcn_rcpf(1.f + __builtin_amdgcn_exp2f(-(pr[r] + bav) * 1.4426950408889634f)), ig = __builtin_amdgcn_rcpf(1.f + __builtin_amdgcn_exp2f(-(pi[r] + bxv) * 1.4426950408889634f));
                    const float la = -8.f * rg * spv, x2 = 2.f * la;
                    const float tay = x2 * (1.f + x2 * (0.5f + x2 * (0.16666667f + x2 * (0.041666668f + x2 * 0.0083333338f))));
                    const float em1 = (x2 > -0.125f) ? tay : (__builtin_amdgcn_exp2f(x2 * 1.4426950408889634f) - 1.f);
                    A_l[idx] = __builtin_amdgcn_exp2f(la * 1.4426950408889634f); U32[idx] = __builtin_amdgcn_sqrtf(-em1) * (ig * u); }
            }
            __syncthreads();
            {
                float av[16], bv[16]; float ap = 1.f, hl = 0.f;
#pragma unroll
                for (int s = 0; s < 16; ++s) { const int sd = 16 * wid + s, tl = d ? 127 - sd : sd; av[s] = A_l[tl * 64 + ch]; bv[s] = U32[tl * 64 + ch]; hl = av[s] * hl + bv[s]; ap *= av[s]; }
                XP[wid * 64 + ch] = ap; XH[wid * 64 + ch] = hl;
                __syncthreads();
                float h = CR[ch];
                for (int s2 = 0; s2 < wid; ++s2) h = XP[s2 * 64 + ch] * h + XH[s2 * 64 + ch];
#pragma unroll
                for (int s = 0; s < 16; ++s) { h = av[s] * h + bv[s]; const int sd = 16 * wid + s, tl = d ? 127 - sd : sd;
                    HH[((size_t)d * NROW + rowbase + t0 + tl) * 1024 + n * 64 + ch] = f2bf(h); }
                __syncthreads();
                if (wid == 7) CR[ch] = h;
            }
        }
    }
    __syncthreads();
#undef RG_GEOM
#undef RG_LOADX
}
__device__ __forceinline__ void ph_mergeC(const bf16_t* P, const bf16_t* HH, bf16_t* MG, int nrow, int tid, int bid, int G) {
    for (size_t gid = (size_t)bid * 512 + tid; gid < (size_t)nrow * 128; gid += (size_t)G * 512) {
        const int row = (int)(gid >> 7), ch = (int)(gid & 127) * 8;
        const v4u a = *(const v4u*)(HH + (size_t)row * 1024 + ch), c = *(const v4u*)(HH + ((size_t)NROW + row) * 1024 + ch);
        const v4u gq = *(const v4u*)(P + (size_t)row * INW + C_GC + ch);
#define MC_LO(x) __uint_as_float((x) << 16)
#define MC_HI(x) __uint_as_float((x) & 0xffff0000u)
        v4u o;
        o.x = pk2((MC_LO(a.x) + MC_LO(c.x)) * silu_f(MC_LO(gq.x)), (MC_HI(a.x) + MC_HI(c.x)) * silu_f(MC_HI(gq.x)));
        o.y = pk2((MC_LO(a.y) + MC_LO(c.y)) * silu_f(MC_LO(gq.y)), (MC_HI(a.y) + MC_HI(c.y)) * silu_f(MC_HI(gq.y)));
        o.z = pk2((MC_LO(a.z) + MC_LO(c.z)) * silu_f(MC_LO(gq.z)), (MC_HI(a.z) + MC_HI(c.z)) * silu_f(MC_HI(gq.z)));
        o.w = pk2((MC_LO(a.w) + MC_LO(c.w)) * silu_f(MC_LO(gq.w)), (MC_HI(a.w) + MC_HI(c.w)) * silu_f(MC_HI(gq.w)));
#undef MC_LO
#undef MC_HI
        *(v4u*)(MG + (size_t)row * DM + 3072 + ch) = o;
    }
}
__device__ __forceinline__ void ph_final(float* X, const bf16_t* X2, const float* w, int wave, int lane, int bid, int G) {
    const int gw = bid * 8 + wave, NGW = G * 8;
    for (int row = gw; row < NLAT; row += NGW) {
        f32x4* xr = (f32x4*)(X + (size_t)row * DM) + lane; const unsigned long long* x2 = (const unsigned long long*)(X2 + (size_t)row * DM) + lane; f32x4 v[16]; float s = 0.f;
#pragma unroll
        for (int j = 0; j < 16; ++j) { const unsigned long long q = x2[64 * j]; const unsigned lo = (unsigned)q, hi = (unsigned)(q >> 32);
            v[j] = (f32x4){__uint_as_float(lo << 16), __uint_as_float(lo & 0xffff0000u), __uint_as_float(hi << 16), __uint_as_float(hi & 0xffff0000u)};
            s += (v[j].x * v[j].x + v[j].y * v[j].y) + (v[j].z * v[j].z + v[j].w * v[j].w); }
        const float rstd = 1.f / sqrtf(wave_sum(s) * (1.f / DM) + 1e-6f);
#pragma unroll
        for (int j = 0; j < 16; ++j) xr[64 * j] = v[j] * rstd * ((const f32x4*)w)[lane + 64 * j];
    }
}

struct Args { const float* in[20]; float* out; unsigned char* ws; };
#define IDS() int t_; asm volatile("v_mbcnt_lo_u32_b32 %0, -1, 0\n\tv_mbcnt_hi_u32_b32 %0, -1, %0" : "=v"(t_)); t_ |= (wave0 << 6); const int ln_ = t_ & 63, wv_ = __builtin_amdgcn_readfirstlane(t_ >> 6); (void)ln_; (void)wv_; \
    int z_ = 0; asm volatile("" : "+v"(z_)); z_ = __builtin_amdgcn_readfirstlane(z_); \
    typedef __attribute__((address_space(4))) const Args CArgs; CArgs* A_ = (CArgs*)((__attribute__((address_space(4))) const char*)__builtin_amdgcn_kernarg_segment_ptr() + z_); unsigned char* ws = A_->ws; (void)ws
#define WSP(T, off) ((T*)(ws + (off)))
constexpr int TR_P0 = 0, TR_P1 = 12288;
#define TAIL_TRANSPOSE(nunits, lo, hi) do { const int first_idle_ = (nunits) - (((nunits) - 1) / G) * G, nidle_ = G - first_idle_; \
        if (nidle_ > 0 && bid >= first_idle_) { IDS(); ph_transpose(A_->in[7], A_->in[8], WSP(bf16_t, WS_WIN), WSP(bf16_t, WS_WOUT), lds, wv_, ln_, (lo), (hi), (bid - first_idle_) * 8 + wv_, nidle_ * 8); } \
        else if (nidle_ <= 0) { IDS(); ph_transpose(A_->in[7], A_->in[8], WSP(bf16_t, WS_WIN), WSP(bf16_t, WS_WOUT), lds, wv_, ln_, (lo), (hi), bid * 8 + wv_, G * 8); } } while (0)
template <int l> __device__ __forceinline__ void layer(const XcdBarrier& bar, LAS unsigned char* lds, int wave0, int bid, int G) {

        { IDS(); ph_norm<l != 0>(l == 0 ? (const void*)A_->in[0] : (const void*)WSP(bf16_t, WS_X1), A_->in[2], A_->in[6] + l * DM, WSP(float, WS_MOD) + (size_t)l * 9 * 12288, WSP(bf16_t, WS_HX), wv_, ln_, bid, G); }
        xcd_barrier(bar);
        { IDS(); pg8::Gemm g{WSP(bf16_t, WS_HX), WSP(bf16_t, WS_WIN) + (size_t)l * INW * DM, NROW, INW, DM, 0}; pg8::EpiP E{WSP(bf16_t, WS_P), INW, 0, WSP(float, WS_ROPE), WSP(bf16_t, WS_QKV)}; pg8::PrunedOrder S; S.init(l == 0 ? NROW : NLAT, INW, G, bid, l == 0 ? 0 : NB);
          pg8::gemm_phase<pg8::EpiP, pg8::PrunedOrder, true, true>(lds, g, S, E, wave0); }
        if constexpr (l == 0) { TAIL_TRANSPOSE((NROW / 256) * (INW / 256), TR_IL + TR_P0, TR_IL + TR_P1); }
        xcd_barrier(bar);
        { IDS(); ph_rglru(WSP(bf16_t, WS_P), A_->in[12] + l * 4096, A_->in[13] + l * 1024, A_->in[14] + (size_t)l * 2 * 16 * 4096, A_->in[15] + l * 2048, A_->in[16] + (size_t)l * 2 * 16 * 4096, A_->in[17] + l * 2048, A_->in[18] + l * 2048, WSP(bf16_t, WS_HH), lds, t_, bid, G); }
        { IDS(); ph_attn(WSP(bf16_t, WS_P), WSP(bf16_t, WS_QKV), WSP(bf16_t, WS_MG), A_->in[10] + l * 128, A_->in[11] + (size_t)l * 12 * 15 * 31, WSP(float, WS_LAM) + l, l == 0, lds, wave0, bid, G); }
        xcd_barrier(bar);
        { IDS(); ph_mergeC(WSP(bf16_t, WS_P), WSP(bf16_t, WS_HH), WSP(bf16_t, WS_MG), l == 0 ? NROW : NLAT, t_, bid, G); }
        xcd_barrier(bar);
        { IDS(); const int M = l == 0 ? NROW : NLAT; pg8::Gemm g{WSP(bf16_t, WS_MG), WSP(bf16_t, WS_WOUT) + (size_t)l * DM * DM, M, DM, DM, 0};
          pg8::EpiRes2<l != 0> E{l == 0 ? (const void*)A_->in[0] : (const void*)WSP(bf16_t, WS_X1), A_->in[2], l == 0 ? WSP(bf16_t, WS_X1) : WSP(bf16_t, WS_HX), WSP(float, WS_MOD) + (size_t)l * 9 * 12288 + 8192, NLAT, 0}; pg8::StaticOrder S; S.init(M, DM, G, bid);
          pg8::gemm_phase<pg8::EpiRes2<l != 0>, pg8::StaticOrder, true, true>(lds, g, S, E, wave0); }
        if constexpr (l == 0) { TAIL_TRANSPOSE((NROW / 256) * (DM / 256), TR_IL + TR_P1, 2 * TR_IL); }
        xcd_barrier(bar);
    }
__global__ void __launch_bounds__(512, 2) fwd(Args a) {
    extern __shared__ __attribute__((aligned(16))) unsigned char lds_raw[];
    LAS unsigned char* lds = (LAS unsigned char*)lds_raw;
    const int tid = threadIdx.x, G = gridDim.x, bid = blockIdx.x, wave0 = __builtin_amdgcn_readfirstlane(tid >> 6);
    volatile LAS unsigned* MISC = (volatile LAS unsigned*)(lds + MISC_OFF);
    if (tid < 32) MISC[tid] = 0u;
    __syncthreads();
    XcdBarrier bar = xcd_barrier_post((unsigned*)(a.ws + WS_CTL) + CW_BAR, MISC + 8);
    if (bid == 0) { IDS(); ph_small(A_->in[9], WSP(float, WS_ROPE), WSP(float, WS_LAM), t_); }
    { IDS(); ph_mod(A_->in[1], A_->in[3], A_->in[4], A_->in[5], WSP(float, WS_MOD), lds, t_, bid, G); }
    { IDS(); ph_transpose(A_->in[7], A_->in[8], WSP(bf16_t, WS_WIN), WSP(bf16_t, WS_WOUT), lds, wv_, ln_, 0, TR_IL + TR_P0, bid * 8 + wv_, G * 8); }
    xcd_barrier(bar);
    layer<0>(bar, lds, wave0, bid, G);
    layer<1>(bar, lds, wave0, bid, G);
    { IDS(); ph_final(A_->out, WSP(bf16_t, WS_HX), A_->in[19], wv_, ln_, bid, G); }
}

extern "C" void kernel_launch(void* const* d_in, const int* in_sizes, int n_in, void* d_out, int out_size, void* d_ws, size_t ws_size, hipStream_t stream) {
    static int grid = 0;
    if (grid == 0) {
        if (n_in != 20 || in_sizes[0] != NLAT * DM || out_size != NLAT * DM || ws_size < WS_END) { fprintf(stderr, "kernel_launch: shape/workspace mismatch: n_in %d in0 %d out %d ws %zu (need %zu)\n", n_in, n_in > 0 ? in_sizes[0] : -1, out_size, ws_size, (size_t)WS_END); grid = -1; return; }
        int dev = 0, cus = 0, per_cu = 0;
        if (hipGetDevice(&dev) != hipSuccess || hipDeviceGetAttribute(&cus, hipDeviceAttributeMultiprocessorCount, dev) != hipSuccess) { fprintf(stderr, "kernel_launch: device query failed\n"); grid = -1; return; }
        if (hipFuncSetAttribute((const void*)fwd, hipFuncAttributeMaxDynamicSharedMemorySize, LDS_BYTES) != hipSuccess) { fprintf(stderr, "kernel_launch: hipFuncSetAttribute failed\n"); grid = -1; return; }
        if (hipOccupancyMaxActiveBlocksPerMultiprocessor(&per_cu, (const void*)fwd, 512, LDS_BYTES) != hipSuccess || per_cu < 1) { fprintf(stderr, "kernel_launch: occupancy query says %d blocks per CU; nothing launched\n", per_cu); (void)hipGetLastError(); grid = -1; return; }
        grid = cus;
    }
    if (grid < 0) return;
    if (hipMemsetAsync((char*)d_ws + WS_CTL, 0, CTL_ZERO_BYTES, stream) != hipSuccess) { fprintf(stderr, "kernel_launch: memset failed\n"); return; }
    Args a{};
    for (int i = 0; i < 20; ++i) a.in[i] = (const float*)d_in[i];
    a.out = (float*)d_out; a.ws = (unsigned char*)d_ws;
    hipLaunchKernelGGL(fwd, dim3(grid), dim3(512), LDS_BYTES, stream, a);
    const hipError_t le = hipPeekAtLastError();
    if (le != hipSuccess) fprintf(stderr, "kernel_launch: launch failed: %s\n", hipGetErrorName(le));
}
```

```cpp
#include <hip/hip_runtime.h>
#include <cstdio>
#include <cstdint>
#include <cmath>
namespace pg8 {
#define PG8_LAS __attribute__((address_space(3)))
typedef unsigned short bf16_t;
typedef short bf16x8 __attribute__((ext_vector_type(8)));
typedef float f32x4 __attribute__((ext_vector_type(4)));
typedef unsigned u32x4 __attribute__((ext_vector_type(4)));
constexpr int BM = 256, BK = 64, HALF = 128, HTB = HALF * BK * 2  , STAGE_BYTES = 8 * HTB, NXCD = 8, WGM = 8;

__host__ __device__ __forceinline__ int lds_byte(int r, int c) { const int st = (r >> 4) * 2 + (c >> 5), rr = r & 15, cc = c & 31, ob = rr * 64 + cc * 2; return st * 1024 + (ob ^ (((ob >> 9) & 1) << 5)); }
__host__ __device__ __forceinline__ void stage_rc(int b, int& R, int& C) { const int st = b / 1024, sb = b % 1024, swz = sb ^ (((sb >> 9) & 1) << 5); R = (st >> 1) * 16 + swz / 64; C = (st & 1) * 32 + (swz % 64) / 2; }
__host__ __device__ __forceinline__ int perm32(int rho) { const int n = rho >> 4, i = rho & 15; return 8 * (i >> 2) + 4 * n + (i & 3); }

struct Unit { int pm, pn; };
struct Gemm { const bf16_t* A; const bf16_t* Bt; int M, N, K, pad; };

struct StaticOrder {
    int nM, nN, nwg, G, c;
    __host__ __device__ void init(int M, int N, int G_, int c_) { nM = M / BM; nN = N / BM; nwg = nM * nN; G = G_; c = c_; }
    __host__ __device__ bool next(int i, Unit& u) const {
        const long L = (long)i * G + c; if (L >= nwg) return false;
        int wgid = (int)L; { const int q = nwg / NXCD, r = nwg % NXCD, xcd = wgid % NXCD, off = wgid / NXCD; wgid = (xcd < r ? xcd * (q + 1) : r * (q + 1) + (xcd - r) * q) + off; }
        const int nig = WGM * nN, gid = wgid / nig, fm = gid * WGM, gsz = (nM - fm) < WGM ? (nM - fm) : WGM;
        u.pm = fm + ((wgid % nig) % gsz); u.pn = (wgid % nig) / gsz; return true;
    }
    __device__ __forceinline__ void a_ready(const Unit&) const {}
    __device__ __forceinline__ void done(const Unit&) const {}
};

struct PrunedOrder {
    StaticOrder S; int n_main, n_x;
    __host__ __device__ void init(int M_main, int N, int G_, int c_, int n_x_) { S.init(M_main, N, G_, c_); n_main = S.nwg; n_x = n_x_; }
    __host__ __device__ bool next(int i, Unit& u) const {
        const long L = (long)i * S.G + S.c;
        if (L < n_main) return S.next(i, u);
        const int k = (int)(L - n_main); if (k >= n_x * 28) return false;
        const int idx = k % 28; u.pm = S.nM + k / 28; u.pn = idx < 12 ? 6 + idx : (idx < 24 ? 30 + (idx - 12) : 48 + (idx - 24)); return true;
    }
    __device__ __forceinline__ void a_ready(const Unit&) const {}
    __device__ __forceinline__ void done(const Unit&) const {}
};
__device__ __forceinline__ unsigned cvt_pk_bf16(float lo, float hi) { unsigned r; asm volatile("v_cvt_pk_bf16_f32 %0, %1, %2" : "=v"(r) : "v"(lo), "v"(hi)); return r; }

struct EpiP {
    static constexpr bool PERM = true, AFTER_DRAIN = false; static constexpr int NVM = 16;
    bf16_t* O; int ldc, pad; const float* rope;
    bf16_t* QKV;
    __device__ __forceinline__ void operator()(const f32x4 (&acc)[2][2][4][2], const Unit& u, int wr, int wc, int fr_, int fq_) const {
        int lid; asm volatile("v_mbcnt_lo_u32_b32 %0, -1, 0\n\tv_mbcnt_hi_u32_b32 %0, -1, %0" : "=v"(lid)); const int fr = lid & 15, fq = lid >> 4;
        const int rowt = u.pm * BM, colt = u.pn * BM;
        const int row0 = rowt + wr * 64 + fr, col0 = colt + wc * 32 + 8 * fq;
        const bool do_rope = (rowt < 16384) && (colt < 3072);
        const bool hm = (colt < 4608) || (colt >= 6144 && colt < 10752); const int th0 = colt < 4608 ? colt / 128 : 36 + (colt - 6144) / 128; const size_t bjs = hm ? (size_t)18432 * 128 : (size_t)HALF;
        const float sgn = (fq < 2) ? -1.f : 1.f;
        const int ln = fr + 16 * fq, sfr = ln >> 2, sfq = ln & 3, ssrc = (sfr + 16 * sfq) * 4;
        const int srow0 = rowt + wr * 64 + sfr;
#pragma unroll
        for (int ai = 0; ai < 2; ++ai)
#pragma unroll
            for (int m = 0; m < 4; ++m) { const int row = row0 + ai * HALF + m * 16; const int srow = srow0 + ai * HALF + m * 16;
                bf16_t* rowp = hm ? QKV + ((size_t)th0 * 18432 + srow) * 128 + wc * 32 + 8 * sfq : O + (size_t)srow * ldc + colt + wc * 32 + 8 * sfq;
                f32x4 cs[4] = {};
                if (do_rope) { const int pos = (wc & 1) ? (row & 63) : ((row & 2047) >> 6); const f32x4* tp = (const f32x4*)(rope + (pos * 16 + 8 * (fq & 1)) * 2);
#pragma unroll
                    for (int e = 0; e < 4; ++e) cs[e] = tp[e]; }
#pragma unroll
                for (int bj = 0; bj < 2; ++bj) { f32x4 v0 = acc[ai][bj][m][0], v1 = acc[ai][bj][m][1];
                    if (do_rope) {
                        f32x4 o0, o1;
#pragma unroll
                        for (int e = 0; e < 4; ++e) { o0[e] = __shfl_xor(v0[e], 32); o1[e] = __shfl_xor(v1[e], 32); }
                        v0[0] = v0[0] * cs[0][0] + sgn * o0[0] * cs[0][1]; v0[1] = v0[1] * cs[0][2] + sgn * o0[1] * cs[0][3];
                        v0[2] = v0[2] * cs[1][0] + sgn * o0[2] * cs[1][1]; v0[3] = v0[3] * cs[1][2] + sgn * o0[3] * cs[1][3];
                        v1[0] = v1[0] * cs[2][0] + sgn * o1[0] * cs[2][1]; v1[1] = v1[1] * cs[2][2] + sgn * o1[1] * cs[2][3];
                        v1[2] = v1[2] * cs[3][0] + sgn * o1[2] * cs[3][1]; v1[3] = v1[3] * cs[3][2] + sgn * o1[3] * cs[3][3];
                    }
                    u32x4 w; w.x = cvt_pk_bf16(v0[0], v0[1]); w.y = cvt_pk_bf16(v0[2], v0[3]); w.z = cvt_pk_bf16(v1[0], v1[1]); w.w = cvt_pk_bf16(v1[2], v1[3]);
                    u32x4 ws; ws.x = (unsigned)__builtin_amdgcn_ds_bpermute(ssrc, (int)w.x); ws.y = (unsigned)__builtin_amdgcn_ds_bpermute(ssrc, (int)w.y);
                    ws.z = (unsigned)__builtin_amdgcn_ds_bpermute(ssrc, (int)w.z); ws.w = (unsigned)__builtin_amdgcn_ds_bpermute(ssrc, (int)w.w);
                    *(u32x4*)(rowp + bj * bjs) = ws; } }
    }
};
struct EpiRes {
    static constexpr bool PERM = false, AFTER_DRAIN = false; static constexpr int NVM = 32;
    const float* res_lat; const float* res_ctx; float* out_lat; float* out_ctx; const float* gate; int nlat, pad;
    __device__ __forceinline__ void operator()(const f32x4 (&acc)[2][2][4][2], const Unit& u, int wr, int wc, int fr_, int fq_) const {
        int lid; asm volatile("v_mbcnt_lo_u32_b32 %0, -1, 0\n\tv_mbcnt_hi_u32_b32 %0, -1, %0" : "=v"(lid)); const int fr = lid & 15, fq = lid >> 4;
        const int rowt = u.pm * BM; const bool isctx = rowt >= nlat; const int gr = isctx ? 8 : (rowt >> 11);
        const float* res = isctx ? res_ctx : res_lat; float* out = isctx ? out_ctx : out_lat;
        const int lrow0 = (isctx ? rowt - nlat : rowt) + wr * 64 + fr, col0 = u.pn * BM + wc * 32 + 4 * fq;
        f32x4 gv[2][2];
#pragma unroll
        for (int bj = 0; bj < 2; ++bj)
#pragma unroll
            for (int n = 0; n < 2; ++n) gv[bj][n] = *(const f32x4*)(gate + (size_t)gr * 12288 + col0 + bj * HALF + n * 16);
#pragma unroll
        for (int ai = 0; ai < 2; ++ai)
#pragma unroll
            for (int m = 0; m < 4; ++m) { const size_t off = (size_t)(lrow0 + ai * HALF + m * 16) * 4096 + col0;
#pragma unroll
                for (int bj = 0; bj < 2; ++bj)
#pragma unroll
                    for (int n = 0; n < 2; ++n) { const f32x4 rs = *(const f32x4*)(res + off + bj * HALF + n * 16);
                        *(f32x4*)(out + off + bj * HALF + n * 16) = rs + gv[bj][n] * acc[ai][bj][m][n]; } }
    }
};
template <bool RB> struct EpiRes2 {
    static constexpr bool PERM = true, AFTER_DRAIN = false; static constexpr int NVM = 0;
    const void* res_lat; const float* res_ctx; bf16_t* out; const float* gate; int nlat, pad;
    __device__ __forceinline__ void operator()(const f32x4 (&acc)[2][2][4][2], const Unit& u, int wr, int wc, int fr_, int fq_) const {
        int lid; asm volatile("v_mbcnt_lo_u32_b32 %0, -1, 0\n\tv_mbcnt_hi_u32_b32 %0, -1, %0" : "=v"(lid)); const int fr = lid & 15, fq = lid >> 4;
        const int rowt = u.pm * BM, colt = u.pn * BM; const bool isctx = rowt >= nlat; const int gr = isctx ? 8 : (rowt >> 11);
        const int col0 = colt + wc * 32 + 8 * fq, row0 = rowt + wr * 64 + fr;
        const int sfr = lid >> 2, sfq = lid & 3, ssrc = (sfr + 16 * sfq) * 4, srow0 = rowt + wr * 64 + sfr, scol0 = colt + wc * 32 + 8 * sfq;
#pragma unroll
        for (int bj = 0; bj < 2; ++bj) {
            const f32x4 g0 = *(const f32x4*)(gate + (size_t)gr * 12288 + col0 + bj * HALF), g1 = *(const f32x4*)(gate + (size_t)gr * 12288 + col0 + bj * HALF + 4);
#pragma unroll
            for (int ai = 0; ai < 2; ++ai)
#pragma unroll
                for (int m = 0; m < 4; ++m) { const int row = row0 + ai * HALF + m * 16, srow = srow0 + ai * HALF + m * 16; f32x4 r0, r1;
                    if constexpr (RB) { const u32x4 rb = *(const u32x4*)((const bf16_t*)res_lat + (size_t)row * 4096 + col0 + bj * HALF);
                        r0 = (f32x4){__uint_as_float(rb.x << 16), __uint_as_float(rb.x & 0xffff0000u), __uint_as_float(rb.y << 16), __uint_as_float(rb.y & 0xffff0000u)};
                        r1 = (f32x4){__uint_as_float(rb.z << 16), __uint_as_float(rb.z & 0xffff0000u), __uint_as_float(rb.w << 16), __uint_as_float(rb.w & 0xffff0000u)}; }
                    else { const float* rp = (isctx ? res_ctx + (size_t)(row - nlat) * 4096 : (const float*)res_lat + (size_t)row * 4096) + col0 + bj * HALF; r0 = *(const f32x4*)rp; r1 = *(const f32x4*)(rp + 4); }
                    const f32x4 v0 = r0 + g0 * acc[ai][bj][m][0], v1 = r1 + g1 * acc[ai][bj][m][1];
                    u32x4 w; w.x = cvt_pk_bf16(v0[0], v0[1]); w.y = cvt_pk_bf16(v0[2], v0[3]); w.z = cvt_pk_bf16(v1[0], v1[1]); w.w = cvt_pk_bf16(v1[2], v1[3]);
                    u32x4 ws; ws.x = (unsigned)__builtin_amdgcn_ds_bpermute(ssrc, (int)w.x); ws.y = (unsigned)__builtin_amdgcn_ds_bpermute(ssrc, (int)w.y);
                    ws.z = (unsigned)__builtin_amdgcn_ds_bpermute(ssrc, (int)w.z); ws.w = (unsigned)__builtin_amdgcn_ds_bpermute(ssrc, (int)w.w);
                    *(u32x4*)(out + (size_t)srow * 4096 + scol0 + bj * HALF) = ws;
                }
        }
    }
};
template <class Epi, class Sched, bool ALIGN_EPI = false, bool SP2 = false>
__device__ __forceinline__ void gemm_phase(PG8_LAS unsigned char* lds, const Gemm g, const Sched& S, const Epi& E, int wave0) {
    int tid; asm volatile("v_mbcnt_lo_u32_b32 %0, -1, 0\n\tv_mbcnt_hi_u32_b32 %0, -1, %0" : "=v"(tid)); tid |= (wave0 << 6);
    const int wid = __builtin_amdgcn_readfirstlane(tid >> 6), lane = tid & 63, wr = wid >> 2, wc = wid & 3, fr = lane & 15, fq = lane >> 4;
    const int K = g.K, nt = K / BK;
    unsigned voffA[2], voffB[2];
#pragma unroll
    for (int i = 0; i < 2; ++i) { int R, C; stage_rc(tid * 16 + i * 8192, R, C); const int Rb = Epi::PERM ? ((R & ~31) + perm32(R & 31)) : R;
        voffA[i] = (unsigned)(R * K + C) * 2u; voffB[i] = (unsigned)(Rb * K + C) * 2u; }
    const size_t kstep = (size_t)(BK * 2);
    const size_t hstep = (size_t)HALF * K * 2;
    const size_t tstep = 2 * hstep;
    const unsigned ldsw = (unsigned)wid * 1024u;
    const int aoff = lds_byte(wr * 64 + fr, fq * 8), boff = lds_byte(wc * 32 + fr, fq * 8);
#define PG8_SA(b, h) (((b) * 2 + (h)) * HTB)
#define PG8_SB(b, h) ((4 + (b) * 2 + (h)) * HTB)
#define PG8_STAGE(bufoff, gbase, voff) do { _Pragma("unroll") for (int _i = 0; _i < 2; ++_i) \
        __builtin_amdgcn_global_load_lds((const unsigned*)((const char*)(gbase) + (voff)[_i]), (PG8_LAS unsigned*)(lds + (bufoff) + ldsw + _i * 8192), 16, 0, 0); } while (0)
#define PG8_LDA(dst, b, h) do { _Pragma("unroll") for (int m = 0; m < 4; ++m) _Pragma("unroll") for (int k = 0; k < 2; ++k) dst[m][k] = *(const PG8_LAS bf16x8*)(lds + PG8_SA(b, h) + aoff + m * 2048 + k * 1024); } while (0)
#define PG8_LDB(dst, b, h) do { _Pragma("unroll") for (int n = 0; n < 2; ++n) _Pragma("unroll") for (int k = 0; k < 2; ++k) dst[n][k] = *(const PG8_LAS bf16x8*)(lds + PG8_SB(b, h) + boff + n * 2048 + k * 1024); } while (0)
#define PG8_MMA(ai, bj, At, Bt) do { __builtin_amdgcn_s_setprio(1); _Pragma("unroll") for (int m = 0; m < 4; ++m) _Pragma("unroll") for (int n = 0; n < 2; ++n) _Pragma("unroll") for (int k = 0; k < 2; ++k) \
        acc[ai][bj][m][n] = __builtin_amdgcn_mfma_f32_16x16x32_bf16(Bt[n][k], At[m][k], acc[ai][bj][m][n], 0, 0, 0); __builtin_amdgcn_s_setprio(0); } while (0)
#define PG8_WAIT_V(n) asm volatile("s_waitcnt vmcnt(" #n ")" ::: "memory")
#define PG8_WAIT_L(n) asm volatile("s_waitcnt lgkmcnt(" #n ")" ::: "memory")
#define PG8_BAR __builtin_amdgcn_s_barrier()
#define PG8_SCHED __builtin_amdgcn_sched_barrier(0)
    Unit cur, nxt; int ui = 0;
    if (!S.next(0, cur)) return;
    f32x4 acc[2][2][4][2];
#pragma unroll
    for (int a = 0; a < 2; ++a)
#pragma unroll
        for (int b = 0; b < 2; ++b)
#pragma unroll
            for (int m = 0; m < 4; ++m)
#pragma unroll
                for (int n = 0; n < 2; ++n) acc[a][b][m][n] = (f32x4){0.f, 0.f, 0.f, 0.f};
    bf16x8 At[4][2], B0[2][2], B1[2][2];
    const char* cA = (const char*)g.A + (size_t)cur.pm * tstep; const char* cB = (const char*)g.Bt + (size_t)cur.pn * tstep;
    S.a_ready(cur);
    {
        PG8_STAGE(PG8_SB(0, 0), cB, voffB); PG8_STAGE(PG8_SB(0, 1), cB + hstep, voffB); PG8_STAGE(PG8_SA(0, 0), cA, voffA); PG8_STAGE(PG8_SA(0, 1), cA + hstep, voffA);
        PG8_STAGE(PG8_SB(1, 0), cB + kstep, voffB); PG8_STAGE(PG8_SA(1, 0), cA + kstep, voffA); PG8_STAGE(PG8_SB(1, 1), cB + hstep + kstep, voffB); PG8_STAGE(PG8_SA(1, 1), cA + hstep + kstep, voffA);
        if (wr == 1) PG8_BAR;
        PG8_WAIT_V(0); PG8_BAR; PG8_BAR;
    }
    for (;;) {
        const bool has_next = S.next(ui + 1, nxt);
        const char* nA = has_next ? (const char*)g.A + (size_t)nxt.pm * tstep : cA; const char* nB = has_next ? (const char*)g.Bt + (size_t)nxt.pn * tstep : cB;
#define PG8_ITER(t, W, L2) do { \
            const bool last = (L2) && ((t) == nt - 2); \
            const char* a1 = cA + (size_t)((t) + 1) * kstep; \
            const char* a2 = last ? nA : cA + (size_t)((t) + 2) * kstep; const char* b2 = last ? nB : cB + (size_t)((t) + 2) * kstep; \
            const char* a3 = a2 + kstep; const char* b3 = b2 + kstep; \
            if (last && has_next) S.a_ready(nxt); \
            PG8_LDB(B0, 0, 0); PG8_LDB(B1, 0, 1); PG8_SCHED; PG8_LDA(At, 0, 0); if (L2) PG8_STAGE(PG8_SA(1, 1), a1 + hstep, voffA); \
            PG8_WAIT_V(W); PG8_WAIT_L(0); PG8_BAR; PG8_MMA(0, 0, At, B0); PG8_MMA(0, 1, At, B1); PG8_BAR; PG8_SCHED; \
            PG8_LDA(At, 0, 1); PG8_STAGE(PG8_SB(0, 0), b2, voffB); PG8_STAGE(PG8_SB(0, 1), b2 + hstep, voffB); PG8_STAGE(PG8_SA(0, 0), a2, voffA); \
            PG8_WAIT_V(W); PG8_WAIT_L(0); PG8_BAR; PG8_MMA(1, 0, At, B0); PG8_MMA(1, 1, At, B1); PG8_BAR; PG8_SCHED; \
            PG8_LDB(B0, 1, 0); PG8_LDB(B1, 1, 1); PG8_SCHED; PG8_LDA(At, 1, 0); PG8_STAGE(PG8_SA(0, 1), a2 + hstep, voffA); \
            PG8_WAIT_V(W); PG8_WAIT_L(0); PG8_BAR; PG8_MMA(0, 0, At, B0); PG8_MMA(0, 1, At, B1); PG8_BAR; PG8_SCHED; \
            PG8_LDA(At, 1, 1); PG8_STAGE(PG8_SB(1, 0), b3, voffB); PG8_STAGE(PG8_SB(1, 1), b3 + hstep, voffB); PG8_STAGE(PG8_SA(1, 0), a3, voffA); \
            PG8_WAIT_V(8); PG8_WAIT_L(0); PG8_BAR; PG8_MMA(1, 0, At, B0); PG8_MMA(1, 1, At, B1); PG8_BAR; PG8_SCHED; } while (0)
        static_assert(SP2, "only the super-phase schedule is kept");
        if constexpr (Epi::NVM == 16) PG8_ITER(0, 24, 0); else if constexpr (Epi::NVM == 32) PG8_ITER(0, 40, 0);
        for (int t = (Epi::NVM ? 2 : 0); t < nt; t += 2) PG8_ITER(t, 8, 1);
        if constexpr (Epi::NVM != 0) { if (has_next) PG8_STAGE(PG8_SA(1, 1), nA + kstep + hstep, voffA); }
        if constexpr (ALIGN_EPI) { if (wr == 0) PG8_BAR; }
        if constexpr (!Epi::AFTER_DRAIN) { E(acc, cur, wr, wc, fr, fq); S.done(cur); }
        if (!has_next) break;
#pragma unroll
        for (int a = 0; a < 2; ++a)
#pragma unroll
            for (int b = 0; b < 2; ++b)
#pragma unroll
                for (int m = 0; m < 4; ++m)
#pragma unroll
                    for (int n = 0; n < 2; ++n) acc[a][b][m][n] = (f32x4){0.f, 0.f, 0.f, 0.f};
        cur = nxt; cA = nA; cB = nB; ++ui;
        if constexpr (ALIGN_EPI) { if (wr == 1) PG8_BAR; }
    }
    PG8_WAIT_V(0);
    if constexpr (!ALIGN_EPI) { if (wr == 0) PG8_BAR; }
    PG8_BAR;
    if constexpr (Epi::AFTER_DRAIN) { E.fused(acc, cur, wr, wc, fr, fq, lds, wid, lane); S.done(cur); }
#undef PG8_SA
#undef PG8_SB
#undef PG8_STAGE
#undef PG8_LDA
#undef PG8_LDB
#undef PG8_MMA
#undef PG8_WAIT_V
#undef PG8_WAIT_L
#undef PG8_BAR
#undef PG8_SCHED
#undef PG8_ITER
}
}

constexpr int DM = 4096, NB = 8, SEQ = 2048, NCTX = 256, INW = 14336, NLAT = NB * SEQ, NROW = NLAT + NB * NCTX;
constexpr int HEADS = 12;
constexpr int C_QA = 0, C_KA = 1536, C_VA = 3072, C_GA = 4608, C_QB = 6144, C_KB = 7680, C_VB = 9216, C_GB = 10752, C_XC = 12288, C_GC = 13312;
constexpr size_t MiB = 1u << 20;
constexpr size_t WS_CTL = 0, WS_MOD = 1 * MiB, WS_ROPE = 2 * MiB, WS_LAM = 2 * MiB + 65536, WS_WIN = 4 * MiB, WS_WOUT = 228 * MiB, WS_HX = 292 * MiB, WS_P = 436 * MiB,
                 WS_MG = 940 * MiB, WS_CTXRES = 1084 * MiB, WS_HH = 1116 * MiB, WS_QKV = 1260 * MiB, WS_X1 = 1584 * MiB  , WS_END = 1728 * MiB;
constexpr size_t CTL_ZERO_BYTES = 1 * MiB;
constexpr int CW_BAR = 4096;
typedef unsigned short bf16_t;
typedef float f32x4 __attribute__((ext_vector_type(4)));
#define GAS __attribute__((address_space(1)))
typedef unsigned v4u __attribute__((ext_vector_type(4)));
#define LDS_WAIT() asm volatile("s_waitcnt lgkmcnt(0)" ::: "memory")

__device__ __forceinline__ float bf2f(bf16_t b) { return __uint_as_float(((unsigned)b) << 16); }
__device__ __forceinline__ unsigned f2bf(float f) { unsigned u = __float_as_uint(f); return (u + 0x7fffu + ((u >> 16) & 1u)) >> 16; }
__device__ __forceinline__ unsigned pk2(float lo, float hi) { return f2bf(lo) | (f2bf(hi) << 16); }
__device__ __forceinline__ float wave_sum(float v) {
#pragma unroll
    for (int o = 1; o < 64; o <<= 1) v += __shfl_xor(v, o);
    return v;
}
__device__ __forceinline__ float wave_max(float v) {
#pragma unroll
    for (int o = 1; o < 64; o <<= 1) v = fmaxf(v, __shfl_xor(v, o));
    return v;
}
__device__ __forceinline__ float silu_f(float v) { return v / (1.f + expf(-v)); }
__device__ __forceinline__ float sigmoid_f(float v) { return 1.f / (1.f + expf(-v)); }
__device__ __forceinline__ float silu_fast(float v) { return v * __builtin_amdgcn_rcpf(1.f + __builtin_amdgcn_exp2f(-1.4426950408889634f * v)); }
__device__ __forceinline__ float silu_e2(float v) { return v / (1.f + __builtin_amdgcn_exp2f(-1.4426950408889634f * v)); }
#define XB_TMO      128
#define XB_XCNT(j)  (256  + 64 * (j))
#define XB_XSUB(j)  (1280 + 64 * (j))
#define XB_XGEN(j)  (2304 + 64 * (j))
#define XB_TOP      3328
#define XB_TOPGEN   3392
#define XCD_BAR_WORDS 3456
#define XB_SPIN_CAP (1u << 18)
#define LAS __attribute__((address_space(3)))

__device__ __forceinline__ unsigned xb_ld(unsigned* p)              { return __hip_atomic_load(p, __ATOMIC_RELAXED, __HIP_MEMORY_SCOPE_AGENT); }
__device__ __forceinline__ unsigned xb_add(unsigned* p, unsigned v) { return __hip_atomic_fetch_add(p, v, __ATOMIC_RELAXED, __HIP_MEMORY_SCOPE_AGENT); }
__device__ __forceinline__ unsigned xb_xcc_id() { return (unsigned)__builtin_amdgcn_s_getreg((3 << 11) | 20) & 0xFu; }
#define XB_SPIN(cond, bar) do { unsigned _sp = 0; while (cond) { __builtin_amdgcn_s_sleep(1); \
    if ((++_sp & 255u) == 0u) { if (xb_ld(&(bar)[XB_TMO])) break; if (_sp > XB_SPIN_CAP) { atomicAdd(&(bar)[XB_TMO], 1u); break; } } } } while (0)

struct XcdBarrier {
    unsigned* bar; unsigned x;
    volatile LAS unsigned* st;
};

__device__ __forceinline__ XcdBarrier xcd_barrier_post(unsigned* bar, volatile LAS unsigned* st) {
    XcdBarrier b; b.bar = bar; b.x = xb_xcc_id(); b.st = st;
    if (threadIdx.x == 0) (void)xb_add(&bar[XB_XCNT(b.x)], 1u);
    return b;
}
__device__ __forceinline__ void xcd_barrier_complete(unsigned* bar, unsigned x, unsigned& nloc, unsigned& nx) {
    const unsigned G = gridDim.x * gridDim.y * gridDim.z;
    unsigned sum, cnt, mine, sp = 0u;
    for (;;) {
        sum = 0u; cnt = 0u; mine = 0u;
#pragma unroll
        for (unsigned j = 0; j < 16; ++j) { const unsigned c = xb_ld(&bar[XB_XCNT(j)]); sum += c; cnt += (c > 0u) ? 1u : 0u; mine = (j == x) ? c : mine; }
        if (sum == G) break;
        __builtin_amdgcn_s_sleep(1);
        if ((++sp & 255u) == 0u) { if (xb_ld(&bar[XB_TMO])) break; if (sp > XB_SPIN_CAP) { atomicAdd(&bar[XB_TMO], 1u); break; } }
    }
    nloc = mine > 0u ? mine : 1u; nx = cnt > 0u ? cnt : 1u;
}

__device__ __forceinline__ void xcd_barrier(const XcdBarrier& b) {
    asm volatile("s_waitcnt vmcnt(0)" ::: "memory");
    __syncthreads();
    if (threadIdx.x == 0) {
        unsigned* bar = b.bar;
        __builtin_amdgcn_s_waitcnt(0);
        unsigned nloc = b.st[0], nx = b.st[1];
        if (nloc == 0u) { xcd_barrier_complete(bar, b.x, nloc, nx); b.st[0] = nloc; b.st[1] = nx; }
        const unsigned old = xb_add(&bar[XB_XSUB(b.x)], 1u);
        const unsigned gen = old / nloc;
        if (old + 1u == (gen + 1u) * nloc) {
            __builtin_amdgcn_fence(__ATOMIC_RELEASE, "agent");
            asm volatile("s_waitcnt vmcnt(0)" ::: "memory");
            const unsigned og = xb_add(&bar[XB_TOP], 1u);
            const unsigned tg = og / nx;
            if (og + 1u == (tg + 1u) * nx) xb_add(&bar[XB_TOPGEN], 1u);
            else XB_SPIN(xb_ld(&bar[XB_TOPGEN]) == tg, bar);
            __builtin_amdgcn_fence(__ATOMIC_ACQUIRE, "agent");
            xb_add(&bar[XB_XGEN(b.x)], 1u);
            asm volatile("s_waitcnt vmcnt(0)" ::: "memory");
        } else {
            XB_SPIN(xb_ld(&bar[XB_XGEN(b.x)]) == gen, bar);
            __builtin_amdgcn_fence(__ATOMIC_ACQUIRE, "agent");
            asm volatile("s_waitcnt vmcnt(0)" ::: "memory");
        }
    }
    __syncthreads();
}
#define LAS __attribute__((address_space(3)))
constexpr int RING_BYTES = 131072, MISC_OFF = 143360, LDS_BYTES = 147456;

__device__ __forceinline__ void p0_transpose_item(const float* W, int K, int N, bf16_t* WT, int row_off, LAS float* scr, int item, int lane) {
    const int nblk = N / 32, kb = item / nblk, nb = item % nblk, k0 = 64 * kb, n0 = 32 * nb;
    float v[32];
#pragma unroll
    for (int i = 0; i < 32; ++i) v[i] = W[(size_t)(k0 + 2 * i + (lane >> 5)) * N + n0 + (lane & 31)];
#pragma unroll
    for (int i = 0; i < 32; ++i) scr[(2 * i + (lane >> 5)) * 33 + (lane & 31)] = v[i];
    LDS_WAIT(); asm volatile("" ::: "memory");
    const int c = lane & 7;
#pragma unroll
    for (int j = 0; j < 4; ++j) { const int n = (lane >> 3) + 8 * j; const LAS float* s = scr + (8 * c) * 33 + n;
        v4u o; o.x = pk2(s[0 * 33], s[1 * 33]); o.y = pk2(s[2 * 33], s[3 * 33]); o.z = pk2(s[4 * 33], s[5 * 33]); o.w = pk2(s[6 * 33], s[7 * 33]);
        *(GAS v4u*)(WT + (size_t)(row_off + n0 + n) * K + k0 + 8 * c) = o; }
    LDS_WAIT(); asm volatile("" ::: "memory");
}
constexpr int TR_IL = (DM / 64) * (INW / 32) + (DM / 64) * (DM / 32);
__device__ __forceinline__ void ph_transpose(const float* w_in, const float* w_out, bf16_t* WinT, bf16_t* WoutT, LAS unsigned char* lds, int wave, int lane, int lo, int hi, int gw, int NGW) {
    LAS float* scr = (LAS float*)lds + wave * 64 * 33;
    constexpr int I_IN = (DM / 64) * (INW / 32), I_OUT = (DM / 64) * (DM / 32), I_L = I_IN + I_OUT;
    for (int it = lo + gw; it < hi; it += NGW) {
        const int l = it / I_L, r = it % I_L;
        if (r < I_IN) p0_transpose_item(w_in + (size_t)l * DM * INW, DM, INW, WinT + (size_t)l * INW * DM, 0, scr, r, lane);
        else p0_transpose_item(w_out + (size_t)l * DM * DM, DM, DM, WoutT + (size_t)l * DM * DM, 0, scr, r - I_IN, lane);
    }
}
__device__ __forceinline__ void ph_small(const float* lambda_qk, float* rope, float* lam, int tid) {
    for (int i = tid; i < 1024; i += 512) { const int pos = i >> 4, f = i & 15; const float fr = exp2f(-(float)f * (13.287712379549449f / 16.f)), ang = (float)pos * fr; float sn, cs; sincosf(ang, &sn, &cs); rope[2 * i] = cs; rope[2 * i + 1] = sn; }
    if (tid < 2) { const float* lq = lambda_qk + tid * 256; float s01 = 0.f, s23 = 0.f; for (int d = 0; d < 64; ++d) { s01 += lq[d] * lq[64 + d]; s23 += lq[128 + d] * lq[192 + d]; }
        const float lam_init = 0.8f - 0.6f * expf(-0.3f * (float)tid); lam[tid] = expf(s01) - expf(s23) + lam_init; lam[2 + tid] = 1.f - lam_init; }
}
__device__ __forceinline__ void ph_mod(const float* c, const float* c_ctx, const float* ada_w, const float* ada_b, float* mod, LAS unsigned char* lds, int tid, int bid, int G) {
    LAS float* sl = (LAS float*)lds; LAS float* red = (LAS float*)(lds + 9 * 1024 * 4);
    const int kg = tid >> 5, cj = tid & 31;
    for (int item = bid; item < 2 * 128; item += G) {
        const int l = item / 128, j0 = (item % 128) * 96;
        float acc[3][9];
#pragma unroll
        for (int cc = 0; cc < 3; ++cc)
#pragma unroll
            for (int r = 0; r < 9; ++r) acc[cc][r] = 0.f;
        const float* W = ada_w + (size_t)l * DM * 12288 + j0 + cj;
        for (int ch = 0; ch < 4; ++ch) {
            __syncthreads();
            for (int idx = tid; idx < 9 * 1024; idx += 512) { const int r = idx >> 10, kk = idx & 1023; const float v = (r < 8) ? c[r * DM + ch * 1024 + kk] : c_ctx[ch * 1024 + kk]; sl[idx] = silu_f(v); }
            __syncthreads();
#pragma unroll 1
            for (int i0 = 0; i0 < 64; i0 += 8) { float w[3][8]; const int kb = kg * 64 + i0;
#pragma unroll
                for (int u = 0; u < 8; ++u)
#pragma unroll
                    for (int cc = 0; cc < 3; ++cc) w[cc][u] = W[(size_t)(ch * 1024 + kb + u) * 12288 + 32 * cc];
#pragma unroll
                for (int r = 0; r < 9; ++r)
#pragma unroll
                    for (int q = 0; q < 2; ++q) { const f32x4 s4 = *(const LAS f32x4*)(sl + r * 1024 + kb + 4 * q);
#pragma unroll
                        for (int cc = 0; cc < 3; ++cc) acc[cc][r] += (s4.x * w[cc][4 * q] + s4.y * w[cc][4 * q + 1]) + (s4.z * w[cc][4 * q + 2] + s4.w * w[cc][4 * q + 3]); } }
        }
#pragma unroll
        for (int cc = 0; cc < 3; ++cc)
#pragma unroll
            for (int r = 0; r < 9; ++r) red[(kg * 27 + cc * 9 + r) * 32 + cj] = acc[cc][r];
        __syncthreads();
        for (int o = tid; o < 27 * 32; o += 512) { const int c9 = o >> 5, c2 = o & 31, cc = c9 / 9, r = c9 % 9; float s = ada_b[l * 12288 + j0 + 32 * cc + c2];
            for (int g = 0; g < 16; ++g) s += red[(g * 27 + c9) * 32 + c2];
            mod[(size_t)(l * 9 + r) * 12288 + j0 + 32 * cc + c2] = s; }
    }
    __syncthreads();
}
template <bool BF> __device__ __forceinline__ void ph_norm(const void* xlat, const float* xctx, const float* norm_w, const float* mod, bf16_t* HX, int wave, int lane, int bid, int G) {
    const int gw = bid * 8 + wave, NGW = G * 8;
    for (int row = gw; row < NROW; row += NGW) {
        const bool isctx = row >= NLAT; const int r = isctx ? 8 : (row >> 11);
        f32x4 v[16]; float s = 0.f;
        if constexpr (BF) { const unsigned long long* xr = (const unsigned long long*)((const bf16_t*)xlat + (size_t)row * DM) + lane;
#pragma unroll
            for (int j = 0; j < 16; ++j) { const unsigned long long q = xr[64 * j]; const unsigned lo = (unsigned)q, hi = (unsigned)(q >> 32);
                v[j] = (f32x4){__uint_as_float(lo << 16), __uint_as_float(lo & 0xffff0000u), __uint_as_float(hi << 16), __uint_as_float(hi & 0xffff0000u)}; }
        } else { const f32x4* xr = (const f32x4*)(isctx ? xctx + (size_t)(row - NLAT) * DM : (const float*)xlat + (size_t)row * DM) + lane;
#pragma unroll
            for (int j = 0; j < 16; ++j) v[j] = xr[64 * j]; }
#pragma unroll
        for (int j = 0; j < 16; ++j) s += (v[j].x * v[j].x + v[j].y * v[j].y) + (v[j].z * v[j].z + v[j].w * v[j].w);
        const float rstd = 1.f / sqrtf(wave_sum(s) * (1.f / DM) + 1e-6f);
        const f32x4* nw = (const f32x4*)norm_w + lane; const f32x4* sh = (const f32x4*)(mod + (size_t)r * 12288) + lane; const f32x4* sc = (const f32x4*)(mod + (size_t)r * 12288 + 4096) + lane;
        unsigned long long* o8 = (unsigned long long*)(HX + (size_t)row * DM) + lane;
#pragma unroll
        for (int j = 0; j < 16; ++j) { const f32x4 w = nw[64 * j], a = sc[64 * j], b = sh[64 * j]; const f32x4 y = v[j] * rstd * w; const f32x4 o = y * (a + 1.f) + b;
            o8[64 * j] = (unsigned long long)pk2(o.x, o.y) | ((unsigned long long)pk2(o.z, o.w) << 32); }
    }
}
namespace att {
using bf16x8 = __attribute__((ext_vector_type(8))) short;
using s16x4  = __attribute__((ext_vector_type(4))) short;
using f32x16 = __attribute__((ext_vector_type(16))) float;
using u32x4  = __attribute__((ext_vector_type(4))) unsigned;
constexpr int SHM_V = 16384, SHM_K = 16384, OFF_K = 2 * SHM_V, OFF_BIAS = OFF_K + 2 * SHM_K, ATT_LDS = OFF_BIAS + 2048;
#define KSWZ(row, colB) ((row) * 256 + ((colB) ^ (((row) & 7) << 4)))
#define SBAR() __builtin_amdgcn_sched_barrier(0)
__device__ __forceinline__ int crow(int r, int hi) { return (r & 3) + 8 * (r >> 2) + 4 * hi; }
__device__ __forceinline__ unsigned cvtpk(float lo, float hi) { unsigned r; asm("v_cvt_pk_bf16_f32 %0, %1, %2" : "=v"(r) : "v"(lo), "v"(hi)); return r; }
__device__ __forceinline__ int v_st(int k, int c) { const int kk = (k & ~0xC) | ((k & 4) << 1) | ((k & 8) >> 1); return ((kk >> 3) * 4 + (c >> 5)) * 512 + ((kk & 7) * 32 + (c & 31)) * 2; }
__device__ __forceinline__ int v_rd_base(int lane) { return ((lane & 3) << 3) | (((lane >> 2) & 3) << 6) | (((lane >> 4) & 1) << 5) | (((lane >> 5) & 1) << 8); }
constexpr int v_rd_off(int d0, int ks, int half) { return d0 * 512 + ks * 4096 + half * 2048; }
template <int OFF> __device__ __forceinline__ s16x4 tr_read(int vb) { return __builtin_amdgcn_ds_read_tr16_b64_v4i16((LAS s16x4*)(unsigned)(vb + OFF)); }
template <int D0> __device__ __forceinline__ void pv_one(f32x16& od, int vb, bf16x8 pa0, bf16x8 pa1, bf16x8 pa2, bf16x8 pa3) {
  s16x4 l0 = tr_read<v_rd_off(D0, 0, 0)>(vb), h0 = tr_read<v_rd_off(D0, 0, 1)>(vb), l1 = tr_read<v_rd_off(D0, 1, 0)>(vb), h1 = tr_read<v_rd_off(D0, 1, 1)>(vb);
  s16x4 l2 = tr_read<v_rd_off(D0, 2, 0)>(vb), h2 = tr_read<v_rd_off(D0, 2, 1)>(vb), l3 = tr_read<v_rd_off(D0, 3, 0)>(vb), h3 = tr_read<v_rd_off(D0, 3, 1)>(vb);
#define PK(L, H) (bf16x8){L[0], L[1], L[2], L[3], H[0], H[1], H[2], H[3]}
  od = __builtin_amdgcn_mfma_f32_32x32x16_bf16(pa0, PK(l0, h0), od, 0, 0, 0);
  od = __builtin_amdgcn_mfma_f32_32x32x16_bf16(pa1, PK(l1, h1), od, 0, 0, 0);
  od = __builtin_amdgcn_mfma_f32_32x32x16_bf16(pa2, PK(l2, h2), od, 0, 0, 0);
  od = __builtin_amdgcn_mfma_f32_32x32x16_bf16(pa3, PK(l3, h3), od, 0, 0, 0);
#undef PK
}
__device__ __forceinline__ void pv_d0(f32x16* o, int vb, bf16x8 pa0, bf16x8 pa1, bf16x8 pa2, bf16x8 pa3) {
  pv_one<0>(o[0], vb, pa0, pa1, pa2, pa3); pv_one<1>(o[1], vb, pa0, pa1, pa2, pa3); pv_one<2>(o[2], vb, pa0, pa1, pa2, pa3); pv_one<3>(o[3], vb, pa0, pa1, pa2, pa3);
}
#define PK4(P, BASE, OUT) do { unsigned a0 = cvtpk(P[BASE + 0], P[BASE + 1]), a1 = cvtpk(P[BASE + 2], P[BASE + 3]);   \
    unsigned b0 = cvtpk(P[BASE + 4], P[BASE + 5]), b1 = cvtpk(P[BASE + 6], P[BASE + 7]);                              \
    auto r0 = __builtin_amdgcn_permlane32_swap(a0, b0, false, false); auto r1 = __builtin_amdgcn_permlane32_swap(a1, b1, false, false); \
    u32x4 w = {r0[0], r1[0], r0[1], r1[1]}; OUT = *reinterpret_cast<bf16x8*>(&w); } while (0)
template <int D_LO, int D_HI> __device__ __forceinline__ void qkt(f32x16& x0, f32x16& x1, const LAS unsigned char* Ks, const bf16x8* qr, int r32, int hi) {
  x0 = f32x16{}; x1 = f32x16{};
#pragma unroll
  for (int d0 = D_LO; d0 < D_HI; ++d0) { const int cb = (d0 * 16 + hi * 8) * 2;
    const bf16x8 b0 = *reinterpret_cast<const LAS bf16x8*>(Ks + KSWZ(r32, cb));
    const bf16x8 b1 = *reinterpret_cast<const LAS bf16x8*>(Ks + KSWZ(32 + r32, cb));
    x0 = __builtin_amdgcn_mfma_f32_32x32x16_bf16(b0, qr[d0], x0, 0, 0, 0);
    x1 = __builtin_amdgcn_mfma_f32_32x32x16_bf16(b1, qr[d0], x1, 0, 0, 0); }
}
struct UnitDesc {
  int qrow0;
  int krow_ctx;
  int krow_lat;
  int lt0, nlt;
  int tq, tk, tv;
  int cg, co;
  int na;
};
constexpr float LOG2E = 1.4426950408889634f;
template <bool DIFF>
__device__ __forceinline__ void attn_unit(const bf16_t* __restrict__ P, const bf16_t* __restrict__ QKV, bf16_t* __restrict__ MG, LAS unsigned char* lds, int tid, const UnitDesc u,
                                          float lam, float oml, const float* __restrict__ subln_w, const float* __restrict__ rpb_h) {
  asm volatile("" : "+v"(tid));
  const int wid = __builtin_amdgcn_readfirstlane(tid >> 6), lane = tid & 63, r32 = lane & 31, hi = lane >> 5;
  LAS unsigned char* V_lds = lds; LAS unsigned char* K_lds = lds + OFF_K; LAS float* bias_l = (LAS float*)(lds + OFF_BIAS);
  constexpr float CS = (DIFF ? 0.125f : 0.08838834764831845f) * LOG2E;
  bf16x8 qr[8];
  { const bf16_t* Qw = QKV + ((size_t)u.tq * NROW + u.qrow0 + wid * 32 + r32) * 128 + hi * 8;
#pragma unroll
    for (int d0 = 0; d0 < 8; ++d0) qr[d0] = *reinterpret_cast<const bf16x8*>(Qw + d0 * 16); }
  const int grow = ((u.qrow0 & 2047) >> 6) + (wid >> 1), cqx = 32 * (wid & 1) + r32;
  const int r0 = min(max(grow - 4, 0), 24), c0 = min(max(cqx - 8, 0), 48);
  if (!DIFF && u.na) { __syncthreads(); if (tid < 465) bias_l[tid] = rpb_h[tid] * LOG2E; }
  const int sr = tid >> 4, sc = (tid & 15) * 8, vst0 = v_st(sr, sc), vst1 = v_st(32 + sr, sc), kst0 = KSWZ(sr, sc * 2), kst1 = KSWZ(32 + sr, sc * 2);
  const int vb0 = (int)(uintptr_t)V_lds + v_rd_base(lane);
  const int NT = 4 + u.nlt;
  bf16x8 ks0, ks1, vs0, vs1;
#define TROW(j) ((j) < 4 ? u.krow_ctx + 64 * (j) : u.krow_lat + 64 * (u.lt0 + (j) - 4))
#define KLOAD(j) do { const bf16_t* kp_ = QKV + ((size_t)u.tk * NROW + TROW(j) + sr) * 128 + sc; ks0 = *reinterpret_cast<const bf16x8*>(kp_); ks1 = *reinterpret_cast<const bf16x8*>(kp_ + 32 * 128); } while (0)
#define VLOAD(j) do { const bf16_t* vp_ = QKV + ((size_t)u.tv * NROW + TROW(j) + sr) * 128 + sc; vs0 = *reinterpret_cast<const bf16x8*>(vp_); vs1 = *reinterpret_cast<const bf16x8*>(vp_ + 32 * 128); } while (0)
#define KWRITE(b) do { *reinterpret_cast<LAS bf16x8*>(K_lds + (b) * SHM_K + kst0) = ks0; *reinterpret_cast<LAS bf16x8*>(K_lds + (b) * SHM_K + kst1) = ks1; } while (0)
#define VWRITE(b) do { *reinterpret_cast<LAS bf16x8*>(V_lds + (b) * SHM_V + vst0) = vs0; *reinterpret_cast<LAS bf16x8*>(V_lds + (b) * SHM_V + vst1) = vs1; } while (0)
#define NA_FIX(X0, X1, j) do { if (!DIFF && u.na && (j) >= 4) { const int R_ = u.lt0 + (j) - 4; const int bb_ = (R_ - grow + 7) * 31 + 15 - cqx; \
    _Pragma("unroll") for (int r = 0; r < 16; ++r) { const int ck0_ = crow(r, hi), ck1_ = 32 + ck0_; \
      const bool v0_ = (ck0_ >= c0) && (ck0_ < c0 + 16), v1_ = (ck1_ >= c0) && (ck1_ < c0 + 16); \
      const float b0_ = bias_l[v0_ ? bb_ + ck0_ : 0], b1_ = bias_l[v1_ ? bb_ + ck1_ : 0]; \
      X0[r] = v0_ ? X0[r] * CS + b0_ : -1e30f; X1[r] = v1_ ? X1[r] * CS + b1_ : -1e30f; } } \
    else { _Pragma("unroll") for (int r = 0; r < 16; ++r) { X0[r] *= CS; X1[r] *= CS; } } } while (0)
#define PART(j) (DIFF || !u.na || (j) < 4 || ((u.lt0 + (j) - 4) >= r0 && (u.lt0 + (j) - 4) < r0 + 8))
  float m0 = -1e30f, l0 = 0.f, m1 = -1e30f, l1 = 0.f;
  __syncthreads();
  KLOAD(0); KWRITE(0);
  __syncthreads();
  for (int j = 0; j < NT; ++j) {
    const LAS unsigned char* Kb = K_lds + (j & 1) * SHM_K;
    if (j + 1 < NT) KLOAD(j + 1);
    if (PART(j)) {
      f32x16 sx0, sx1;
      if (DIFF) {
        qkt<0, 4>(sx0, sx1, Kb, qr, r32, hi);
        { float tm = -1e30f;
#pragma unroll
          for (int r = 0; r < 16; ++r) { sx0[r] *= CS; sx1[r] *= CS; tm = fmaxf(tm, fmaxf(sx0[r], sx1[r])); }
          const float mn = fmaxf(m0, tm); float s = 0.f;
#pragma unroll
          for (int r = 0; r < 16; ++r) s += __builtin_amdgcn_exp2f(sx0[r] - mn) + __builtin_amdgcn_exp2f(sx1[r] - mn);
          l0 = l0 * __builtin_amdgcn_exp2f(m0 - mn) + s; m0 = mn; }
        qkt<4, 8>(sx0, sx1, Kb, qr, r32, hi);
        { float tm = -1e30f;
#pragma unroll
          for (int r = 0; r < 16; ++r) { sx0[r] *= CS; sx1[r] *= CS; tm = fmaxf(tm, fmaxf(sx0[r], sx1[r])); }
          const float mn = fmaxf(m1, tm); float s = 0.f;
#pragma unroll
          for (int r = 0; r < 16; ++r) s += __builtin_amdgcn_exp2f(sx0[r] - mn) + __builtin_amdgcn_exp2f(sx1[r] - mn);
          l1 = l1 * __builtin_amdgcn_exp2f(m1 - mn) + s; m1 = mn; }
      } else {
        qkt<0, 8>(sx0, sx1, Kb, qr, r32, hi);
        NA_FIX(sx0, sx1, j);
        float tm = -1e30f;
#pragma unroll
        for (int r = 0; r < 16; ++r) tm = fmaxf(tm, fmaxf(sx0[r], sx1[r]));
        const float mn = fmaxf(m0, tm); float s = 0.f;
#pragma unroll
        for (int r = 0; r < 16; ++r) s += __builtin_amdgcn_exp2f(sx0[r] - mn) + __builtin_amdgcn_exp2f(sx1[r] - mn);
        l0 = l0 * __builtin_amdgcn_exp2f(m0 - mn) + s; m0 = mn;
      }
    }
    if (j + 1 < NT) KWRITE((j + 1) & 1);
    __syncthreads();
  }
  float K0, K1 = 0.f, c1 = 0.f;
  { const float mo = __shfl_xor(m0, 32), lo = __shfl_xor(l0, 32), M = fmaxf(m0, mo), L = l0 * __builtin_amdgcn_exp2f(m0 - M) + lo * __builtin_amdgcn_exp2f(mo - M); K0 = M + __builtin_amdgcn_logf(L); }
  if (DIFF) { const float mo = __shfl_xor(m1, 32), lo = __shfl_xor(l1, 32), M = fmaxf(m1, mo), L = l1 * __builtin_amdgcn_exp2f(m1 - M) + lo * __builtin_amdgcn_exp2f(mo - M); K1 = M; c1 = lam * __builtin_amdgcn_rcpf(L); }
  f32x16 o[4] = {};
  KLOAD(0); VLOAD(0); KWRITE(0); VWRITE(0);
  __syncthreads();
  for (int j = 0; j < NT; ++j) {
    const LAS unsigned char* Kb = K_lds + (j & 1) * SHM_K;
    if (j + 1 < NT) { KLOAD(j + 1); VLOAD(j + 1); }
    if (PART(j)) {
      f32x16 sx0, sx1; bf16x8 pa0, pa1, pa2, pa3;
      if (DIFF) {
        f32x16 sy0, sy1;
        qkt<0, 4>(sx0, sx1, Kb, qr, r32, hi);
        qkt<4, 8>(sy0, sy1, Kb, qr, r32, hi);
#pragma unroll
        for (int r = 0; r < 16; ++r) {
          const float e0 = __builtin_amdgcn_exp2f(sx0[r] * CS - K0), e1 = __builtin_amdgcn_exp2f(sx1[r] * CS - K0);
          const float f0 = __builtin_amdgcn_exp2f(sy0[r] * CS - K1), f1 = __builtin_amdgcn_exp2f(sy1[r] * CS - K1);
          sx0[r] = e0 - c1 * f0; sx1[r] = e1 - c1 * f1; }
      } else {
        qkt<0, 8>(sx0, sx1, Kb, qr, r32, hi);
        NA_FIX(sx0, sx1, j);
#pragma unroll
        for (int r = 0; r < 16; ++r) { sx0[r] = __builtin_amdgcn_exp2f(sx0[r] - K0); sx1[r] = __builtin_amdgcn_exp2f(sx1[r] - K0); }
      }
      PK4(sx0, 0, pa0); PK4(sx0, 8, pa1); PK4(sx1, 0, pa2); PK4(sx1, 8, pa3);
      pv_d0(o, vb0 + (j & 1) * SHM_V, pa0, pa1, pa2, pa3);
    }
    if (j + 1 < NT) { KWRITE((j + 1) & 1); VWRITE((j + 1) & 1); }
    __syncthreads();
  }
  const int orow0 = u.qrow0 + wid * 32;
  float sw[4];
#pragma unroll
  for (int d0 = 0; d0 < 4; ++d0) sw[d0] = DIFF ? subln_w[32 * d0 + r32] * oml : 1.f;
#pragma unroll
  for (int r = 0; r < 16; ++r) {
    const int row = orow0 + crow(r, hi);
    float rn = 1.f;
    if (DIFF) { float ss = (o[0][r] * o[0][r] + o[1][r] * o[1][r]) + (o[2][r] * o[2][r] + o[3][r] * o[3][r]);
      ss += __shfl_xor(ss, 1); ss += __shfl_xor(ss, 2); ss += __shfl_xor(ss, 4); ss += __shfl_xor(ss, 8); ss += __shfl_xor(ss, 16);
      rn = __builtin_amdgcn_rsqf(ss * (1.f / 128.f) + 1e-5f); }
#pragma unroll
    for (int d0 = 0; d0 < 4; ++d0) {
      const float g = bf2f(P[(size_t)row * INW + u.cg + 32 * d0 + r32]);
      MG[(size_t)row * DM + u.co + 32 * d0 + r32] = (bf16_t)f2bf(o[d0][r] * rn * sw[d0] * silu_e2(g)); }
  }
#undef TROW
#undef KLOAD
#undef VLOAD
#undef KWRITE
#undef VWRITE
#undef NA_FIX
#undef PART
}

constexpr float DIFF_THR = 8.f;
__device__ __forceinline__ void attn_unit_diff1p(const bf16_t* __restrict__ P, const bf16_t* __restrict__ QKV, bf16_t* __restrict__ MG, LAS unsigned char* lds, int tid, const UnitDesc u,
                                                 const float* __restrict__ lamp, const float* __restrict__ subln_w) {
  asm volatile("" : "+v"(tid));
  const int wid = __builtin_amdgcn_readfirstlane(tid >> 6), lane = tid & 63, r32 = lane & 31, hi = lane >> 5, sub = wid & 1, rb = wid >> 1;
  LAS unsigned char* V_lds = lds; LAS unsigned char* K_lds = lds + 2 * SHM_V;
  LAS float* sc_l = (LAS float*)(lds + 4 * SHM_V) + wid * 64;
  constexpr float CS = 0.125f * LOG2E;
  bf16x8 qr[2][4];
#pragma unroll
  for (int a_ = 0; a_ < 2; ++a_) { const bf16_t* Qw = QKV + ((size_t)u.tq * NROW + u.qrow0 + rb * 64 + a_ * 32 + r32) * 128 + sub * 64 + hi * 8;
#pragma unroll
    for (int d = 0; d < 4; ++d) qr[a_][d] = *reinterpret_cast<const bf16x8*>(Qw + d * 16); }
  const int vb0 = (int)(uintptr_t)V_lds + v_rd_base(lane);
  const int NT = 4 + u.nlt;
  unsigned gk[2], gv[2];
#pragma unroll
  for (int i = 0; i < 2; ++i) { const int q = 64 * wid + 512 * i + lane, row = q >> 4, cx_ = (q & 15) ^ (row & 7); gk[i] = (unsigned)(row * 128 + cx_ * 8) * 2u;
    const int st = q >> 5, kk = 8 * (st >> 2) + ((q & 31) >> 2), c = 32 * (st & 3) + 8 * (q & 3), k = (kk & ~0xC) | ((kk & 4) << 1) | ((kk & 8) >> 1); gv[i] = (unsigned)(k * 128 + c) * 2u; }
#define TROW(j) ((j) < 4 ? u.krow_ctx + 64 * (j) : u.krow_lat + 64 * (u.lt0 + (j) - 4))
#define KVDMA(j, b) do { const char* kb_ = (const char*)(QKV + ((size_t)u.tk * NROW + TROW(j)) * 128); const char* vb_ = (const char*)(QKV + ((size_t)u.tv * NROW + TROW(j)) * 128); _Pragma("unroll") for (int i = 0; i < 2; ++i) { \
    __builtin_amdgcn_global_load_lds((const unsigned*)(kb_ + gk[i]), (LAS unsigned*)(K_lds + (b) * SHM_K + wid * 1024 + i * 8192), 16, 0, 0); \
    __builtin_amdgcn_global_load_lds((const unsigned*)(vb_ + gv[i]), (LAS unsigned*)(V_lds + (b) * SHM_V + wid * 1024 + i * 8192), 16, 0, 0); } } while (0)
#define DMA_WAIT_BAR() do { asm volatile("s_waitcnt vmcnt(0)" ::: "memory"); __syncthreads(); } while (0)
  f32x16 o[2][4] = {};
  float mrun[2] = {-1e30f, -1e30f}, lsum[2] = {0.f, 0.f};
  __syncthreads();
  KVDMA(0, 0);
  DMA_WAIT_BAR();
  for (int j = 0; j < NT; ++j) {
    if (j + 1 < NT) KVDMA(j + 1, (j + 1) & 1);
    const LAS unsigned char* Kb = K_lds + (j & 1) * SHM_K;
    const int vb = vb0 + (j & 1) * SHM_V;
#pragma unroll
    for (int hf = 0; hf < 2; ++hf) {
      f32x16 s0 = {}, s1 = {};
#pragma unroll
      for (int d = 0; d < 4; ++d) { const bf16x8 kf = *reinterpret_cast<const LAS bf16x8*>(Kb + KSWZ(32 * hf + r32, sub * 128 + (d * 16 + hi * 8) * 2));
        s0 = __builtin_amdgcn_mfma_f32_32x32x16_bf16(kf, qr[0][d], s0, 0, 0, 0);
        s1 = __builtin_amdgcn_mfma_f32_32x32x16_bf16(kf, qr[1][d], s1, 0, 0, 0); }
      bf16x8 pl0, ph0, pl1, ph1;
#define SOFTMAX(S, A, PL, PH) do { float tm_ = S[0]; _Pragma("unroll") for (int r = 1; r < 16; ++r) tm_ = fmaxf(tm_, S[r]); tm_ *= CS; \
      { const auto sw_ = __builtin_amdgcn_permlane32_swap(__float_as_uint(tm_), __float_as_uint(tm_), false, false); tm_ = fmaxf(__uint_as_float(sw_[0]), __uint_as_float(sw_[1])); } \
      if (__builtin_expect(__any(tm_ > mrun[A] + DIFF_THR), 0)) { const float mn_ = fmaxf(mrun[A], tm_), al_ = __builtin_amdgcn_exp2f(mrun[A] - mn_); mrun[A] = mn_; lsum[A] *= al_; \
        if (hi == 0) sc_l[r32] = al_; asm volatile("s_waitcnt lgkmcnt(0)" ::: "memory"); \
        _Pragma("unroll") for (int rq = 0; rq < 4; ++rq) { _Pragma("unroll") for (int ri = 0; ri < 4; ++ri) { const float f_ = sc_l[crow(4 * rq + ri, hi)]; _Pragma("unroll") for (int d0 = 0; d0 < 4; ++d0) o[A][d0][4 * rq + ri] *= f_; } \
          asm volatile("" ::: "memory"); } } \
      { const float nm_ = -mrun[A]; float su_ = 0.f; _Pragma("unroll") for (int r = 0; r < 16; ++r) { S[r] = __builtin_amdgcn_exp2f(fmaf(S[r], CS, nm_)); su_ += S[r]; } lsum[A] += su_; } \
      PK4(S, 0, PL); PK4(S, 8, PH); } while (0)
      SOFTMAX(s0, 0, pl0, ph0);
      SOFTMAX(s1, 1, pl1, ph1);
#pragma unroll
      for (int d0 = 0; d0 < 4; ++d0) {
        const s16x4 l0 = __builtin_amdgcn_ds_read_tr16_b64_v4i16((LAS s16x4*)(unsigned)(vb + d0 * 512 + (2 * hf) * 4096)), h0 = __builtin_amdgcn_ds_read_tr16_b64_v4i16((LAS s16x4*)(unsigned)(vb + d0 * 512 + (2 * hf) * 4096 + 2048));
        const s16x4 l1 = __builtin_amdgcn_ds_read_tr16_b64_v4i16((LAS s16x4*)(unsigned)(vb + d0 * 512 + (2 * hf + 1) * 4096)), h1 = __builtin_amdgcn_ds_read_tr16_b64_v4i16((LAS s16x4*)(unsigned)(vb + d0 * 512 + (2 * hf + 1) * 4096 + 2048));
        const bf16x8 v0 = (bf16x8){l0[0], l0[1], l0[2], l0[3], h0[0], h0[1], h0[2], h0[3]}, v1 = (bf16x8){l1[0], l1[1], l1[2], l1[3], h1[0], h1[1], h1[2], h1[3]};
        o[0][d0] = __builtin_amdgcn_mfma_f32_32x32x16_bf16(pl0, v0, o[0][d0], 0, 0, 0); o[1][d0] = __builtin_amdgcn_mfma_f32_32x32x16_bf16(pl1, v0, o[1][d0], 0, 0, 0);
        o[0][d0] = __builtin_amdgcn_mfma_f32_32x32x16_bf16(ph0, v1, o[0][d0], 0, 0, 0); o[1][d0] = __builtin_amdgcn_mfma_f32_32x32x16_bf16(ph1, v1, o[1][d0], 0, 0, 0);
      }
#undef SOFTMAX
    }
    DMA_WAIT_BAR();
  }
  const float lamv = sub ? lamp[0] : 1.f;
#pragma unroll
  for (int a_ = 0; a_ < 2; ++a_) { const float lt = lsum[a_] + __shfl_xor(lsum[a_], 32), f = lamv * __builtin_amdgcn_rcpf(lt);
    if (hi == 0) sc_l[r32] = f; asm volatile("s_waitcnt lgkmcnt(0)" ::: "memory");
#pragma unroll
    for (int rq = 0; rq < 4; ++rq) {
#pragma unroll
      for (int ri = 0; ri < 4; ++ri) { const float f_ = sc_l[crow(4 * rq + ri, hi)];
#pragma unroll
        for (int d0 = 0; d0 < 4; ++d0) o[a_][d0][4 * rq + ri] *= f_; }
      asm volatile("" ::: "memory"); }
    asm volatile("s_waitcnt lgkmcnt(0)" ::: "memory"); }
  LAS float* xs = (LAS float*)lds;
  __syncthreads();
#pragma unroll
  for (int d0 = 0; d0 < 4; ++d0)
#pragma unroll
    for (int r = 0; r < 16; ++r) xs[wid * 4096 + (d0 * 16 + r) * 64 + lane] = sub ? o[0][d0][r] : o[1][d0][r];
  __syncthreads();
  f32x16 fo[4];
#pragma unroll
  for (int d0 = 0; d0 < 4; ++d0)
#pragma unroll
    for (int r = 0; r < 16; ++r) { const float pv_ = xs[(wid ^ 1) * 4096 + (d0 * 16 + r) * 64 + lane]; fo[d0][r] = sub ? (pv_ - o[1][d0][r]) : (o[0][d0][r] - pv_); }
  __syncthreads();
  int tid2 = tid; asm volatile("" : "+v"(tid2));
  const int lane2 = tid2 & 63, c32 = lane2 & 31, h2 = lane2 >> 5;
  const int orow0 = u.qrow0 + rb * 64 + sub * 32;
  float sw[4]; const float oml = lamp[2];
#pragma unroll
  for (int d0 = 0; d0 < 4; ++d0) sw[d0] = subln_w[32 * d0 + c32] * oml;
#pragma unroll
  for (int r = 0; r < 16; ++r) {
    const int row = orow0 + crow(r, h2);
    float ss = (fo[0][r] * fo[0][r] + fo[1][r] * fo[1][r]) + (fo[2][r] * fo[2][r] + fo[3][r] * fo[3][r]);
    ss += __shfl_xor(ss, 1); ss += __shfl_xor(ss, 2); ss += __shfl_xor(ss, 4); ss += __shfl_xor(ss, 8); ss += __shfl_xor(ss, 16);
    const float rn = __builtin_amdgcn_rsqf(ss * (1.f / 128.f) + 1e-5f);
#pragma unroll
    for (int d0 = 0; d0 < 4; ++d0) {
      const float g = bf2f(P[(size_t)row * INW + u.cg + 32 * d0 + c32]);
      MG[(size_t)row * DM + u.co + 32 * d0 + c32] = (bf16_t)f2bf(fo[d0][r] * rn * sw[d0] * silu_e2(g)); }
  }
#undef TROW
#undef KVDMA
#undef DMA_WAIT_BAR
}

__device__ __forceinline__ void attn_unit_na1p(const bf16_t* __restrict__ P, const bf16_t* __restrict__ QKV, bf16_t* __restrict__ MG, LAS unsigned char* lds, int tid, const UnitDesc u,
                                               const float* __restrict__ rpb_h) {
  asm volatile("" : "+v"(tid));
  const int wid = __builtin_amdgcn_readfirstlane(tid >> 6), lane = tid & 63, r32 = lane & 31, hi = lane >> 5;
  LAS unsigned char* V_lds = lds; LAS unsigned char* K_lds = lds + 2 * SHM_V; LAS float* bias_l = (LAS float*)(lds + 4 * SHM_V);
  LAS float* sc_l = (LAS float*)(lds + 4 * SHM_V + 2048) + wid * 64;
  constexpr float CS = 0.08838834764831845f * LOG2E;
  bf16x8 qr[8];
  { const bf16_t* Qw = QKV + ((size_t)u.tq * NROW + u.qrow0 + wid * 32 + r32) * 128 + hi * 8;
#pragma unroll
    for (int d0 = 0; d0 < 8; ++d0) qr[d0] = *reinterpret_cast<const bf16x8*>(Qw + d0 * 16); }
  const int grow = ((u.qrow0 & 2047) >> 6) + (wid >> 1), cqx = 32 * (wid & 1) + r32;
  const int r0 = min(max(grow - 4, 0), 24), c0 = min(max(cqx - 8, 0), 48);
  const bool na = u.na != 0;
  __syncthreads();
  if (na && tid < 465) bias_l[tid] = rpb_h[tid] * LOG2E;
  const int vb0 = (int)(uintptr_t)V_lds + v_rd_base(lane);
  const int NT = 4 + u.nlt;
  unsigned gk[2], gv[2];
#pragma unroll
  for (int i = 0; i < 2; ++i) { const int q = 64 * wid + 512 * i + lane, row = q >> 4, cx_ = (q & 15) ^ (row & 7); gk[i] = (unsigned)(row * 128 + cx_ * 8) * 2u;
    const int st = q >> 5, kk = 8 * (st >> 2) + ((q & 31) >> 2), c = 32 * (st & 3) + 8 * (q & 3), k = (kk & ~0xC) | ((kk & 4) << 1) | ((kk & 8) >> 1); gv[i] = (unsigned)(k * 128 + c) * 2u; }
#define TROW(j) ((j) < 4 ? u.krow_ctx + 64 * (j) : u.krow_lat + 64 * (u.lt0 + (j) - 4))
#define KVDMA(j, b) do { const char* kb_ = (const char*)(QKV + ((size_t)u.tk * NROW + TROW(j)) * 128); const char* vb_ = (const char*)(QKV + ((size_t)u.tv * NROW + TROW(j)) * 128); _Pragma("unroll") for (int i = 0; i < 2; ++i) { \
    __builtin_amdgcn_global_load_lds((const unsigned*)(kb_ + gk[i]), (LAS unsigned*)(K_lds + (b) * SHM_K + wid * 1024 + i * 8192), 16, 0, 0); \
    __builtin_amdgcn_global_load_lds((const unsigned*)(vb_ + gv[i]), (LAS unsigned*)(V_lds + (b) * SHM_V + wid * 1024 + i * 8192), 16, 0, 0); } } while (0)
#define DMA_WAIT_BAR() do { asm volatile("s_waitcnt vmcnt(0)" ::: "memory"); __syncthreads(); } while (0)
  f32x16 o[4] = {};
  float mrun = -1e30f, lsum = 0.f;
  KVDMA(0, 0);
  DMA_WAIT_BAR();
  for (int j = 0; j < NT; ++j) {
    if (j + 1 < NT) KVDMA(j + 1, (j + 1) & 1);
    const int R = u.lt0 + j - 4;
    if (!na || j < 4 || (R >= r0 && R < r0 + 8)) {
      const LAS unsigned char* Kb = K_lds + (j & 1) * SHM_K; const int vb = vb0 + (j & 1) * SHM_V;
      f32x16 s0 = {}, s1 = {};
#pragma unroll
      for (int d0 = 0; d0 < 8; ++d0) { const int cb = (d0 * 16 + hi * 8) * 2;
        s0 = __builtin_amdgcn_mfma_f32_32x32x16_bf16(*reinterpret_cast<const LAS bf16x8*>(Kb + KSWZ(r32, cb)), qr[d0], s0, 0, 0, 0);
        s1 = __builtin_amdgcn_mfma_f32_32x32x16_bf16(*reinterpret_cast<const LAS bf16x8*>(Kb + KSWZ(32 + r32, cb)), qr[d0], s1, 0, 0, 0); }
      if (na && j >= 4) { const int bb = (R - grow + 7) * 31 + 15 - cqx;
#pragma unroll
        for (int r = 0; r < 16; ++r) { const int ck0 = crow(r, hi), ck1 = 32 + ck0; const bool v0 = (ck0 >= c0) && (ck0 < c0 + 16), v1 = (ck1 >= c0) && (ck1 < c0 + 16);
          const float b0 = bias_l[v0 ? bb + ck0 : 0], b1 = bias_l[v1 ? bb + ck1 : 0];
          s0[r] = v0 ? fmaf(s0[r], CS, b0) : -1e30f; s1[r] = v1 ? fmaf(s1[r], CS, b1) : -1e30f; } }
      else {
#pragma unroll
        for (int r = 0; r < 16; ++r) { s0[r] *= CS; s1[r] *= CS; } }
      float tm = s0[0];
#pragma unroll
      for (int r = 1; r < 16; ++r) tm = fmaxf(tm, s0[r]);
#pragma unroll
      for (int r = 0; r < 16; ++r) tm = fmaxf(tm, s1[r]);
      { const auto sw_ = __builtin_amdgcn_permlane32_swap(__float_as_uint(tm), __float_as_uint(tm), false, false); tm = fmaxf(__uint_as_float(sw_[0]), __uint_as_float(sw_[1])); }
      if (__builtin_expect(__any(tm > mrun + DIFF_THR), 0)) { const float mn = fmaxf(mrun, tm), al = __builtin_amdgcn_exp2f(mrun - mn); mrun = mn; lsum *= al;
        if (hi == 0) sc_l[r32] = al; asm volatile("s_waitcnt lgkmcnt(0)" ::: "memory");
#pragma unroll
        for (int rq = 0; rq < 4; ++rq) {
#pragma unroll
          for (int ri = 0; ri < 4; ++ri) { const float f_ = sc_l[crow(4 * rq + ri, hi)];
#pragma unroll
            for (int d0 = 0; d0 < 4; ++d0) o[d0][4 * rq + ri] *= f_; }
          asm volatile("" ::: "memory"); } }
      { float su = 0.f;
#pragma unroll
        for (int r = 0; r < 16; ++r) { s0[r] = __builtin_amdgcn_exp2f(s0[r] - mrun); s1[r] = __builtin_amdgcn_exp2f(s1[r] - mrun); su += s0[r] + s1[r]; }
        lsum += su; }
      bf16x8 pa0, pa1, pa2, pa3;
      PK4(s0, 0, pa0); PK4(s0, 8, pa1); PK4(s1, 0, pa2); PK4(s1, 8, pa3);
      pv_d0(o, vb, pa0, pa1, pa2, pa3);
    }
    DMA_WAIT_BAR();
  }
  { const float lt = lsum + __shfl_xor(lsum, 32), f = __builtin_amdgcn_rcpf(lt);
    if (hi == 0) sc_l[r32] = f; asm volatile("s_waitcnt lgkmcnt(0)" ::: "memory");
#pragma unroll
    for (int rq = 0; rq < 4; ++rq) {
#pragma unroll
      for (int ri = 0; ri < 4; ++ri) { const float f_ = sc_l[crow(4 * rq + ri, hi)];
#pragma unroll
        for (int d0 = 0; d0 < 4; ++d0) o[d0][4 * rq + ri] *= f_; }
      asm volatile("" ::: "memory"); } }
  int tid2 = tid; asm volatile("" : "+v"(tid2));
  const int lane2 = tid2 & 63, c32 = lane2 & 31, h2 = lane2 >> 5;
  const int orow0 = u.qrow0 + wid * 32;
#pragma unroll
  for (int r = 0; r < 16; ++r) {
    const int row = orow0 + crow(r, h2);
#pragma unroll
    for (int d0 = 0; d0 < 4; ++d0) {
      const float g = bf2f(P[(size_t)row * INW + u.cg + 32 * d0 + c32]);
      MG[(size_t)row * DM + u.co + 32 * d0 + c32] = (bf16_t)f2bf(o[d0][r] * silu_e2(g)); }
  }
#undef TROW
#undef KVDMA
#undef DMA_WAIT_BAR
}
}


__device__ __forceinline__ void ph_attn(const bf16_t* P, const bf16_t* QKV, bf16_t* MG, const float* subln_w, const float* rpb_l, const float* lamp, bool with_ctx, LAS unsigned char* lds, int wave0, int bid, int G) {
#define UNIT_TID() int tid; asm volatile("v_mbcnt_lo_u32_b32 %0, -1, 0\n\tv_mbcnt_hi_u32_b32 %0, -1, %0" : "=v"(tid)); tid |= (wave0 << 6)
    const int NU = with_ctx ? 864 : 768;
    for (int u = bid; u < NU; u += G) {
        att::UnitDesc d; int h;
        if (u < 768) { const int x = u & 7, j = (u >> 3) & 31, i = u >> 8, pl = (i * 32 + j) >> 3, p = pl * 8 + x, b = p / 12, qb = j & 7; h = p % 12;     d.qrow0 = b * SEQ + qb * 256; d.krow_ctx = NLAT + b * NCTX; d.krow_lat = b * SEQ; d.nlt = 32; }
        else { const int v = u - 768, b = v / 12; h = v % 12; d.qrow0 = NLAT + b * NCTX; d.krow_ctx = NLAT + b * NCTX; d.krow_lat = b * SEQ; d.nlt = 0; }
        d.lt0 = 0; d.tq = h; d.tk = 12 + h; d.tv = 24 + h; d.cg = C_GA + h * 128; d.co = h * 128; d.na = 0;
        UNIT_TID(); att::attn_unit_diff1p(P, QKV, MG, lds, tid, d, lamp, subln_w);
    }
    for (int u = bid; u < NU; u += G) {
        att::UnitDesc d; int h;
        if (u < 768) { const int x = u & 7, j = (u >> 3) & 31, i = u >> 8, pl = (i * 32 + j) >> 3, p = pl * 8 + x, b = p / 12, g = j & 7; h = p % 12; d.qrow0 = b * SEQ + g * 256; d.krow_ctx = NLAT + b * NCTX; d.krow_lat = b * SEQ;
                       d.lt0 = (g == 0) ? 0 : (g == 7 ? 24 : 4 * g - 4); d.nlt = (g == 0 || g == 7) ? 8 : 11; d.na = 1; }
        else { const int v = u - 768, b = v / 12; h = v % 12; d.qrow0 = NLAT + b * NCTX; d.krow_ctx = NLAT + b * NCTX; d.krow_lat = b * SEQ; d.lt0 = 0; d.nlt = 0; d.na = 0; }
        d.tq = 36 + h; d.tk = 48 + h; d.tv = 60 + h; d.cg = C_GB + h * 128; d.co = 1536 + h * 128;
        UNIT_TID(); att::attn_unit_na1p(P, QKV, MG, lds, tid, d, rpb_l + h * 465);
    }
    __syncthreads();
#undef UNIT_TID
}

__device__ __forceinline__ void ph_rglru(const bf16_t* __restrict__ P, const float* __restrict__ conv_w, const float* __restrict__ conv_b, const float* __restrict__ wa, const float* __restrict__ ba,
                                         const float* __restrict__ wx, const float* __restrict__ bx, const float* __restrict__ rlam, bf16_t* __restrict__ HH, LAS unsigned char* lds, int tid, int bid, int G) {
    using att::bf16x8; using att::f32x16;
    LAS float* U32 = (LAS float*)lds;
    LAS bf16_t* Ub = (LAS bf16_t*)(lds + 32768);
    LAS bf16_t* WTa = (LAS bf16_t*)(lds + 51200);
    LAS bf16_t* WTx = (LAS bf16_t*)(lds + 60416);
    LAS float* A_l = (LAS float*)(lds + 69632);
    LAS float* XP = (LAS float*)(lds + 102400);
    LAS float* XH = XP + 512;
    LAS float* CR = XH + 512;
    const int wid = __builtin_amdgcn_readfirstlane(tid >> 6), lane = tid & 63, r32 = lane & 31, hi = lane >> 5, ch = lane, rt = wid >> 1, ct = wid & 1;
    for (int it = bid; it < 256; it += G) {
        const int d = it & 1, n = (it >> 1) & 15, b = it >> 5;
        __syncthreads();
        { const float* wa_ = wa + (size_t)((d * 16 + n) * 64) * 64; const float* wx_ = wx + (size_t)((d * 16 + n) * 64) * 64;
          for (int e = tid; e < 4096; e += 512) { const int i = e >> 6, j = e & 63; WTa[j * 72 + i] = (bf16_t)f2bf(wa_[e]); WTx[j * 72 + i] = (bf16_t)f2bf(wx_[e]); } }
        if (tid < 64) CR[tid] = 0.f;
        const int cch = n * 64 + 32 * ct + r32;
        const float bav = ba[d * 1024 + cch], bxv = bx[d * 1024 + cch], xl = -rlam[d * 1024 + cch], ey = __builtin_amdgcn_exp2f(xl * 1.4426950408889634f), spv = xl > 20.f ? xl : (ey < 0.01f ? ey * (1.f + ey * (-0.5f + ey * 0.33333334f)) : __builtin_amdgcn_logf(1.f + ey) * 0.6931471805599453f);
        const float cw0 = conv_w[n * 64 + ch], cw1 = conv_w[1024 + n * 64 + ch], cw2 = conv_w[2048 + n * 64 + ch], cw3 = conv_w[3072 + n * 64 + ch], cbv = conv_b[n * 64 + ch];
        unsigned short xr[19];
#define RG_GEOM(cc_) const bool isctx = (cc_) < 2; const int nch = isctx ? 2 : 16, ci = isctx ? (cc_) : (cc_) - 2, c = d ? nch - 1 - ci : ci; \
            const int len = isctx ? NCTX : SEQ, rowbase = isctx ? NLAT + b * NCTX : b * SEQ, t0 = c * 128
#define RG_LOADX(cc_) do { RG_GEOM(cc_); const int tb = t0 + 16 * wid; _Pragma("unroll") for (int k = 0; k < 19; ++k) { const int t = tb + k - 2; \
            xr[k] = (t >= 0 && t < len) ? P[(size_t)(rowbase + t) * INW + C_XC + n * 64 + ch] : (unsigned short)0; } } while (0)
        RG_LOADX(0);
        for (int cc = 0; cc < 18; ++cc) {
            RG_GEOM(cc); (void)len;
            {
                float xv[19];
#pragma unroll
                for (int k = 0; k < 19; ++k) xv[k] = bf2f(xr[k]);
                if (cc + 1 < 18) RG_LOADX(cc + 1);
#pragma unroll
                for (int i = 0; i < 16; ++i) { const float u = cbv + cw0 * xv[i] + cw1 * xv[i + 1] + cw2 * xv[i + 2] + cw3 * xv[i + 3];
                    U32[(16 * wid + i) * 64 + ch] = u; Ub[(16 * wid + i) * 72 + ch] = (bf16_t)f2bf(u); }
            }
            __syncthreads();
            {
                f32x16 pr = {}, pi = {};
#pragma unroll
                for (int kk = 0; kk < 4; ++kk) {
                    const bf16x8 af = *reinterpret_cast<const LAS bf16x8*>(Ub + (32 * rt + r32) * 72 + kk * 16 + hi * 8);
                    const bf16x8 wf = *reinterpret_cast<const LAS bf16x8*>(WTa + (32 * ct + r32) * 72 + kk * 16 + hi * 8);
                    const bf16x8 xf = *reinterpret_cast<const LAS bf16x8*>(WTx + (32 * ct + r32) * 72 + kk * 16 + hi * 8);
                    pr = __builtin_amdgcn_mfma_f32_32x32x16_bf16(af, wf, pr, 0, 0, 0);
                    pi = __builtin_amdgcn_mfma_f32_32x32x16_bf16(af, xf, pi, 0, 0, 0); }
#pragma unroll
                for (int r = 0; r < 16; ++r) { const int idx = (32 * rt + att::crow(r, hi)) * 64 + 32 * ct + r32; const float u = U32[idx];
                    const float rg = __builtin_amdgcn_rcpf(1.f + __builtin_amdgcn_exp2f(-(pr[r] + bav) * 1.4426950408889634f)), ig = __builtin_amdgcn_rcpf(1.f + __builtin_amdgcn_exp2f(-(pi[r] + bxv) * 1.4426950408889634f));
                    const float la = -8.f * rg * spv, x2 = 2.f * la;
                    const float tay = x2 * (1.f + x2 * (0.5f + x2 * (0.16666667f + x2 * (0.041666668f + x2 * 0.0083333338f))));
                    const float em1 = (x2 > -0.125f) ? tay : (__builtin_amdgcn_exp2f(x2 * 1.4426950408889634f) - 1.f);
                    A_l[idx] = __builtin_amdgcn_exp2f(la * 1.4426950408889634f); U32[idx] = __builtin_amdgcn_sqrtf(-em1) * (ig * u); }
            }
            __syncthreads();
            {
                float av[16], bv[16]; float ap = 1.f, hl = 0.f;
#pragma unroll
                for (int s = 0; s < 16; ++s) { const int sd = 16 * wid + s, tl = d ? 127 - sd : sd; av[s] = A_l[tl * 64 + ch]; bv[s] = U32[tl * 64 + ch]; hl = av[s] * hl + bv[s]; ap *= av[s]; }
                XP[wid * 64 + ch] = ap; XH[wid * 64 + ch] = hl;
                __syncthreads();
                float h = CR[ch];
                for (int s2 = 0; s2 < wid; ++s2) h = XP[s2 * 64 + ch] * h + XH[s2 * 64 + ch];
#pragma unroll
                for (int s = 0; s < 16; ++s) { h = av[s] * h + bv[s]; const int sd = 16 * wid + s, tl = d ? 127 - sd : sd;
                    HH[((size_t)d * NROW + rowbase + t0 + tl) * 1024 + n * 64 + ch] = f2bf(h); }
                __syncthreads();
                if (wid == 7) CR[ch] = h;
            }
        }
    }
    __syncthreads();
#undef RG_GEOM
#undef RG_LOADX
}
__device__ __forceinline__ void ph_mergeC(const bf16_t* P, const bf16_t* HH, bf16_t* MG, int nrow, int tid, int bid, int G) {
    for (size_t gid = (size_t)bid * 512 + tid; gid < (size_t)nrow * 128; gid += (size_t)G * 512) {
        const int row = (int)(gid >> 7), ch = (int)(gid & 127) * 8;
        const v4u a = *(const v4u*)(HH + (size_t)row * 1024 + ch), c = *(const v4u*)(HH + ((size_t)NROW + row) * 1024 + ch);
        const v4u gq = *(const v4u*)(P + (size_t)row * INW + C_GC + ch);
#define MC_LO(x) __uint_as_float((x) << 16)
#define MC_HI(x) __uint_as_float((x) & 0xffff0000u)
        v4u o;
        o.x = pk2((MC_LO(a.x) + MC_LO(c.x)) * silu_f(MC_LO(gq.x)), (MC_HI(a.x) + MC_HI(c.x)) * silu_f(MC_HI(gq.x)));
        o.y = pk2((MC_LO(a.y) + MC_LO(c.y)) * silu_f(MC_LO(gq.y)), (MC_HI(a.y) + MC_HI(c.y)) * silu_f(MC_HI(gq.y)));
        o.z = pk2((MC_LO(a.z) + MC_LO(c.z)) * silu_f(MC_LO(gq.z)), (MC_HI(a.z) + MC_HI(c.z)) * silu_f(MC_HI(gq.z)));
        o.w = pk2((MC_LO(a.w) + MC_LO(c.w)) * silu_f(MC_LO(gq.w)), (MC_HI(a.w) + MC_HI(c.w)) * silu_f(MC_HI(gq.w)));
#undef MC_LO
#undef MC_HI
        *(v4u*)(MG + (size_t)row * DM + 3072 + ch) = o;
    }
}
__device__ __forceinline__ void ph_final(float* X, const bf16_t* X2, const float* w, int wave, int lane, int bid, int G) {
    const int gw = bid * 8 + wave, NGW = G * 8;
    for (int row = gw; row < NLAT; row += NGW) {
        f32x4* xr = (f32x4*)(X + (size_t)row * DM) + lane; const unsigned long long* x2 = (const unsigned long long*)(X2 + (size_t)row * DM) + lane; f32x4 v[16]; float s = 0.f;
#pragma unroll
        for (int j = 0; j < 16; ++j) { const unsigned long long q = x2[64 * j]; const unsigned lo = (unsigned)q, hi = (unsigned)(q >> 32);
            v[j] = (f32x4){__uint_as_float(lo << 16), __uint_as_float(lo & 0xffff0000u), __uint_as_float(hi << 16), __uint_as_float(hi & 0xffff0000u)};
            s += (v[j].x * v[j].x + v[j].y * v[j].y) + (v[j].z * v[j].z + v[j].w * v[j].w); }
        const float rstd = 1.f / sqrtf(wave_sum(s) * (1.f / DM) + 1e-6f);
#pragma unroll
        for (int j = 0; j < 16; ++j) xr[64 * j] = v[j] * rstd * ((const f32x4*)w)[lane + 64 * j];
    }
}

struct Args { const float* in[20]; float* out; unsigned char* ws; };
#define IDS() int t_; asm volatile("v_mbcnt_lo_u32_b32 %0, -1, 0\n\tv_mbcnt_hi_u32_b32 %0, -1, %0" : "=v"(t_)); t_ |= (wave0 << 6); const int ln_ = t_ & 63, wv_ = __builtin_amdgcn_readfirstlane(t_ >> 6); (void)ln_; (void)wv_; \
    int z_ = 0; asm volatile("" : "+v"(z_)); z_ = __builtin_amdgcn_readfirstlane(z_); \
    typedef __attribute__((address_space(4))) const Args CArgs; CArgs* A_ = (CArgs*)((__attribute__((address_space(4))) const char*)__builtin_amdgcn_kernarg_segment_ptr() + z_); unsigned char* ws = A_->ws; (void)ws
#define WSP(T, off) ((T*)(ws + (off)))
constexpr int TR_P0 = 7168, TR_P1 = 16384;
#define TAIL_TRANSPOSE(nunits, lo, hi) do { const int first_idle_ = (nunits) - (((nunits) - 1) / G) * G, nidle_ = G - first_idle_; \
        if (nidle_ > 0 && bid >= first_idle_) { IDS(); ph_transpose(A_->in[7], A_->in[8], WSP(bf16_t, WS_WIN), WSP(bf16_t, WS_WOUT), lds, wv_, ln_, (lo), (hi), (bid - first_idle_) * 8 + wv_, nidle_ * 8); } \
        else if (nidle_ <= 0) { IDS(); ph_transpose(A_->in[7], A_->in[8], WSP(bf16_t, WS_WIN), WSP(bf16_t, WS_WOUT), lds, wv_, ln_, (lo), (hi), bid * 8 + wv_, G * 8); } } while (0)
template <int l> __device__ __forceinline__ void layer(const XcdBarrier& bar, LAS unsigned char* lds, int wave0, int bid, int G) {

        { IDS(); ph_norm<l != 0>(l == 0 ? (const void*)A_->in[0] : (const void*)WSP(bf16_t, WS_X1), A_->in[2], A_->in[6] + l * DM, WSP(float, WS_MOD) + (size_t)l * 9 * 12288, WSP(bf16_t, WS_HX), wv_, ln_, bid, G); }
        xcd_barrier(bar);
        { IDS(); pg8::Gemm g{WSP(bf16_t, WS_HX), WSP(bf16_t, WS_WIN) + (size_t)l * INW * DM, NROW, INW, DM, 0}; pg8::EpiP E{WSP(bf16_t, WS_P), INW, 0, WSP(float, WS_ROPE), WSP(bf16_t, WS_QKV)}; pg8::PrunedOrder S; S.init(l == 0 ? NROW : NLAT, INW, G, bid, l == 0 ? 0 : NB);
          pg8::gemm_phase<pg8::EpiP, pg8::PrunedOrder, true, true>(lds, g, S, E, wave0); }
        if constexpr (l == 0) { TAIL_TRANSPOSE((NROW / 256) * (INW / 256), TR_IL + TR_P0, TR_IL + TR_P1); }
        xcd_barrier(bar);
        { IDS(); ph_rglru(WSP(bf16_t, WS_P), A_->in[12] + l * 4096, A_->in[13] + l * 1024, A_->in[14] + (size_t)l * 2 * 16 * 4096, A_->in[15] + l * 2048, A_->in[16] + (size_t)l * 2 * 16 * 4096, A_->in[17] + l * 2048, A_->in[18] + l * 2048, WSP(bf16_t, WS_HH), lds, t_, bid, G); }
        { IDS(); ph_attn(WSP(bf16_t, WS_P), WSP(bf16_t, WS_QKV), WSP(bf16_t, WS_MG), A_->in[10] + l * 128, A_->in[11] + (size_t)l * 12 * 15 * 31, WSP(float, WS_LAM) + l, l == 0, lds, wave0, bid, G); }
        xcd_barrier(bar);
        { IDS(); ph_mergeC(WSP(bf16_t, WS_P), WSP(bf16_t, WS_HH), WSP(bf16_t, WS_MG), l == 0 ? NROW : NLAT, t_, bid, G); }
        xcd_barrier(bar);
        { IDS(); const int M = l == 0 ? NROW : NLAT; pg8::Gemm g{WSP(bf16_t, WS_MG), WSP(bf16_t, WS_WOUT) + (size_t)l * DM * DM, M, DM, DM, 0};
          pg8::EpiRes2<l != 0> E{l == 0 ? (const void*)A_->in[0] : (const void*)WSP(bf16_t, WS_X1), A_->in[2], l == 0 ? WSP(bf16_t, WS_X1) : WSP(bf16_t, WS_HX), WSP(float, WS_MOD) + (size_t)l * 9 * 12288 + 8192, NLAT, 0}; pg8::StaticOrder S; S.init(M, DM, G, bid);
          pg8::gemm_phase<pg8::EpiRes2<l != 0>, pg8::StaticOrder, true, true>(lds, g, S, E, wave0); }
        if constexpr (l == 0) { TAIL_TRANSPOSE((NROW / 256) * (DM / 256), TR_IL + TR_P1, 2 * TR_IL); }
        xcd_barrier(bar);
    }
__global__ void __launch_bounds__(512, 2) fwd(Args a) {
    extern __shared__ __attribute__((aligned(16))) unsigned char lds_raw[];
    LAS unsigned char* lds = (LAS unsigned char*)lds_raw;
    const int tid = threadIdx.x, G = gridDim.x, bid = blockIdx.x, wave0 = __builtin_amdgcn_readfirstlane(tid >> 6);
    volatile LAS unsigned* MISC = (volatile LAS unsigned*)(lds + MISC_OFF);
    if (tid < 32) MISC[tid] = 0u;
    __syncthreads();
    XcdBarrier bar = xcd_barrier_post((unsigned*)(a.ws + WS_CTL) + CW_BAR, MISC + 8);
    if (bid == 0) { IDS(); ph_small(A_->in[9], WSP(float, WS_ROPE), WSP(float, WS_LAM), t_); }
    { IDS(); ph_mod(A_->in[1], A_->in[3], A_->in[4], A_->in[5], WSP(float, WS_MOD), lds, t_, bid, G); }
    { IDS(); ph_transpose(A_->in[7], A_->in[8], WSP(bf16_t, WS_WIN), WSP(bf16_t, WS_WOUT), lds, wv_, ln_, 0, TR_IL + TR_P0, bid * 8 + wv_, G * 8); }
    xcd_barrier(bar);
    layer<0>(bar, lds, wave0, bid, G);
    layer<1>(bar, lds, wave0, bid, G);
    { IDS(); ph_final(A_->out, WSP(bf16_t, WS_HX), A_->in[19], wv_, ln_, bid, G); }
}

extern "C" void kernel_launch(void* const* d_in, const int* in_sizes, int n_in, void* d_out, int out_size, void* d_ws, size_t ws_size, hipStream_t stream) {
    static int grid = 0;
    if (grid == 0) {
        if (n_in != 20 || in_sizes[0] != NLAT * DM || out_size != NLAT * DM || ws_size < WS_END) { fprintf(stderr, "kernel_launch: shape/workspace mismatch: n_in %d in0 %d out %d ws %zu (need %zu)\n", n_in, n_in > 0 ? in_sizes[0] : -1, out_size, ws_size, (size_t)WS_END); grid = -1; return; }
        int dev = 0, cus = 0, per_cu = 0;
        if (hipGetDevice(&dev) != hipSuccess || hipDeviceGetAttribute(&cus, hipDeviceAttributeMultiprocessorCount, dev) != hipSuccess) { fprintf(stderr, "kernel_launch: device query failed\n"); grid = -1; return; }
        if (hipFuncSetAttribute((const void*)fwd, hipFuncAttributeMaxDynamicSharedMemorySize, LDS_BYTES) != hipSuccess) { fprintf(stderr, "kernel_launch: hipFuncSetAttribute failed\n"); grid = -1; return; }
        if (hipOccupancyMaxActiveBlocksPerMultiprocessor(&per_cu, (const void*)fwd, 512, LDS_BYTES) != hipSuccess || per_cu < 1) { fprintf(stderr, "kernel_launch: occupancy query says %d blocks per CU; nothing launched\n", per_cu); (void)hipGetLastError(); grid = -1; return; }
        grid = cus;
    }
    if (grid < 0) return;
    if (hipMemsetAsync((char*)d_ws + WS_CTL, 0, CTL_ZERO_BYTES, stream) != hipSuccess) { fprintf(stderr, "kernel_launch: memset failed\n"); return; }
    Args a{};
    for (int i = 0; i < 20; ++i) a.in[i] = (const float*)d_in[i];
    a.out = (float*)d_out; a.ws = (unsigned char*)d_ws;
    hipLaunchKernelGGL(fwd, dim3(grid), dim3(512), LDS_BYTES, stream, a);
    const hipError_t le = hipPeekAtLastError();
    if (le != hipSuccess) fprintf(stderr, "kernel_launch: launch failed: %s\n", hipGetErrorName(le));
}
```

```cpp
#include <hip/hip_runtime.h>
#include <cstdio>
#include <cstdint>
#include <cmath>
namespace pg8 {
#define PG8_LAS __attribute__((address_space(3)))
typedef unsigned short bf16_t;
typedef short bf16x8 __attribute__((ext_vector_type(8)));
typedef float f32x4 __attribute__((ext_vector_type(4)));
typedef unsigned u32x4 __attribute__((ext_vector_type(4)));
constexpr int BM = 256, BK = 64, HALF = 128, HTB = HALF * BK * 2  , STAGE_BYTES = 8 * HTB, NXCD = 8, WGM = 8;

__host__ __device__ __forceinline__ int lds_byte(int r, int c) { const int st = (r >> 4) * 2 + (c >> 5), rr = r & 15, cc = c & 31, ob = rr * 64 + cc * 2; return st * 1024 + (ob ^ (((ob >> 9) & 1) << 5)); }
__host__ __device__ __forceinline__ void stage_rc(int b, int& R, int& C) { const int st = b / 1024, sb = b % 1024, swz = sb ^ (((sb >> 9) & 1) << 5); R = (st >> 1) * 16 + swz / 64; C = (st & 1) * 32 + (swz % 64) / 2; }
__host__ __device__ __forceinline__ int perm32(int rho) { const int n = rho >> 4, i = rho & 15; return 8 * (i >> 2) + 4 * n + (i & 3); }

struct Unit { int pm, pn; };
struct Gemm { const bf16_t* A; const bf16_t* Bt; int M, N, K, pad; };

struct StaticOrder {
    int nM, nN, nwg, G, c;
    __host__ __device__ void init(int M, int N, int G_, int c_) { nM = M / BM; nN = N / BM; nwg = nM * nN; G = G_; c = c_; }
    __host__ __device__ bool next(int i, Unit& u) const {
        const long L = (long)i * G + c; if (L >= nwg) return false;
        int wgid = (int)L; { const int q = nwg / NXCD, r = nwg % NXCD, xcd = wgid % NXCD, off = wgid / NXCD; wgid = (xcd < r ? xcd * (q + 1) : r * (q + 1) + (xcd - r) * q) + off; }
        const int nig = WGM * nN, gid = wgid / nig, fm = gid * WGM, gsz = (nM - fm) < WGM ? (nM - fm) : WGM;
        u.pm = fm + ((wgid % nig) % gsz); u.pn = (wgid % nig) / gsz; return true;
    }
    __device__ __forceinline__ void a_ready(const Unit&) const {}
    __device__ __forceinline__ void done(const Unit&) const {}
};

struct PrunedOrder {
    StaticOrder S; int n_main, n_x;
    __host__ __device__ void init(int M_main, int N, int G_, int c_, int n_x_) { S.init(M_main, N, G_, c_); n_main = S.nwg; n_x = n_x_; }
    __host__ __device__ bool next(int i, Unit& u) const {
        const long L = (long)i * S.G + S.c;
        if (L < n_main) return S.next(i, u);
        const int k = (int)(L - n_main); if (k >= n_x * 28) return false;
        const int idx = k % 28; u.pm = S.nM + k / 28; u.pn = idx < 12 ? 6 + idx : (idx < 24 ? 30 + (idx - 12) : 48 + (idx - 24)); return true;
    }
    __device__ __forceinline__ void a_ready(const Unit&) const {}
    __device__ __forceinline__ void done(const Unit&) const {}
};
__device__ __forceinline__ unsigned cvt_pk_bf16(float lo, float hi) { unsigned r; asm volatile("v_cvt_pk_bf16_f32 %0, %1, %2" : "=v"(r) : "v"(lo), "v"(hi)); return r; }

struct EpiP {
    static constexpr bool PERM = true, AFTER_DRAIN = false; static constexpr int NVM = 16;
    bf16_t* O; int ldc, pad; const float* rope;
    bf16_t* QKV;
    __device__ __forceinline__ void operator()(const f32x4 (&acc)[2][2][4][2], const Unit& u, int wr, int wc, int fr_, int fq_) const {
        int lid; asm volatile("v_mbcnt_lo_u32_b32 %0, -1, 0\n\tv_mbcnt_hi_u32_b32 %0, -1, %0" : "=v"(lid)); const int fr = lid & 15, fq = lid >> 4;
        const int rowt = u.pm * BM, colt = u.pn * BM;
        const int row0 = rowt + wr * 64 + fr, col0 = colt + wc * 32 + 8 * fq;
        const bool do_rope = (rowt < 16384) && (colt < 3072);
        const bool hm = (colt < 4608) || (colt >= 6144 && colt < 10752); const int th0 = colt < 4608 ? colt / 128 : 36 + (colt - 6144) / 128; const size_t bjs = hm ? (size_t)18432 * 128 : (size_t)HALF;
        const float sgn = (fq < 2) ? -1.f : 1.f;
        const int ln = fr + 16 * fq, sfr = ln >> 2, sfq = ln & 3, ssrc = (sfr + 16 * sfq) * 4;
        const int srow0 = rowt + wr * 64 + sfr;
#pragma unroll
        for (int ai = 0; ai < 2; ++ai)
#pragma unroll
            for (int m = 0; m < 4; ++m) { const int row = row0 + ai * HALF + m * 16; const int srow = srow0 + ai * HALF + m * 16;
                bf16_t* rowp = hm ? QKV + ((size_t)th0 * 18432 + srow) * 128 + wc * 32 + 8 * sfq : O + (size_t)srow * ldc + colt + wc * 32 + 8 * sfq;
                f32x4 cs[4] = {};
                if (do_rope) { const int pos = (wc & 1) ? (row & 63) : ((row & 2047) >> 6); const f32x4* tp = (const f32x4*)(rope + (pos * 16 + 8 * (fq & 1)) * 2);
#pragma unroll
                    for (int e = 0; e < 4; ++e) cs[e] = tp[e]; }
#pragma unroll
                for (int bj = 0; bj < 2; ++bj) { f32x4 v0 = acc[ai][bj][m][0], v1 = acc[ai][bj][m][1];
                    if (do_rope) {
                        f32x4 o0, o1;
#pragma unroll
                        for (int e = 0; e < 4; ++e) { o0[e] = __shfl_xor(v0[e], 32); o1[e] = __shfl_xor(v1[e], 32); }
                        v0[0] = v0[0] * cs[0][0] + sgn * o0[0] * cs[0][1]; v0[1] = v0[1] * cs[0][2] + sgn * o0[1] * cs[0][3];
                        v0[2] = v0[2] * cs[1][0] + sgn * o0[2] * cs[1][1]; v0[3] = v0[3] * cs[1][2] + sgn * o0[3] * cs[1][3];
                        v1[0] = v1[0] * cs[2][0] + sgn * o1[0] * cs[2][1]; v1[1] = v1[1] * cs[2][2] + sgn * o1[1] * cs[2][3];
                        v1[2] = v1[2] * cs[3][0] + sgn * o1[2] * cs[3][1]; v1[3] = v1[3] * cs[3][2] + sgn * o1[3] * cs[3][3];
                    }
                    u32x4 w; w.x = cvt_pk_bf16(v0[0], v0[1]); w.y = cvt_pk_bf16(v0[2], v0[3]); w.z = cvt_pk_bf16(v1[0], v1[1]); w.w = cvt_pk_bf16(v1[2], v1[3]);
                    u32x4 ws; ws.x = (unsigned)__builtin_amdgcn_ds_bpermute(ssrc, (int)w.x); ws.y = (unsigned)__builtin_amdgcn_ds_bpermute(ssrc, (int)w.y);
                    ws.z = (unsigned)__builtin_amdgcn_ds_bpermute(ssrc, (int)w.z); ws.w = (unsigned)__builtin_amdgcn_ds_bpermute(ssrc, (int)w.w);
                    *(u32x4*)(rowp + bj * bjs) = ws; } }
    }
};
struct EpiRes {
    static constexpr bool PERM = false, AFTER_DRAIN = false; static constexpr int NVM = 32;
    const float* res_lat; const float* res_ctx; float* out_lat; float* out_ctx; const float* gate; int nlat, pad;
    __device__ __forceinline__ void operator()(const f32x4 (&acc)[2][2][4][2], const Unit& u, int wr, int wc, int fr_, int fq_) const {
        int lid; asm volatile("v_mbcnt_lo_u32_b32 %0, -1, 0\n\tv_mbcnt_hi_u32_b32 %0, -1, %0" : "=v"(lid)); const int fr = lid & 15, fq = lid >> 4;
        const int rowt = u.pm * BM; const bool isctx = rowt >= nlat; const int gr = isctx ? 8 : (rowt >> 11);
        const float* res = isctx ? res_ctx : res_lat; float* out = isctx ? out_ctx : out_lat;
        const int lrow0 = (isctx ? rowt - nlat : rowt) + wr * 64 + fr, col0 = u.pn * BM + wc * 32 + 4 * fq;
        f32x4 gv[2][2];
#pragma unroll
        for (int bj = 0; bj < 2; ++bj)
#pragma unroll
            for (int n = 0; n < 2; ++n) gv[bj][n] = *(const f32x4*)(gate + (size_t)gr * 12288 + col0 + bj * HALF + n * 16);
#pragma unroll
        for (int ai = 0; ai < 2; ++ai)
#pragma unroll
            for (int m = 0; m < 4; ++m) { const size_t off = (size_t)(lrow0 + ai * HALF + m * 16) * 4096 + col0;
#pragma unroll
                for (int bj = 0; bj < 2; ++bj)
#pragma unroll
                    for (int n = 0; n < 2; ++n) { const f32x4 rs = *(const f32x4*)(res + off + bj * HALF + n * 16);
                        *(f32x4*)(out + off + bj * HALF + n * 16) = rs + gv[bj][n] * acc[ai][bj][m][n]; } }
    }
};
template <bool RB> struct EpiRes2 {
    static constexpr bool PERM = true, AFTER_DRAIN = false; static constexpr int NVM = 0;
    const void* res_lat; const float* res_ctx; bf16_t* out; const float* gate; int nlat, pad;
    __device__ __forceinline__ void operator()(const f32x4 (&acc)[2][2][4][2], const Unit& u, int wr, int wc, int fr_, int fq_) const {
        int lid; asm volatile("v_mbcnt_lo_u32_b32 %0, -1, 0\n\tv_mbcnt_hi_u32_b32 %0, -1, %0" : "=v"(lid)); const int fr = lid & 15, fq = lid >> 4;
        const int rowt = u.pm * BM, colt = u.pn * BM; const bool isctx = rowt >= nlat; const int gr = isctx ? 8 : (rowt >> 11);
        const int col0 = colt + wc * 32 + 8 * fq, row0 = rowt + wr * 64 + fr;
        const int sfr = lid >> 2, sfq = lid & 3, ssrc = (sfr + 16 * sfq) * 4, srow0 = rowt + wr * 64 + sfr, scol0 = colt + wc * 32 + 8 * sfq;
#pragma unroll
        for (int bj = 0; bj < 2; ++bj) {
            const f32x4 g0 = *(const f32x4*)(gate + (size_t)gr * 12288 + col0 + bj * HALF), g1 = *(const f32x4*)(gate + (size_t)gr * 12288 + col0 + bj * HALF + 4);
#pragma unroll
            for (int ai = 0; ai < 2; ++ai)
#pragma unroll
                for (int m = 0; m < 4; ++m) { const int row = row0 + ai * HALF + m * 16, srow = srow0 + ai * HALF + m * 16; f32x4 r0, r1;
                    if constexpr (RB) { const u32x4 rb = *(const u32x4*)((const bf16_t*)res_lat + (size_t)row * 4096 + col0 + bj * HALF);
                        r0 = (f32x4){__uint_as_float(rb.x << 16), __uint_as_float(rb.x & 0xffff0000u), __uint_as_float(rb.y << 16), __uint_as_float(rb.y & 0xffff0000u)};
                        r1 = (f32x4){__uint_as_float(rb.z << 16), __uint_as_float(rb.z & 0xffff0000u), __uint_as_float(rb.w << 16), __uint_as_float(rb.w & 0xffff0000u)}; }
                    else { const float* rp = (isctx ? res_ctx + (size_t)(row - nlat) * 4096 : (const float*)res_lat + (size_t)row * 4096) + col0 + bj * HALF; r0 = *(const f32x4*)rp; r1 = *(const f32x4*)(rp + 4); }
                    const f32x4 v0 = r0 + g0 * acc[ai][bj][m][0], v1 = r1 + g1 * acc[ai][bj][m][1];
                    u32x4 w; w.x = cvt_pk_bf16(v0[0], v0[1]); w.y = cvt_pk_bf16(v0[2], v0[3]); w.z = cvt_pk_bf16(v1[0], v1[1]); w.w = cvt_pk_bf16(v1[2], v1[3]);
                    u32x4 ws; ws.x = (unsigned)__builtin_amdgcn_ds_bpermute(ssrc, (int)w.x); ws.y = (unsigned)__builtin_amdgcn_ds_bpermute(ssrc, (int)w.y);
                    ws.z = (unsigned)__builtin_amdgcn_ds_bpermute(ssrc, (int)w.z); ws.w = (unsigned)__builtin_amdgcn_ds_bpermute(ssrc, (int)w.w);
                    *(u32x4*)(out + (size_t)srow * 4096 + scol0 + bj * HALF) = ws;
                }
        }
    }
};
template <class Epi, class Sched, bool ALIGN_EPI = false, bool SP2 = false>
__device__ __forceinline__ void gemm_phase(PG8_LAS unsigned char* lds, const Gemm g, const Sched& S, const Epi& E, int wave0) {
    int tid; asm volatile("v_mbcnt_lo_u32_b32 %0, -1, 0\n\tv_mbcnt_hi_u32_b32 %0, -1, %0" : "=v"(tid)); tid |= (wave0 << 6);
    const int wid = __builtin_amdgcn_readfirstlane(tid >> 6), lane = tid & 63, wr = wid >> 2, wc = wid & 3, fr = lane & 15, fq = lane >> 4;
    const int K = g.K, nt = K / BK;
    unsigned voffA[2], voffB[2];
#pragma unroll
    for (int i = 0; i < 2; ++i) { int R, C; stage_rc(tid * 16 + i * 8192, R, C); const int Rb = Epi::PERM ? ((R & ~31) + perm32(R & 31)) : R;
        voffA[i] = (unsigned)(R * K + C) * 2u; voffB[i] = (unsigned)(Rb * K + C) * 2u; }
    const size_t kstep = (size_t)(BK * 2);
    const size_t hstep = (size_t)HALF * K * 2;
    const size_t tstep = 2 * hstep;
    const unsigned ldsw = (unsigned)wid * 1024u;
    const int aoff = lds_byte(wr * 64 + fr, fq * 8), boff = lds_byte(wc * 32 + fr, fq * 8);
#define PG8_SA(b, h) (((b) * 2 + (h)) * HTB)
#define PG8_SB(b, h) ((4 + (b) * 2 + (h)) * HTB)
#define PG8_STAGE(bufoff, gbase, voff) do { _Pragma("unroll") for (int _i = 0; _i < 2; ++_i) \
        __builtin_amdgcn_global_load_lds((const unsigned*)((const char*)(gbase) + (voff)[_i]), (PG8_LAS unsigned*)(lds + (bufoff) + ldsw + _i * 8192), 16, 0, 0); } while (0)
#define PG8_LDA(dst, b, h) do { _Pragma("unroll") for (int m = 0; m < 4; ++m) _Pragma("unroll") for (int k = 0; k < 2; ++k) dst[m][k] = *(const PG8_LAS bf16x8*)(lds + PG8_SA(b, h) + aoff + m * 2048 + k * 1024); } while (0)
#define PG8_LDB(dst, b, h) do { _Pragma("unroll") for (int n = 0; n < 2; ++n) _Pragma("unroll") for (int k = 0; k < 2; ++k) dst[n][k] = *(const PG8_LAS bf16x8*)(lds + PG8_SB(b, h) + boff + n * 2048 + k * 1024); } while (0)
#define PG8_MMA(ai, bj, At, Bt) do { __builtin_amdgcn_s_setprio(1); _Pragma("unroll") for (int m = 0; m < 4; ++m) _Pragma("unroll") for (int n = 0; n < 2; ++n) _Pragma("unroll") for (int k = 0; k < 2; ++k) \
        acc[ai][bj][m][n] = __builtin_amdgcn_mfma_f32_16x16x32_bf16(Bt[n][k], At[m][k], acc[ai][bj][m][n], 0, 0, 0); __builtin_amdgcn_s_setprio(0); } while (0)
#define PG8_WAIT_V(n) asm volatile("s_waitcnt vmcnt(" #n ")" ::: "memory")
#define PG8_WAIT_L(n) asm volatile("s_waitcnt lgkmcnt(" #n ")" ::: "memory")
#define PG8_BAR __builtin_amdgcn_s_barrier()
#define PG8_SCHED __builtin_amdgcn_sched_barrier(0)
    Unit cur, nxt; int ui = 0;
    if (!S.next(0, cur)) return;
    f32x4 acc[2][2][4][2];
#pragma unroll
    for (int a = 0; a < 2; ++a)
#pragma unroll
        for (int b = 0; b < 2; ++b)
#pragma unroll
            for (int m = 0; m < 4; ++m)
#pragma unroll
                for (int n = 0; n < 2; ++n) acc[a][b][m][n] = (f32x4){0.f, 0.f, 0.f, 0.f};
    bf16x8 At[4][2], B0[2][2], B1[2][2];
    const char* cA = (const char*)g.A + (size_t)cur.pm * tstep; const char* cB = (const char*)g.Bt + (size_t)cur.pn * tstep;
    S.a_ready(cur);
    {
        PG8_STAGE(PG8_SB(0, 0), cB, voffB); PG8_STAGE(PG8_SB(0, 1), cB + hstep, voffB); PG8_STAGE(PG8_SA(0, 0), cA, voffA); PG8_STAGE(PG8_SA(0, 1), cA + hstep, voffA);
        PG8_STAGE(PG8_SB(1, 0), cB + kstep, voffB); PG8_STAGE(PG8_SA(1, 0), cA + kstep, voffA); PG8_STAGE(PG8_SB(1, 1), cB + hstep + kstep, voffB); PG8_STAGE(PG8_SA(1, 1), cA + hstep + kstep, voffA);
        if (wr == 1) PG8_BAR;
        PG8_WAIT_V(0); PG8_BAR; PG8_BAR;
    }
    for (;;) {
        const bool has_next = S.next(ui + 1, nxt);
        const char* nA = has_next ? (const char*)g.A + (size_t)nxt.pm * tstep : cA; const char* nB = has_next ? (const char*)g.Bt + (size_t)nxt.pn * tstep : cB;
#define PG8_ITER(t, W, L2) do { \
            const bool last = (L2) && ((t) == nt - 2); \
            const char* a1 = cA + (size_t)((t) + 1) * kstep; \
            const char* a2 = last ? nA : cA + (size_t)((t) + 2) * kstep; const char* b2 = last ? nB : cB + (size_t)((t) + 2) * kstep; \
            const char* a3 = a2 + kstep; const char* b3 = b2 + kstep; \
            if (last && has_next) S.a_ready(nxt); \
            PG8_LDB(B0, 0, 0); PG8_LDB(B1, 0, 1); PG8_SCHED; PG8_LDA(At, 0, 0); if (L2) PG8_STAGE(PG8_SA(1, 1), a1 + hstep, voffA); \
            PG8_WAIT_V(W); PG8_WAIT_L(0); PG8_BAR; PG8_MMA(0, 0, At, B0); PG8_MMA(0, 1, At, B1); PG8_BAR; PG8_SCHED; \
            PG8_LDA(At, 0, 1); PG8_STAGE(PG8_SB(0, 0), b2, voffB); PG8_STAGE(PG8_SB(0, 1), b2 + hstep, voffB); PG8_STAGE(PG8_SA(0, 0), a2, voffA); \
            PG8_WAIT_V(W); PG8_WAIT_L(0); PG8_BAR; PG8_MMA(1, 0, At, B0); PG8_MMA(1, 1, At, B1); PG8_BAR; PG8_SCHED; \
            PG8_LDB(B0, 1, 0); PG8_LDB(B1, 1, 1); PG8_SCHED; PG8_LDA(At, 1, 0); PG8_STAGE(PG8_SA(0, 1), a2 + hstep, voffA); \
            PG8_WAIT_V(W); PG8_WAIT_L(0); PG8_BAR; PG8_MMA(0, 0, At, B0); PG8_MMA(0, 1, At, B1); PG8_BAR; PG8_SCHED; \
            PG8_LDA(At, 1, 1); PG8_STAGE(PG8_SB(1, 0), b3, voffB); PG8_STAGE(PG8_SB(1, 1), b3 + hstep, voffB); PG8_STAGE(PG8_SA(1, 0), a3, voffA); \
            PG8_WAIT_V(8); PG8_WAIT_L(0); PG8_BAR; PG8_MMA(1, 0, At, B0); PG8_MMA(1, 1, At, B1); PG8_BAR; PG8_SCHED; } while (0)
        static_assert(SP2, "only the super-phase schedule is kept");
        if constexpr (Epi::NVM == 16) PG8_ITER(0, 24, 0); else if constexpr (Epi::NVM == 32) PG8_ITER(0, 40, 0);
        for (int t = (Epi::NVM ? 2 : 0); t < nt; t += 2) PG8_ITER(t, 8, 1);
        if constexpr (Epi::NVM != 0) { if (has_next) PG8_STAGE(PG8_SA(1, 1), nA + kstep + hstep, voffA); }
        if constexpr (ALIGN_EPI) { if (wr == 0) PG8_BAR; }
        if constexpr (!Epi::AFTER_DRAIN) { E(acc, cur, wr, wc, fr, fq); S.done(cur); }
        if (!has_next) break;
#pragma unroll
        for (int a = 0; a < 2; ++a)
#pragma unroll
            for (int b = 0; b < 2; ++b)
#pragma unroll
                for (int m = 0; m < 4; ++m)
#pragma unroll
                    for (int n = 0; n < 2; ++n) acc[a][b][m][n] = (f32x4){0.f, 0.f, 0.f, 0.f};
        cur = nxt; cA = nA; cB = nB; ++ui;
        if constexpr (ALIGN_EPI) { if (wr == 1) PG8_BAR; }
    }
    PG8_WAIT_V(0);
    if constexpr (!ALIGN_EPI) { if (wr == 0) PG8_BAR; }
    PG8_BAR;
    if constexpr (Epi::AFTER_DRAIN) { E.fused(acc, cur, wr, wc, fr, fq, lds, wid, lane); S.done(cur); }
#undef PG8_SA
#undef PG8_SB
#undef PG8_STAGE
#undef PG8_LDA
#undef PG8_LDB
#undef PG8_MMA
#undef PG8_WAIT_V
#undef PG8_WAIT_L
#undef PG8_BAR
#undef PG8_SCHED
#undef PG8_ITER
}
}

constexpr int DM = 4096, NB = 8, SEQ = 2048, NCTX = 256, INW = 14336, NLAT = NB * SEQ, NROW = NLAT + NB * NCTX;
constexpr int HEADS = 12;
constexpr int C_QA = 0, C_KA = 1536, C_VA = 3072, C_GA = 4608, C_QB = 6144, C_KB = 7680, C_VB = 9216, C_GB = 10752, C_XC = 12288, C_GC = 13312;
constexpr size_t MiB = 1u << 20;
constexpr size_t WS_CTL = 0, WS_MOD = 1 * MiB, WS_ROPE = 2 * MiB, WS_LAM = 2 * MiB + 65536, WS_WIN = 4 * MiB, WS_WOUT = 228 * MiB, WS_HX = 292 * MiB, WS_P = 436 * MiB,
                 WS_MG = 940 * MiB, WS_CTXRES = 1084 * MiB, WS_HH = 1116 * MiB, WS_QKV = 1260 * MiB, WS_X1 = 1584 * MiB  , WS_END = 1728 * MiB;
constexpr size_t CTL_ZERO_BYTES = 1 * MiB;
constexpr int CW_BAR = 4096;
typedef unsigned short bf16_t;
typedef float f32x4 __attribute__((ext_vector_type(4)));
#define GAS __attribute__((address_space(1)))
typedef unsigned v4u __attribute__((ext_vector_type(4)));
#define LDS_WAIT() asm volatile("s_waitcnt lgkmcnt(0)" ::: "memory")

__device__ __forceinline__ float bf2f(bf16_t b) { return __uint_as_float(((unsigned)b) << 16); }
__device__ __forceinline__ unsigned pk2(float lo, float hi) { unsigned r; asm("v_cvt_pk_bf16_f32 %0, %1, %2" : "=v"(r) : "v"(lo), "v"(hi)); return r; }
__device__ __forceinline__ unsigned f2bf(float f) { return pk2(f, f); }

__device__ __forceinline__ float wave_sum(float v) {
#pragma unroll
    for (int o = 1; o < 64; o <<= 1) v += __shfl_xor(v, o);
    return v;
}
__device__ __forceinline__ float wave_max(float v) {
#pragma unroll
    for (int o = 1; o < 64; o <<= 1) v = fmaxf(v, __shfl_xor(v, o));
    return v;
}
__device__ __forceinline__ float silu_f(float v) { return v / (1.f + expf(-v)); }
__device__ __forceinline__ float sigmoid_f(float v) { return 1.f / (1.f + expf(-v)); }
__device__ __forceinline__ float silu_fast(float v) { return v * __builtin_amdgcn_rcpf(1.f + __builtin_amdgcn_exp2f(-1.4426950408889634f * v)); }
__device__ __forceinline__ float silu_e2(float v) { return v / (1.f + __builtin_amdgcn_exp2f(-1.4426950408889634f * v)); }
#define XB_TMO      128
#define XB_XCNT(j)  (256  + 64 * (j))
#define XB_XSUB(j)  (1280 + 64 * (j))
#define XB_XGEN(j)  (2304 + 64 * (j))
#define XB_TOP      3328
#define XB_TOPGEN   3392
#define XCD_BAR_WORDS 3456
#define XB_SPIN_CAP (1u << 18)
#define LAS __attribute__((address_space(3)))

__device__ __forceinline__ unsigned xb_ld(unsigned* p)              { return __hip_atomic_load(p, __ATOMIC_RELAXED, __HIP_MEMORY_SCOPE_AGENT); }
__device__ __forceinline__ unsigned xb_add(unsigned* p, unsigned v) { return __hip_atomic_fetch_add(p, v, __ATOMIC_RELAXED, __HIP_MEMORY_SCOPE_AGENT); }
__device__ __forceinline__ unsigned xb_xcc_id() { return (unsigned)__builtin_amdgcn_s_getreg((3 << 11) | 20) & 0xFu; }
#define XB_SPIN(cond, bar) do { unsigned _sp = 0; while (cond) { __builtin_amdgcn_s_sleep(1); \
    if ((++_sp & 255u) == 0u) { if (xb_ld(&(bar)[XB_TMO])) break; if (_sp > XB_SPIN_CAP) { atomicAdd(&(bar)[XB_TMO], 1u); break; } } } } while (0)

struct XcdBarrier {
    unsigned* bar; unsigned x;
    volatile LAS unsigned* st;
};

__device__ __forceinline__ XcdBarrier xcd_barrier_post(unsigned* bar, volatile LAS unsigned* st) {
    XcdBarrier b; b.bar = bar; b.x = xb_xcc_id(); b.st = st;
    if (threadIdx.x == 0) (void)xb_add(&bar[XB_XCNT(b.x)], 1u);
    return b;
}
__device__ __forceinline__ void xcd_barrier_complete(unsigned* bar, unsigned x, unsigned& nloc, unsigned& nx) {
    const unsigned G = gridDim.x * gridDim.y * gridDim.z;
    unsigned sum, cnt, mine, sp = 0u;
    for (;;) {
        sum = 0u; cnt = 0u; mine = 0u;
#pragma unroll
        for (unsigned j = 0; j < 16; ++j) { const unsigned c = xb_ld(&bar[XB_XCNT(j)]); sum += c; cnt += (c > 0u) ? 1u : 0u; mine = (j == x) ? c : mine; }
        if (sum == G) break;
        __builtin_amdgcn_s_sleep(1);
        if ((++sp & 255u) == 0u) { if (xb_ld(&bar[XB_TMO])) break; if (sp > XB_SPIN_CAP) { atomicAdd(&bar[XB_TMO], 1u); break; } }
    }
    nloc = mine > 0u ? mine : 1u; nx = cnt > 0u ? cnt : 1u;
}

__device__ __forceinline__ void xcd_barrier(const XcdBarrier& b) {
    asm volatile("s_waitcnt vmcnt(0)" ::: "memory");
    __syncthreads();
    if (threadIdx.x == 0) {
        unsigned* bar = b.bar;
        __builtin_amdgcn_s_waitcnt(0);
        unsigned nloc = b.st[0], nx = b.st[1];
        if (nloc == 0u) { xcd_barrier_complete(bar, b.x, nloc, nx); b.st[0] = nloc; b.st[1] = nx; }
        const unsigned old = xb_add(&bar[XB_XSUB(b.x)], 1u);
        const unsigned gen = old / nloc;
        if (old + 1u == (gen + 1u) * nloc) {
            __builtin_amdgcn_fence(__ATOMIC_RELEASE, "agent");
            asm volatile("s_waitcnt vmcnt(0)" ::: "memory");
            const unsigned og = xb_add(&bar[XB_TOP], 1u);
            const unsigned tg = og / nx;
            if (og + 1u == (tg + 1u) * nx) xb_add(&bar[XB_TOPGEN], 1u);
            else XB_SPIN(xb_ld(&bar[XB_TOPGEN]) == tg, bar);
            __builtin_amdgcn_fence(__ATOMIC_ACQUIRE, "agent");
            xb_add(&bar[XB_XGEN(b.x)], 1u);
            asm volatile("s_waitcnt vmcnt(0)" ::: "memory");
        } else {
            XB_SPIN(xb_ld(&bar[XB_XGEN(b.x)]) == gen, bar);
            __builtin_amdgcn_fence(__ATOMIC_ACQUIRE, "agent");
            asm volatile("s_waitcnt vmcnt(0)" ::: "memory");
        }
    }
    __syncthreads();
}
#define LAS __attribute__((address_space(3)))
constexpr int RING_BYTES = 131072, MISC_OFF = 143360, LDS_BYTES = 147456;

__device__ __forceinline__ void p0_transpose_item(const float* W, int K, int N, bf16_t* WT, int row_off, LAS float* scr, int item, int lane) {
    const int nblk = N / 32, kb = item / nblk, nb = item % nblk, k0 = 64 * kb, n0 = 32 * nb;
    float v[32];
#pragma unroll
    for (int i = 0; i < 32; ++i) v[i] = W[(size_t)(k0 + 2 * i + (lane >> 5)) * N + n0 + (lane & 31)];
#pragma unroll
    for (int i = 0; i < 32; ++i) scr[(2 * i + (lane >> 5)) * 33 + (lane & 31)] = v[i];
    LDS_WAIT(); asm volatile("" ::: "memory");
    const int c = lane & 7;
#pragma unroll
    for (int j = 0; j < 4; ++j) { const int n = (lane >> 3) + 8 * j; const LAS float* s = scr + (8 * c) * 33 + n;
        v4u o; o.x = pk2(s[0 * 33], s[1 * 33]); o.y = pk2(s[2 * 33], s[3 * 33]); o.z = pk2(s[4 * 33], s[5 * 33]); o.w = pk2(s[6 * 33], s[7 * 33]);
        *(GAS v4u*)(WT + (size_t)(row_off + n0 + n) * K + k0 + 8 * c) = o; }
    LDS_WAIT(); asm volatile("" ::: "memory");
}
constexpr int TR_IL = (DM / 64) * (INW / 32) + (DM / 64) * (DM / 32);
__device__ __forceinline__ void ph_transpose(const float* w_in, const float* w_out, bf16_t* WinT, bf16_t* WoutT, LAS unsigned char* lds, int wave, int lane, int lo, int hi, int gw, int NGW) {
    LAS float* scr = (LAS float*)lds + wave * 64 * 33;
    constexpr int I_IN = (DM / 64) * (INW / 32), I_OUT = (DM / 64) * (DM / 32), I_L = I_IN + I_OUT;
    for (int it = lo + gw; it < hi; it += NGW) {
        const int l = it / I_L, r = it % I_L;
        if (r < I_IN) p0_transpose_item(w_in + (size_t)l * DM * INW, DM, INW, WinT + (size_t)l * INW * DM, 0, scr, r, lane);
        else p0_transpose_item(w_out + (size_t)l * DM * DM, DM, DM, WoutT + (size_t)l * DM * DM, 0, scr, r - I_IN, lane);
    }
}
__device__ __forceinline__ void ph_small(const float* lambda_qk, float* rope, float* lam, int tid) {
    for (int i = tid; i < 1024; i += 512) { const int pos = i >> 4, f = i & 15; const float fr = exp2f(-(float)f * (13.287712379549449f / 16.f)), ang = (float)pos * fr; float sn, cs; sincosf(ang, &sn, &cs); rope[2 * i] = cs; rope[2 * i + 1] = sn; }
    if (tid < 2) { const float* lq = lambda_qk + tid * 256; float s01 = 0.f, s23 = 0.f; for (int d = 0; d < 64; ++d) { s01 += lq[d] * lq[64 + d]; s23 += lq[128 + d] * lq[192 + d]; }
        const float lam_init = 0.8f - 0.6f * expf(-0.3f * (float)tid); lam[tid] = expf(s01) - expf(s23) + lam_init; lam[2 + tid] = 1.f - lam_init; }
}
__device__ __forceinline__ void ph_mod(const float* c, const float* c_ctx, const float* ada_w, const float* ada_b, float* mod, LAS unsigned char* lds, int tid, int bid, int G) {
    LAS float* sl = (LAS float*)lds; LAS float* red = (LAS float*)(lds + 9 * 1024 * 4);
    const int kg = tid >> 5, cj = tid & 31;
    for (int item = bid; item < 2 * 128; item += G) {
        const int l = item / 128, j0 = (item % 128) * 96;
        float acc[3][9];
#pragma unroll
        for (int cc = 0; cc < 3; ++cc)
#pragma unroll
            for (int r = 0; r < 9; ++r) acc[cc][r] = 0.f;
        const float* W = ada_w + (size_t)l * DM * 12288 + j0 + cj;
        for (int ch = 0; ch < 4; ++ch) {
            __syncthreads();
            for (int idx = tid; idx < 9 * 1024; idx += 512) { const int r = idx >> 10, kk = idx & 1023; const float v = (r < 8) ? c[r * DM + ch * 1024 + kk] : c_ctx[ch * 1024 + kk]; sl[idx] = silu_f(v); }
            __syncthreads();
#pragma unroll 1
            for (int i0 = 0; i0 < 64; i0 += 8) { float w[3][8]; const int kb = kg * 64 + i0;
#pragma unroll
                for (int u = 0; u < 8; ++u)
#pragma unroll
                    for (int cc = 0; cc < 3; ++cc) w[cc][u] = W[(size_t)(ch * 1024 + kb + u) * 12288 + 32 * cc];
#pragma unroll
                for (int r = 0; r < 9; ++r)
#pragma unroll
                    for (int q = 0; q < 2; ++q) { const f32x4 s4 = *(const LAS f32x4*)(sl + r * 1024 + kb + 4 * q);
#pragma unroll
                        for (int cc = 0; cc < 3; ++cc) acc[cc][r] += (s4.x * w[cc][4 * q] + s4.y * w[cc][4 * q + 1]) + (s4.z * w[cc][4 * q + 2] + s4.w * w[cc][4 * q + 3]); } }
        }
#pragma unroll
        for (int cc = 0; cc < 3; ++cc)
#pragma unroll
            for (int r = 0; r < 9; ++r) red[(kg * 27 + cc * 9 + r) * 32 + cj] = acc[cc][r];
        __syncthreads();
        for (int o = tid; o < 27 * 32; o += 512) { const int c9 = o >> 5, c2 = o & 31, cc = c9 / 9, r = c9 % 9; float s = ada_b[l * 12288 + j0 + 32 * cc + c2];
            for (int g = 0; g < 16; ++g) s += red[(g * 27 + c9) * 32 + c2];
            mod[(size_t)(l * 9 + r) * 12288 + j0 + 32 * cc + c2] = s; }
    }
    __syncthreads();
}
template <bool BF> __device__ __forceinline__ void ph_norm(const void* xlat, const float* xctx, const float* norm_w, const float* mod, bf16_t* HX, int wave, int lane, int bid, int G) {
    const int gw = bid * 8 + wave, NGW = G * 8;
    for (int row = gw; row < NROW; row += NGW) {
        const bool isctx = row >= NLAT; const int r = isctx ? 8 : (row >> 11);
        f32x4 v[16]; float s = 0.f;
        if constexpr (BF) { const unsigned long long* xr = (const unsigned long long*)((const bf16_t*)xlat + (size_t)row * DM) + lane;
#pragma unroll
            for (int j = 0; j < 16; ++j) { const unsigned long long q = xr[64 * j]; const unsigned lo = (unsigned)q, hi = (unsigned)(q >> 32);
                v[j] = (f32x4){__uint_as_float(lo << 16), __uint_as_float(lo & 0xffff0000u), __uint_as_float(hi << 16), __uint_as_float(hi & 0xffff0000u)}; }
        } else { const f32x4* xr = (const f32x4*)(isctx ? xctx + (size_t)(row - NLAT) * DM : (const float*)xlat + (size_t)row * DM) + lane;
#pragma unroll
            for (int j = 0; j < 16; ++j) v[j] = xr[64 * j]; }
#pragma unroll
        for (int j = 0; j < 16; ++j) s += (v[j].x * v[j].x + v[j].y * v[j].y) + (v[j].z * v[j].z + v[j].w * v[j].w);
        const float rstd = 1.f / sqrtf(wave_sum(s) * (1.f / DM) + 1e-6f);
        const f32x4* nw = (const f32x4*)norm_w + lane; const f32x4* sh = (const f32x4*)(mod + (size_t)r * 12288) + lane; const f32x4* sc = (const f32x4*)(mod + (size_t)r * 12288 + 4096) + lane;
        unsigned long long* o8 = (unsigned long long*)(HX + (size_t)row * DM) + lane;
#pragma unroll
        for (int j = 0; j < 16; ++j) { const f32x4 w = nw[64 * j], a = sc[64 * j], b = sh[64 * j]; const f32x4 y = v[j] * rstd * w; const f32x4 o = y * (a + 1.f) + b;
            o8[64 * j] = (unsigned long long)pk2(o.x, o.y) | ((unsigned long long)pk2(o.z, o.w) << 32); }
    }
}
namespace att {
using bf16x8 = __attribute__((ext_vector_type(8))) short;
using s16x4  = __attribute__((ext_vector_type(4))) short;
using f32x16 = __attribute__((ext_vector_type(16))) float;
using u32x4  = __attribute__((ext_vector_type(4))) unsigned;
constexpr int SHM_V = 16384, SHM_K = 16384, OFF_K = 2 * SHM_V, OFF_BIAS = OFF_K + 2 * SHM_K, ATT_LDS = OFF_BIAS + 2048;
#define KSWZ(row, colB) ((row) * 256 + ((colB) ^ (((row) & 7) << 4)))
#define SBAR() __builtin_amdgcn_sched_barrier(0)
__device__ __forceinline__ int crow(int r, int hi) { return (r & 3) + 8 * (r >> 2) + 4 * hi; }
__device__ __forceinline__ unsigned cvtpk(float lo, float hi) { unsigned r; asm("v_cvt_pk_bf16_f32 %0, %1, %2" : "=v"(r) : "v"(lo), "v"(hi)); return r; }
__device__ __forceinline__ int v_st(int k, int c) { const int kk = (k & ~0xC) | ((k & 4) << 1) | ((k & 8) >> 1); return ((kk >> 3) * 4 + (c >> 5)) * 512 + ((kk & 7) * 32 + (c & 31)) * 2; }
__device__ __forceinline__ int v_rd_base(int lane) { return ((lane & 3) << 3) | (((lane >> 2) & 3) << 6) | (((lane >> 4) & 1) << 5) | (((lane >> 5) & 1) << 8); }
constexpr int v_rd_off(int d0, int ks, int half) { return d0 * 512 + ks * 4096 + half * 2048; }
template <int OFF> __device__ __forceinline__ s16x4 tr_read(int vb) { return __builtin_amdgcn_ds_read_tr16_b64_v4i16((LAS s16x4*)(unsigned)(vb + OFF)); }
template <int D0> __device__ __forceinline__ void pv_one(f32x16& od, int vb, bf16x8 pa0, bf16x8 pa1, bf16x8 pa2, bf16x8 pa3) {
  s16x4 l0 = tr_read<v_rd_off(D0, 0, 0)>(vb), h0 = tr_read<v_rd_off(D0, 0, 1)>(vb), l1 = tr_read<v_rd_off(D0, 1, 0)>(vb), h1 = tr_read<v_rd_off(D0, 1, 1)>(vb);
  s16x4 l2 = tr_read<v_rd_off(D0, 2, 0)>(vb), h2 = tr_read<v_rd_off(D0, 2, 1)>(vb), l3 = tr_read<v_rd_off(D0, 3, 0)>(vb), h3 = tr_read<v_rd_off(D0, 3, 1)>(vb);
#define PK(L, H) (bf16x8){L[0], L[1], L[2], L[3], H[0], H[1], H[2], H[3]}
  od = __builtin_amdgcn_mfma_f32_32x32x16_bf16(pa0, PK(l0, h0), od, 0, 0, 0);
  od = __builtin_amdgcn_mfma_f32_32x32x16_bf16(pa1, PK(l1, h1), od, 0, 0, 0);
  od = __builtin_amdgcn_mfma_f32_32x32x16_bf16(pa2, PK(l2, h2), od, 0, 0, 0);
  od = __builtin_amdgcn_mfma_f32_32x32x16_bf16(pa3, PK(l3, h3), od, 0, 0, 0);
#undef PK
}
__device__ __forceinline__ void pv_d0(f32x16* o, int vb, bf16x8 pa0, bf16x8 pa1, bf16x8 pa2, bf16x8 pa3) {
  pv_one<0>(o[0], vb, pa0, pa1, pa2, pa3); pv_one<1>(o[1], vb, pa0, pa1, pa2, pa3); pv_one<2>(o[2], vb, pa0, pa1, pa2, pa3); pv_one<3>(o[3], vb, pa0, pa1, pa2, pa3);
}
#define PK4(P, BASE, OUT) do { unsigned a0 = cvtpk(P[BASE + 0], P[BASE + 1]), a1 = cvtpk(P[BASE + 2], P[BASE + 3]);   \
    unsigned b0 = cvtpk(P[BASE + 4], P[BASE + 5]), b1 = cvtpk(P[BASE + 6], P[BASE + 7]);                              \
    auto r0 = __builtin_amdgcn_permlane32_swap(a0, b0, false, false); auto r1 = __builtin_amdgcn_permlane32_swap(a1, b1, false, false); \
    u32x4 w = {r0[0], r1[0], r0[1], r1[1]}; OUT = *reinterpret_cast<bf16x8*>(&w); } while (0)
template <int D_LO, int D_HI> __device__ __forceinline__ void qkt(f32x16& x0, f32x16& x1, const LAS unsigned char* Ks, const bf16x8* qr, int r32, int hi) {
  x0 = f32x16{}; x1 = f32x16{};
#pragma unroll
  for (int d0 = D_LO; d0 < D_HI; ++d0) { const int cb = (d0 * 16 + hi * 8) * 2;
    const bf16x8 b0 = *reinterpret_cast<const LAS bf16x8*>(Ks + KSWZ(r32, cb));
    const bf16x8 b1 = *reinterpret_cast<const LAS bf16x8*>(Ks + KSWZ(32 + r32, cb));
    x0 = __builtin_amdgcn_mfma_f32_32x32x16_bf16(b0, qr[d0], x0, 0, 0, 0);
    x1 = __builtin_amdgcn_mfma_f32_32x32x16_bf16(b1, qr[d0], x1, 0, 0, 0); }
}
struct UnitDesc {
  int qrow0;
  int krow_ctx;
  int krow_lat;
  int lt0, nlt;
  int tq, tk, tv;
  int cg, co;
  int na;
};
constexpr float LOG2E = 1.4426950408889634f;
template <bool DIFF>
__device__ __forceinline__ void attn_unit(const bf16_t* __restrict__ P, const bf16_t* __restrict__ QKV, bf16_t* __restrict__ MG, LAS unsigned char* lds, int tid, const UnitDesc u,
                                          float lam, float oml, const float* __restrict__ subln_w, const float* __restrict__ rpb_h) {
  asm volatile("" : "+v"(tid));
  const int wid = __builtin_amdgcn_readfirstlane(tid >> 6), lane = tid & 63, r32 = lane & 31, hi = lane >> 5;
  LAS unsigned char* V_lds = lds; LAS unsigned char* K_lds = lds + OFF_K; LAS float* bias_l = (LAS float*)(lds + OFF_BIAS);
  constexpr float CS = (DIFF ? 0.125f : 0.08838834764831845f) * LOG2E;
  bf16x8 qr[8];
  { const bf16_t* Qw = QKV + ((size_t)u.tq * NROW + u.qrow0 + wid * 32 + r32) * 128 + hi * 8;
#pragma unroll
    for (int d0 = 0; d0 < 8; ++d0) qr[d0] = *reinterpret_cast<const bf16x8*>(Qw + d0 * 16); }
  const int grow = ((u.qrow0 & 2047) >> 6) + (wid >> 1), cqx = 32 * (wid & 1) + r32;
  const int r0 = min(max(grow - 4, 0), 24), c0 = min(max(cqx - 8, 0), 48);
  if (!DIFF && u.na) { __syncthreads(); if (tid < 465) bias_l[tid] = rpb_h[tid] * LOG2E; }
  const int sr = tid >> 4, sc = (tid & 15) * 8, vst0 = v_st(sr, sc), vst1 = v_st(32 + sr, sc), kst0 = KSWZ(sr, sc * 2), kst1 = KSWZ(32 + sr, sc * 2);
  const int vb0 = (int)(uintptr_t)V_lds + v_rd_base(lane);
  const int NT = 4 + u.nlt;
  bf16x8 ks0, ks1, vs0, vs1;
#define TROW(j) ((j) < 4 ? u.krow_ctx + 64 * (j) : u.krow_lat + 64 * (u.lt0 + (j) - 4))
#define KLOAD(j) do { const bf16_t* kp_ = QKV + ((size_t)u.tk * NROW + TROW(j) + sr) * 128 + sc; ks0 = *reinterpret_cast<const bf16x8*>(kp_); ks1 = *reinterpret_cast<const bf16x8*>(kp_ + 32 * 128); } while (0)
#define VLOAD(j) do { const bf16_t* vp_ = QKV + ((size_t)u.tv * NROW + TROW(j) + sr) * 128 + sc; vs0 = *reinterpret_cast<const bf16x8*>(vp_); vs1 = *reinterpret_cast<const bf16x8*>(vp_ + 32 * 128); } while (0)
#define KWRITE(b) do { *reinterpret_cast<LAS bf16x8*>(K_lds + (b) * SHM_K + kst0) = ks0; *reinterpret_cast<LAS bf16x8*>(K_lds + (b) * SHM_K + kst1) = ks1; } while (0)
#define VWRITE(b) do { *reinterpret_cast<LAS bf16x8*>(V_lds + (b) * SHM_V + vst0) = vs0; *reinterpret_cast<LAS bf16x8*>(V_lds + (b) * SHM_V + vst1) = vs1; } while (0)
#define NA_FIX(X0, X1, j) do { if (!DIFF && u.na && (j) >= 4) { const int R_ = u.lt0 + (j) - 4; const int bb_ = (R_ - grow + 7) * 31 + 15 - cqx; \
    _Pragma("unroll") for (int r = 0; r < 16; ++r) { const int ck0_ = crow(r, hi), ck1_ = 32 + ck0_; \
      const bool v0_ = (ck0_ >= c0) && (ck0_ < c0 + 16), v1_ = (ck1_ >= c0) && (ck1_ < c0 + 16); \
      const float b0_ = bias_l[v0_ ? bb_ + ck0_ : 0], b1_ = bias_l[v1_ ? bb_ + ck1_ : 0]; \
      X0[r] = v0_ ? X0[r] * CS + b0_ : -1e30f; X1[r] = v1_ ? X1[r] * CS + b1_ : -1e30f; } } \
    else { _Pragma("unroll") for (int r = 0; r < 16; ++r) { X0[r] *= CS; X1[r] *= CS; } } } while (0)
#define PART(j) (DIFF || !u.na || (j) < 4 || ((u.lt0 + (j) - 4) >= r0 && (u.lt0 + (j) - 4) < r0 + 8))
  float m0 = -1e30f, l0 = 0.f, m1 = -1e30f, l1 = 0.f;
  __syncthreads();
  KLOAD(0); KWRITE(0);
  __syncthreads();
  for (int j = 0; j < NT; ++j) {
    const LAS unsigned char* Kb = K_lds + (j & 1) * SHM_K;
    if (j + 1 < NT) KLOAD(j + 1);
    if (PART(j)) {
      f32x16 sx0, sx1;
      if (DIFF) {
        qkt<0, 4>(sx0, sx1, Kb, qr, r32, hi);
        { float tm = -1e30f;
#pragma unroll
          for (int r = 0; r < 16; ++r) { sx0[r] *= CS; sx1[r] *= CS; tm = fmaxf(tm, fmaxf(sx0[r], sx1[r])); }
          const float mn = fmaxf(m0, tm); float s = 0.f;
#pragma unroll
          for (int r = 0; r < 16; ++r) s += __builtin_amdgcn_exp2f(sx0[r] - mn) + __builtin_amdgcn_exp2f(sx1[r] - mn);
          l0 = l0 * __builtin_amdgcn_exp2f(m0 - mn) + s; m0 = mn; }
        qkt<4, 8>(sx0, sx1, Kb, qr, r32, hi);
        { float tm = -1e30f;
#pragma unroll
          for (int r = 0; r < 16; ++r) { sx0[r] *= CS; sx1[r] *= CS; tm = fmaxf(tm, fmaxf(sx0[r], sx1[r])); }
          const float mn = fmaxf(m1, tm); float s = 0.f;
#pragma unroll
          for (int r = 0; r < 16; ++r) s += __builtin_amdgcn_exp2f(sx0[r] - mn) + __builtin_amdgcn_exp2f(sx1[r] - mn);
          l1 = l1 * __builtin_amdgcn_exp2f(m1 - mn) + s; m1 = mn; }
      } else {
        qkt<0, 8>(sx0, sx1, Kb, qr, r32, hi);
        NA_FIX(sx0, sx1, j);
        float tm = -1e30f;
#pragma unroll
        for (int r = 0; r < 16; ++r) tm = fmaxf(tm, fmaxf(sx0[r], sx1[r]));
        const float mn = fmaxf(m0, tm); float s = 0.f;
#pragma unroll
        for (int r = 0; r < 16; ++r) s += __builtin_amdgcn_exp2f(sx0[r] - mn) + __builtin_amdgcn_exp2f(sx1[r] - mn);
        l0 = l0 * __builtin_amdgcn_exp2f(m0 - mn) + s; m0 = mn;
      }
    }
    if (j + 1 < NT) KWRITE((j + 1) & 1);
    __syncthreads();
  }
  float K0, K1 = 0.f, c1 = 0.f;
  { const float mo = __shfl_xor(m0, 32), lo = __shfl_xor(l0, 32), M = fmaxf(m0, mo), L = l0 * __builtin_amdgcn_exp2f(m0 - M) + lo * __builtin_amdgcn_exp2f(mo - M); K0 = M + __builtin_amdgcn_logf(L); }
  if (DIFF) { const float mo = __shfl_xor(m1, 32), lo = __shfl_xor(l1, 32), M = fmaxf(m1, mo), L = l1 * __builtin_amdgcn_exp2f(m1 - M) + lo * __builtin_amdgcn_exp2f(mo - M); K1 = M; c1 = lam * __builtin_amdgcn_rcpf(L); }
  f32x16 o[4] = {};
  KLOAD(0); VLOAD(0); KWRITE(0); VWRITE(0);
  __syncthreads();
  for (int j = 0; j < NT; ++j) {
    const LAS unsigned char* Kb = K_lds + (j & 1) * SHM_K;
    if (j + 1 < NT) { KLOAD(j + 1); VLOAD(j + 1); }
    if (PART(j)) {
      f32x16 sx0, sx1; bf16x8 pa0, pa1, pa2, pa3;
      if (DIFF) {
        f32x16 sy0, sy1;
        qkt<0, 4>(sx0, sx1, Kb, qr, r32, hi);
        qkt<4, 8>(sy0, sy1, Kb, qr, r32, hi);
#pragma unroll
        for (int r = 0; r < 16; ++r) {
          const float e0 = __builtin_amdgcn_exp2f(sx0[r] * CS - K0), e1 = __builtin_amdgcn_exp2f(sx1[r] * CS - K0);
          const float f0 = __builtin_amdgcn_exp2f(sy0[r] * CS - K1), f1 = __builtin_amdgcn_exp2f(sy1[r] * CS - K1);
          sx0[r] = e0 - c1 * f0; sx1[r] = e1 - c1 * f1; }
      } else {
        qkt<0, 8>(sx0, sx1, Kb, qr, r32, hi);
        NA_FIX(sx0, sx1, j);
#pragma unroll
        for (int r = 0; r < 16; ++r) { sx0[r] = __builtin_amdgcn_exp2f(sx0[r] - K0); sx1[r] = __builtin_amdgcn_exp2f(sx1[r] - K0); }
      }
      PK4(sx0, 0, pa0); PK4(sx0, 8, pa1); PK4(sx1, 0, pa2); PK4(sx1, 8, pa3);
      pv_d0(o, vb0 + (j & 1) * SHM_V, pa0, pa1, pa2, pa3);
    }
    if (j + 1 < NT) { KWRITE((j + 1) & 1); VWRITE((j + 1) & 1); }
    __syncthreads();
  }
  const int orow0 = u.qrow0 + wid * 32;
  float sw[4];
#pragma unroll
  for (int d0 = 0; d0 < 4; ++d0) sw[d0] = DIFF ? subln_w[32 * d0 + r32] * oml : 1.f;
#pragma unroll
  for (int r = 0; r < 16; ++r) {
    const int row = orow0 + crow(r, hi);
    float rn = 1.f;
    if (DIFF) { float ss = (o[0][r] * o[0][r] + o[1][r] * o[1][r]) + (o[2][r] * o[2][r] + o[3][r] * o[3][r]);
      ss += __shfl_xor(ss, 1); ss += __shfl_xor(ss, 2); ss += __shfl_xor(ss, 4); ss += __shfl_xor(ss, 8); ss += __shfl_xor(ss, 16);
      rn = __builtin_amdgcn_rsqf(ss * (1.f / 128.f) + 1e-5f); }
#pragma unroll
    for (int d0 = 0; d0 < 4; ++d0) {
      const float g = bf2f(P[(size_t)row * INW + u.cg + 32 * d0 + r32]);
      MG[(size_t)row * DM + u.co + 32 * d0 + r32] = (bf16_t)f2bf(o[d0][r] * rn * sw[d0] * silu_e2(g)); }
  }
#undef TROW
#undef KLOAD
#undef VLOAD
#undef KWRITE
#undef VWRITE
#undef NA_FIX
#undef PART
}

constexpr float DIFF_THR = 8.f;
__device__ __forceinline__ void attn_unit_diff1p(const bf16_t* __restrict__ P, const bf16_t* __restrict__ QKV, bf16_t* __restrict__ MG, LAS unsigned char* lds, int tid, const UnitDesc u,
                                                 const float* __restrict__ lamp, const float* __restrict__ subln_w) {
  asm volatile("" : "+v"(tid));
  const int wid = __builtin_amdgcn_readfirstlane(tid >> 6), lane = tid & 63, r32 = lane & 31, hi = lane >> 5, sub = wid & 1, rb = wid >> 1;
  LAS unsigned char* V_lds = lds; LAS unsigned char* K_lds = lds + 2 * SHM_V;
  LAS float* sc_l = (LAS float*)(lds + 4 * SHM_V) + wid * 64;
  constexpr float CS = 0.125f * LOG2E;
  bf16x8 qr[2][4];
#pragma unroll
  for (int a_ = 0; a_ < 2; ++a_) { const bf16_t* Qw = QKV + ((size_t)u.tq * NROW + u.qrow0 + rb * 64 + a_ * 32 + r32) * 128 + sub * 64 + hi * 8;
#pragma unroll
    for (int d = 0; d < 4; ++d) qr[a_][d] = *reinterpret_cast<const bf16x8*>(Qw + d * 16); }
  const int vb0 = (int)(uintptr_t)V_lds + v_rd_base(lane);
  const int NT = 4 + u.nlt;
  unsigned gk[2], gv[2];
#pragma unroll
  for (int i = 0; i < 2; ++i) { const int q = 64 * wid + 512 * i + lane, row = q >> 4, cx_ = (q & 15) ^ (row & 7); gk[i] = (unsigned)(row * 128 + cx_ * 8) * 2u;
    const int st = q >> 5, kk = 8 * (st >> 2) + ((q & 31) >> 2), c = 32 * (st & 3) + 8 * (q & 3), k = (kk & ~0xC) | ((kk & 4) << 1) | ((kk & 8) >> 1); gv[i] = (unsigned)(k * 128 + c) * 2u; }
#define TROW(j) ((j) < 4 ? u.krow_ctx + 64 * (j) : u.krow_lat + 64 * (u.lt0 + (j) - 4))
#define KVDMA(j, b) do { const char* kb_ = (const char*)(QKV + ((size_t)u.tk * NROW + TROW(j)) * 128); const char* vb_ = (const char*)(QKV + ((size_t)u.tv * NROW + TROW(j)) * 128); _Pragma("unroll") for (int i = 0; i < 2; ++i) { \
    __builtin_amdgcn_global_load_lds((const unsigned*)(kb_ + gk[i]), (LAS unsigned*)(K_lds + (b) * SHM_K + wid * 1024 + i * 8192), 16, 0, 0); \
    __builtin_amdgcn_global_load_lds((const unsigned*)(vb_ + gv[i]), (LAS unsigned*)(V_lds + (b) * SHM_V + wid * 1024 + i * 8192), 16, 0, 0); } } while (0)
#define DMA_WAIT_BAR() do { asm volatile("s_waitcnt vmcnt(0)" ::: "memory"); __syncthreads(); } while (0)
  f32x16 o[2][4] = {};
  float mrun[2] = {-1e30f, -1e30f}, lsum[2] = {0.f, 0.f};
  __syncthreads();
  KVDMA(0, 0);
  DMA_WAIT_BAR();
  for (int j = 0; j < NT; ++j) {
    if (j + 1 < NT) KVDMA(j + 1, (j + 1) & 1);
    const LAS unsigned char* Kb = K_lds + (j & 1) * SHM_K;
    const int vb = vb0 + (j & 1) * SHM_V;
#pragma unroll
    for (int hf = 0; hf < 2; ++hf) {
      f32x16 s0 = {}, s1 = {};
#pragma unroll
      for (int d = 0; d < 4; ++d) { const bf16x8 kf = *reinterpret_cast<const LAS bf16x8*>(Kb + KSWZ(32 * hf + r32, sub * 128 + (d * 16 + hi * 8) * 2));
        s0 = __builtin_amdgcn_mfma_f32_32x32x16_bf16(kf, qr[0][d], s0, 0, 0, 0);
        s1 = __builtin_amdgcn_mfma_f32_32x32x16_bf16(kf, qr[1][d], s1, 0, 0, 0); }
      bf16x8 pl0, ph0, pl1, ph1;
#define SOFTMAX(S, A, PL, PH) do { float tm_ = S[0]; _Pragma("unroll") for (int r = 1; r < 16; ++r) tm_ = fmaxf(tm_, S[r]); tm_ *= CS; \
      { const auto sw_ = __builtin_amdgcn_permlane32_swap(__float_as_uint(tm_), __float_as_uint(tm_), false, false); tm_ = fmaxf(__uint_as_float(sw_[0]), __uint_as_float(sw_[1])); } \
      if (__builtin_expect(__any(tm_ > mrun[A] + DIFF_THR), 0)) { const float mn_ = fmaxf(mrun[A], tm_), al_ = __builtin_amdgcn_exp2f(mrun[A] - mn_); mrun[A] = mn_; lsum[A] *= al_; \
        if (hi == 0) sc_l[r32] = al_; asm volatile("s_waitcnt lgkmcnt(0)" ::: "memory"); \
        _Pragma("unroll") for (int rq = 0; rq < 4; ++rq) { _Pragma("unroll") for (int ri = 0; ri < 4; ++ri) { const float f_ = sc_l[crow(4 * rq + ri, hi)]; _Pragma("unroll") for (int d0 = 0; d0 < 4; ++d0) o[A][d0][4 * rq + ri] *= f_; } \
          asm volatile("" ::: "memory"); } } \
      { const float nm_ = -mrun[A]; float su_ = 0.f; _Pragma("unroll") for (int r = 0; r < 16; ++r) { S[r] = __builtin_amdgcn_exp2f(fmaf(S[r], CS, nm_)); su_ += S[r]; } lsum[A] += su_; } \
      PK4(S, 0, PL); PK4(S, 8, PH); } while (0)
      SOFTMAX(s0, 0, pl0, ph0);
      SOFTMAX(s1, 1, pl1, ph1);
#pragma unroll
      for (int d0 = 0; d0 < 4; ++d0) {
        const s16x4 l0 = __builtin_amdgcn_ds_read_tr16_b64_v4i16((LAS s16x4*)(unsigned)(vb + d0 * 512 + (2 * hf) * 4096)), h0 = __builtin_amdgcn_ds_read_tr16_b64_v4i16((LAS s16x4*)(unsigned)(vb + d0 * 512 + (2 * hf) * 4096 + 2048));
        const s16x4 l1 = __builtin_amdgcn_ds_read_tr16_b64_v4i16((LAS s16x4*)(unsigned)(vb + d0 * 512 + (2 * hf + 1) * 4096)), h1 = __builtin_amdgcn_ds_read_tr16_b64_v4i16((LAS s16x4*)(unsigned)(vb + d0 * 512 + (2 * hf + 1) * 4096 + 2048));
        const bf16x8 v0 = (bf16x8){l0[0], l0[1], l0[2], l0[3], h0[0], h0[1], h0[2], h0[3]}, v1 = (bf16x8){l1[0], l1[1], l1[2], l1[3], h1[0], h1[1], h1[2], h1[3]};
        o[0][d0] = __builtin_amdgcn_mfma_f32_32x32x16_bf16(pl0, v0, o[0][d0], 0, 0, 0); o[1][d0] = __builtin_amdgcn_mfma_f32_32x32x16_bf16(pl1, v0, o[1][d0], 0, 0, 0);
        o[0][d0] = __builtin_amdgcn_mfma_f32_32x32x16_bf16(ph0, v1, o[0][d0], 0, 0, 0); o[1][d0] = __builtin_amdgcn_mfma_f32_32x32x16_bf16(ph1, v1, o[1][d0], 0, 0, 0);
      }
#undef SOFTMAX
    }
    DMA_WAIT_BAR();
  }
  const float lamv = sub ? lamp[0] : 1.f;
#pragma unroll
  for (int a_ = 0; a_ < 2; ++a_) { const float lt = lsum[a_] + __shfl_xor(lsum[a_], 32), f = lamv * __builtin_amdgcn_rcpf(lt);
    if (hi == 0) sc_l[r32] = f; asm volatile("s_waitcnt lgkmcnt(0)" ::: "memory");
#pragma unroll
    for (int rq = 0; rq < 4; ++rq) {
#pragma unroll
      for (int ri = 0; ri < 4; ++ri) { const float f_ = sc_l[crow(4 * rq + ri, hi)];
#pragma unroll
        for (int d0 = 0; d0 < 4; ++d0) o[a_][d0][4 * rq + ri] *= f_; }
      asm volatile("" ::: "memory"); }
    asm volatile("s_waitcnt lgkmcnt(0)" ::: "memory"); }
  LAS float* xs = (LAS float*)lds;
  __syncthreads();
#pragma unroll
  for (int d0 = 0; d0 < 4; ++d0)
#pragma unroll
    for (int r = 0; r < 16; ++r) xs[wid * 4096 + (d0 * 16 + r) * 64 + lane] = sub ? o[0][d0][r] : o[1][d0][r];
  __syncthreads();
  f32x16 fo[4];
#pragma unroll
  for (int d0 = 0; d0 < 4; ++d0)
#pragma unroll
    for (int r = 0; r < 16; ++r) { const float pv_ = xs[(wid ^ 1) * 4096 + (d0 * 16 + r) * 64 + lane]; fo[d0][r] = sub ? (pv_ - o[1][d0][r]) : (o[0][d0][r] - pv_); }
  __syncthreads();
  int tid2 = tid; asm volatile("" : "+v"(tid2));
  const int lane2 = tid2 & 63, c32 = lane2 & 31, h2 = lane2 >> 5;
  const int orow0 = u.qrow0 + rb * 64 + sub * 32;
  float sw[4]; const float oml = lamp[2];
#pragma unroll
  for (int d0 = 0; d0 < 4; ++d0) sw[d0] = subln_w[32 * d0 + c32] * oml;
#pragma unroll
  for (int r = 0; r < 16; ++r) {
    const int row = orow0 + crow(r, h2);
    float ss = (fo[0][r] * fo[0][r] + fo[1][r] * fo[1][r]) + (fo[2][r] * fo[2][r] + fo[3][r] * fo[3][r]);
    ss += __shfl_xor(ss, 1); ss += __shfl_xor(ss, 2); ss += __shfl_xor(ss, 4); ss += __shfl_xor(ss, 8); ss += __shfl_xor(ss, 16);
    const float rn = __builtin_amdgcn_rsqf(ss * (1.f / 128.f) + 1e-5f);
#pragma unroll
    for (int d0 = 0; d0 < 4; ++d0) {
      const float g = bf2f(P[(size_t)row * INW + u.cg + 32 * d0 + c32]);
      MG[(size_t)row * DM + u.co + 32 * d0 + c32] = (bf16_t)f2bf(fo[d0][r] * rn * sw[d0] * silu_e2(g)); }
  }
#undef TROW
#undef KVDMA
#undef DMA_WAIT_BAR
}

__device__ __forceinline__ void attn_unit_na1p(const bf16_t* __restrict__ P, const bf16_t* __restrict__ QKV, bf16_t* __restrict__ MG, LAS unsigned char* lds, int tid, const UnitDesc u,
                                               const float* __restrict__ rpb_h) {
  asm volatile("" : "+v"(tid));
  const int wid = __builtin_amdgcn_readfirstlane(tid >> 6), lane = tid & 63, r32 = lane & 31, hi = lane >> 5;
  LAS unsigned char* V_lds = lds; LAS unsigned char* K_lds = lds + 2 * SHM_V; LAS float* bias_l = (LAS float*)(lds + 4 * SHM_V);
  LAS float* sc_l = (LAS float*)(lds + 4 * SHM_V + 2048) + wid * 64;
  constexpr float CS = 0.08838834764831845f * LOG2E;
  bf16x8 qr[8];
  { const bf16_t* Qw = QKV + ((size_t)u.tq * NROW + u.qrow0 + wid * 32 + r32) * 128 + hi * 8;
#pragma unroll
    for (int d0 = 0; d0 < 8; ++d0) qr[d0] = *reinterpret_cast<const bf16x8*>(Qw + d0 * 16); }
  const int grow = ((u.qrow0 & 2047) >> 6) + (wid >> 1), cqx = 32 * (wid & 1) + r32;
  const int r0 = min(max(grow - 4, 0), 24), c0 = min(max(cqx - 8, 0), 48);
  const bool na = u.na != 0;
  __syncthreads();
  if (na && tid < 465) bias_l[tid] = rpb_h[tid] * LOG2E;
  const int vb0 = (int)(uintptr_t)V_lds + v_rd_base(lane);
  const int NT = 4 + u.nlt;
  unsigned gk[2], gv[2];
#pragma unroll
  for (int i = 0; i < 2; ++i) { const int q = 64 * wid + 512 * i + lane, row = q >> 4, cx_ = (q & 15) ^ (row & 7); gk[i] = (unsigned)(row * 128 + cx_ * 8) * 2u;
    const int st = q >> 5, kk = 8 * (st >> 2) + ((q & 31) >> 2), c = 32 * (st & 3) + 8 * (q & 3), k = (kk & ~0xC) | ((kk & 4) << 1) | ((kk & 8) >> 1); gv[i] = (unsigned)(k * 128 + c) * 2u; }
#define TROW(j) ((j) < 4 ? u.krow_ctx + 64 * (j) : u.krow_lat + 64 * (u.lt0 + (j) - 4))
#define KVDMA(j, b) do { const char* kb_ = (const char*)(QKV + ((size_t)u.tk * NROW + TROW(j)) * 128); const char* vb_ = (const char*)(QKV + ((size_t)u.tv * NROW + TROW(j)) * 128); _Pragma("unroll") for (int i = 0; i < 2; ++i) { \
    __builtin_amdgcn_global_load_lds((const unsigned*)(kb_ + gk[i]), (LAS unsigned*)(K_lds + (b) * SHM_K + wid * 1024 + i * 8192), 16, 0, 0); \
    __builtin_amdgcn_global_load_lds((const unsigned*)(vb_ + gv[i]), (LAS unsigned*)(V_lds + (b) * SHM_V + wid * 1024 + i * 8192), 16, 0, 0); } } while (0)
#define DMA_WAIT_BAR() do { asm volatile("s_waitcnt vmcnt(0)" ::: "memory"); __syncthreads(); } while (0)
  f32x16 o[4] = {};
  float mrun = -1e30f, lsum = 0.f;
  KVDMA(0, 0);
  DMA_WAIT_BAR();
  for (int j = 0; j < NT; ++j) {
    if (j + 1 < NT) KVDMA(j + 1, (j + 1) & 1);
    const int R = u.lt0 + j - 4;
    if (!na || j < 4 || (R >= r0 && R < r0 + 8)) {
      const LAS unsigned char* Kb = K_lds + (j & 1) * SHM_K; const int vb = vb0 + (j & 1) * SHM_V;
      f32x16 s0 = {}, s1 = {};
#pragma unroll
      for (int d0 = 0; d0 < 8; ++d0) { const int cb = (d0 * 16 + hi * 8) * 2;
        s0 = __builtin_amdgcn_mfma_f32_32x32x16_bf16(*reinterpret_cast<const LAS bf16x8*>(Kb + KSWZ(r32, cb)), qr[d0], s0, 0, 0, 0);
        s1 = __builtin_amdgcn_mfma_f32_32x32x16_bf16(*reinterpret_cast<const LAS bf16x8*>(Kb + KSWZ(32 + r32, cb)), qr[d0], s1, 0, 0, 0); }
      if (na && j >= 4) { const int bb = (R - grow + 7) * 31 + 15 - cqx;
#pragma unroll
        for (int r = 0; r < 16; ++r) { const int ck0 = crow(r, hi), ck1 = 32 + ck0; const bool v0 = (ck0 >= c0) && (ck0 < c0 + 16), v1 = (ck1 >= c0) && (ck1 < c0 + 16);
          const float b0 = bias_l[v0 ? bb + ck0 : 0], b1 = bias_l[v1 ? bb + ck1 : 0];
          s0[r] = v0 ? fmaf(s0[r], CS, b0) : -1e30f; s1[r] = v1 ? fmaf(s1[r], CS, b1) : -1e30f; } }
      else {
#pragma unroll
        for (int r = 0; r < 16; ++r) { s0[r] *= CS; s1[r] *= CS; } }
      float tm = s0[0];
#pragma unroll
      for (int r = 1; r < 16; ++r) tm = fmaxf(tm, s0[r]);
#pragma unroll
      for (int r = 0; r < 16; ++r) tm = fmaxf(tm, s1[r]);
      { const auto sw_ = __builtin_amdgcn_permlane32_swap(__float_as_uint(tm), __float_as_uint(tm), false, false); tm = fmaxf(__uint_as_float(sw_[0]), __uint_as_float(sw_[1])); }
      if (__builtin_expect(__any(tm > mrun + DIFF_THR), 0)) { const float mn = fmaxf(mrun, tm), al = __builtin_amdgcn_exp2f(mrun - mn); mrun = mn; lsum *= al;
        if (hi == 0) sc_l[r32] = al; asm volatile("s_waitcnt lgkmcnt(0)" ::: "memory");
#pragma unroll
        for (int rq = 0; rq < 4; ++rq) {
#pragma unroll
          for (int ri = 0; ri < 4; ++ri) { const float f_ = sc_l[crow(4 * rq + ri, hi)];
#pragma unroll
            for (int d0 = 0; d0 < 4; ++d0) o[d0][4 * rq + ri] *= f_; }
          asm volatile("" ::: "memory"); } }
      { float su = 0.f;
#pragma unroll
        for (int r = 0; r < 16; ++r) { s0[r] = __builtin_amdgcn_exp2f(s0[r] - mrun); s1[r] = __builtin_amdgcn_exp2f(s1[r] - mrun); su += s0[r] + s1[r]; }
        lsum += su; }
      bf16x8 pa0, pa1, pa2, pa3;
      PK4(s0, 0, pa0); PK4(s0, 8, pa1); PK4(s1, 0, pa2); PK4(s1, 8, pa3);
      pv_d0(o, vb, pa0, pa1, pa2, pa3);
    }
    DMA_WAIT_BAR();
  }
  { const float lt = lsum + __shfl_xor(lsum, 32), f = __builtin_amdgcn_rcpf(lt);
    if (hi == 0) sc_l[r32] = f; asm volatile("s_waitcnt lgkmcnt(0)" ::: "memory");
#pragma unroll
    for (int rq = 0; rq < 4; ++rq) {
#pragma unroll
      for (int ri = 0; ri < 4; ++ri) { const float f_ = sc_l[crow(4 * rq + ri, hi)];
#pragma unroll
        for (int d0 = 0; d0 < 4; ++d0) o[d0][4 * rq + ri] *= f_; }
      asm volatile("" ::: "memory"); } }
  int tid2 = tid; asm volatile("" : "+v"(tid2));
  const int lane2 = tid2 & 63, c32 = lane2 & 31, h2 = lane2 >> 5;
  const int orow0 = u.qrow0 + wid * 32;
#pragma unroll
  for (int r = 0; r < 16; ++r) {
    const int row = orow0 + crow(r, h2);
#pragma unroll
    for (int d0 = 0; d0 < 4; ++d0) {
      const float g = bf2f(P[(size_t)row * INW + u.cg + 32 * d0 + c32]);
      MG[(size_t)row * DM + u.co + 32 * d0 + c32] = (bf16_t)f2bf(o[d0][r] * silu_e2(g)); }
  }
#undef TROW
#undef KVDMA
#undef DMA_WAIT_BAR
}
}


__device__ __forceinline__ void ph_attn(const bf16_t* P, const bf16_t* QKV, bf16_t* MG, const float* subln_w, const float* rpb_l, const float* lamp, bool with_ctx, LAS unsigned char* lds, int wave0, int bid, int G) {
#define UNIT_TID() int tid; asm volatile("v_mbcnt_lo_u32_b32 %0, -1, 0\n\tv_mbcnt_hi_u32_b32 %0, -1, %0" : "=v"(tid)); tid |= (wave0 << 6)
    const int NU = with_ctx ? 864 : 768;
    for (int u = bid; u < NU; u += G) {
        att::UnitDesc d; int h;
        if (u < 768) { const int x = u & 7, j = (u >> 3) & 31, i = u >> 8, pl = (i * 32 + j) >> 3, p = pl * 8 + x, b = p / 12, qb = j & 7; h = p % 12;     d.qrow0 = b * SEQ + qb * 256; d.krow_ctx = NLAT + b * NCTX; d.krow_lat = b * SEQ; d.nlt = 32; }
        else { const int v = u - 768, b = v / 12; h = v % 12; d.qrow0 = NLAT + b * NCTX; d.krow_ctx = NLAT + b * NCTX; d.krow_lat = b * SEQ; d.nlt = 0; }
        d.lt0 = 0; d.tq = h; d.tk = 12 + h; d.tv = 24 + h; d.cg = C_GA + h * 128; d.co = h * 128; d.na = 0;
        UNIT_TID(); att::attn_unit_diff1p(P, QKV, MG, lds, tid, d, lamp, subln_w);
    }
    for (int u = bid; u < NU; u += G) {
        att::UnitDesc d; int h;
        if (u < 768) { const int x = u & 7, j = (u >> 3) & 31, i = u >> 8, pl = (i * 32 + j) >> 3, p = pl * 8 + x, b = p / 12, g = j & 7; h = p % 12; d.qrow0 = b * SEQ + g * 256; d.krow_ctx = NLAT + b * NCTX; d.krow_lat = b * SEQ;
                       d.lt0 = (g == 0) ? 0 : (g == 7 ? 24 : 4 * g - 4); d.nlt = (g == 0 || g == 7) ? 8 : 11; d.na = 1; }
        else { const int v = u - 768, b = v / 12; h = v % 12; d.qrow0 = NLAT + b * NCTX; d.krow_ctx = NLAT + b * NCTX; d.krow_lat = b * SEQ; d.lt0 = 0; d.nlt = 0; d.na = 0; }
        d.tq = 36 + h; d.tk = 48 + h; d.tv = 60 + h; d.cg = C_GB + h * 128; d.co = 1536 + h * 128;
        UNIT_TID(); att::attn_unit_na1p(P, QKV, MG, lds, tid, d, rpb_l + h * 465);
    }
    __syncthreads();
#undef UNIT_TID
}

__device__ __forceinline__ void ph_rglru(const bf16_t* __restrict__ P, const float* __restrict__ conv_w, const float* __restrict__ conv_b, const float* __restrict__ wa, const float* __restrict__ ba,
                                         const float* __restrict__ wx, const float* __restrict__ bx, const float* __restrict__ rlam, bf16_t* __restrict__ HH, LAS unsigned char* lds, int tid, int bid, int G) {
    using att::bf16x8; using att::f32x16;
    LAS float* U32 = (LAS float*)lds;
    LAS bf16_t* Ub = (LAS bf16_t*)(lds + 32768);
    LAS bf16_t* WTa = (LAS bf16_t*)(lds + 51200);
    LAS bf16_t* WTx = (LAS bf16_t*)(lds + 60416);
    LAS float* A_l = (LAS float*)(lds + 69632);
    LAS float* XP = (LAS float*)(lds + 102400);
    LAS float* XH = XP + 512;
    LAS float* CR = XH + 512;
    const int wid = __builtin_amdgcn_readfirstlane(tid >> 6), lane = tid & 63, r32 = lane & 31, hi = lane >> 5, ch = lane, rt = wid >> 1, ct = wid & 1;
    for (int it = bid; it < 256; it += G) {
        const int d = it & 1, n = (it >> 1) & 15, b = it >> 5;
        __syncthreads();
        { const float* wa_ = wa + (size_t)((d * 16 + n) * 64) * 64; const float* wx_ = wx + (size_t)((d * 16 + n) * 64) * 64;
          for (int e = tid; e < 4096; e += 512) { const int i = e >> 6, j = e & 63; WTa[j * 72 + i] = (bf16_t)f2bf(wa_[e]); WTx[j * 72 + i] = (bf16_t)f2bf(wx_[e]); } }
        if (tid < 64) CR[tid] = 0.f;
        const int cch = n * 64 + 32 * ct + r32;
        const float bav = ba[d * 1024 + cch], bxv = bx[d * 1024 + cch], xl = -rlam[d * 1024 + cch], ey = __builtin_amdgcn_exp2f(xl * 1.4426950408889634f), spv = xl > 20.f ? xl : (ey < 0.01f ? ey * (1.f + ey * (-0.5f + ey * 0.33333334f)) : __builtin_amdgcn_logf(1.f + ey) * 0.6931471805599453f);
        const float cw0 = conv_w[n * 64 + ch], cw1 = conv_w[1024 + n * 64 + ch], cw2 = conv_w[2048 + n * 64 + ch], cw3 = conv_w[3072 + n * 64 + ch], cbv = conv_b[n * 64 + ch];
        unsigned short xr[19];
#define RG_GEOM(cc_) const bool isctx = (cc_) < 2; const int nch = isctx ? 2 : 16, ci = isctx ? (cc_) : (cc_) - 2, c = d ? nch - 1 - ci : ci; \
            const int len = isctx ? NCTX : SEQ, rowbase = isctx ? NLAT + b * NCTX : b * SEQ, t0 = c * 128
#define RG_LOADX(cc_) do { RG_GEOM(cc_); const int tb = t0 + 16 * wid; _Pragma("unroll") for (int k = 0; k < 19; ++k) { const int t = tb + k - 2; \
            xr[k] = (t >= 0 && t < len) ? P[(size_t)(rowbase + t) * INW + C_XC + n * 64 + ch] : (unsigned short)0; } } while (0)
        RG_LOADX(0);
        for (int cc = 0; cc < 18; ++cc) {
            RG_GEOM(cc); (void)len;
            {
                float xv[19];
#pragma unroll
                for (int k = 0; k < 19; ++k) xv[k] = bf2f(xr[k]);
                if (cc + 1 < 18) RG_LOADX(cc + 1);
#pragma unroll
                for (int i = 0; i < 16; ++i) { const float u = cbv + cw0 * xv[i] + cw1 * xv[i + 1] + cw2 * xv[i + 2] + cw3 * xv[i + 3];
                    U32[(16 * wid + i) * 64 + ch] = u; Ub[(16 * wid + i) * 72 + ch] = (bf16_t)f2bf(u); }
            }
            __syncthreads();
            {
                f32x16 pr = {}, pi = {};
#pragma unroll
                for (int kk = 0; kk < 4; ++kk) {
                    const bf16x8 af = *reinterpret_cast<const LAS bf16x8*>(Ub + (32 * rt + r32) * 72 + kk * 16 + hi * 8);
                    const bf16x8 wf = *reinterpret_cast<const LAS bf16x8*>(WTa + (32 * ct + r32) * 72 + kk * 16 + hi * 8);
                    const bf16x8 xf = *reinterpret_cast<const LAS bf16x8*>(WTx + (32 * ct + r32) * 72 + kk * 16 + hi * 8);
                    pr = __builtin_amdgcn_mfma_f32_32x32x16_bf16(af, wf, pr, 0, 0, 0);
                    pi = __builtin_amdgcn_mfma_f32_32x32x16_bf16(af, xf, pi, 0, 0, 0); }
#pragma unroll
                for (int r = 0; r < 16; ++r) { const int idx = (32 * rt + att::crow(r, hi)) * 64 + 32 * ct + r32; const float u = U32[idx];
                    const float rg = __builtin_amdgcn_rcpf(1.f + __builtin_amdgcn_exp2f(-(pr[r] + bav) * 1.4426950408889634f)), ig = __builtin_amdgcn_rcpf(1.f + __builtin_amdgcn_exp2f(-(pi[r] + bxv) * 1.4426950408889634f));
                    const float la = -8.f * rg * spv, x2 = 2.f * la;
                    const float tay = x2 * (1.f + x2 * (0.5f + x2 * (0.16666667f + x2 * (0.041666668f + x2 * 0.0083333338f))));
                    const float em1 = (x2 > -0.125f) ? tay : (__builtin_amdgcn_exp2f(x2 * 1.4426950408889634f) - 1.f);
                    A_l[idx] = __builtin_amdgcn_exp2f(la * 1.4426950408889634f); U32[idx] = __builtin_amdgcn_sqrtf(-em1) * (ig * u); }
            }
            __syncthreads();
            {
                float av[16], bv[16]; float ap = 1.f, hl = 0.f;
#pragma unroll
                for (int s = 0; s < 16; ++s) { const int sd = 16 * wid + s, tl = d ? 127 - sd : sd; av[s] = A_l[tl * 64 + ch]; bv[s] = U32[tl * 64 + ch]; hl = av[s] * hl + bv[s]; ap *= av[s]; }
                XP[wid * 64 + ch] = ap; XH[wid * 64 + ch] = hl;
                __syncthreads();
                float h = CR[ch];
                for (int s2 = 0; s2 < wid; ++s2) h = XP[s2 * 64 + ch] * h + XH[s2 * 64 + ch];
#pragma unroll
                for (int s = 0; s < 16; ++s) { h = av[s] * h + bv[s]; const int sd = 16 * wid + s, tl = d ? 127 - sd : sd;
                    HH[((size_t)d * NROW + rowbase + t0 + tl) * 1024 + n * 64 + ch] = f2bf(h); }
                __syncthreads();
                if (wid == 7) CR[ch] = h;
            }
        }
    }
    __syncthreads();
#undef RG_GEOM
#undef RG_LOADX
}
__device__ __forceinline__ void ph_mergeC(const bf16_t* P, const bf16_t* HH, bf16_t* MG, int nrow, int tid, int bid, int G) {
    for (size_t gid = (size_t)bid * 512 + tid; gid < (size_t)nrow * 128; gid += (size_t)G * 512) {
        const int row = (int)(gid >> 7), ch = (int)(gid & 127) * 8;
        const v4u a = *(const v4u*)(HH + (size_t)row * 1024 + ch), c = *(const v4u*)(HH + ((size_t)NROW + row) * 1024 + ch);
        const v4u gq = *(const v4u*)(P + (size_t)row * INW + C_GC + ch);
#define MC_LO(x) __uint_as_float((x) << 16)
#define MC_HI(x) __uint_as_float((x) & 0xffff0000u)
        v4u o;
        o.x = pk2((MC_LO(a.x) + MC_LO(c.x)) * silu_f(MC_LO(gq.x)), (MC_HI(a.x) + MC_HI(c.x)) * silu_f(MC_HI(gq.x)));
        o.y = pk2((MC_LO(a.y) + MC_LO(c.y)) * silu_f(MC_LO(gq.y)), (MC_HI(a.y) + MC_HI(c.y)) * silu_f(MC_HI(gq.y)));
        o.z = pk2((MC_LO(a.z) + MC_LO(c.z)) * silu_f(MC_LO(gq.z)), (MC_HI(a.z) + MC_HI(c.z)) * silu_f(MC_HI(gq.z)));
        o.w = pk2((MC_LO(a.w) + MC_LO(c.w)) * silu_f(MC_LO(gq.w)), (MC_HI(a.w) + MC_HI(c.w)) * silu_f(MC_HI(gq.w)));
#undef MC_LO
#undef MC_HI
        *(v4u*)(MG + (size_t)row * DM + 3072 + ch) = o;
    }
}
__device__ __forceinline__ void ph_final(float* X, const bf16_t* X2, const float* w, int wave, int lane, int bid, int G) {
    const int gw = bid * 8 + wave, NGW = G * 8;
    for (int row = gw; row < NLAT; row += NGW) {
        f32x4* xr = (f32x4*)(X + (size_t)row * DM) + lane; const unsigned long long* x2 = (const unsigned long long*)(X2 + (size_t)row * DM) + lane; f32x4 v[16]; float s = 0.f;
#pragma unroll
        for (int j = 0; j < 16; ++j) { const unsigned long long q = x2[64 * j]; const unsigned lo = (unsigned)q, hi = (unsigned)(q >> 32);
            v[j] = (f32x4){__uint_as_float(lo << 16), __uint_as_float(lo & 0xffff0000u), __uint_as_float(hi << 16), __uint_as_float(hi & 0xffff0000u)};
            s += (v[j].x * v[j].x + v[j].y * v[j].y) + (v[j].z * v[j].z + v[j].w * v[j].w); }
        const float rstd = 1.f / sqrtf(wave_sum(s) * (1.f / DM) + 1e-6f);
#pragma unroll
        for (int j = 0; j < 16; ++j) xr[64 * j] = v[j] * rstd * ((const f32x4*)w)[lane + 64 * j];
    }
}

struct Args { const float* in[20]; float* out; unsigned char* ws; };
#define IDS() int t_; asm volatile("v_mbcnt_lo_u32_b32 %0, -1, 0\n\tv_mbcnt_hi_u32_b32 %0, -1, %0" : "=v"(t_)); t_ |= (wave0 << 6); const int ln_ = t_ & 63, wv_ = __builtin_amdgcn_readfirstlane(t_ >> 6); (void)ln_; (void)wv_; \
    int z_ = 0; asm volatile("" : "+v"(z_)); z_ = __builtin_amdgcn_readfirstlane(z_); \
    typedef __attribute__((address_space(4))) const Args CArgs; CArgs* A_ = (CArgs*)((__attribute__((address_space(4))) const char*)__builtin_amdgcn_kernarg_segment_ptr() + z_); unsigned char* ws = A_->ws; (void)ws
#define WSP(T, off) ((T*)(ws + (off)))
constexpr int TR_P0 = 7168, TR_P1 = 16384;
#define TAIL_TRANSPOSE(nunits, lo, hi) do { const int first_idle_ = (nunits) - (((nunits) - 1) / G) * G, nidle_ = G - first_idle_; \
        if (nidle_ > 0 && bid >= first_idle_) { IDS(); ph_transpose(A_->in[7], A_->in[8], WSP(bf16_t, WS_WIN), WSP(bf16_t, WS_WOUT), lds, wv_, ln_, (lo), (hi), (bid - first_idle_) * 8 + wv_, nidle_ * 8); } \
        else if (nidle_ <= 0) { IDS(); ph_transpose(A_->in[7], A_->in[8], WSP(bf16_t, WS_WIN), WSP(bf16_t, WS_WOUT), lds, wv_, ln_, (lo), (hi), bid * 8 + wv_, G * 8); } } while (0)
template <int l> __device__ __forceinline__ void layer(const XcdBarrier& bar, LAS unsigned char* lds, int wave0, int bid, int G) {

        { IDS(); ph_norm<l != 0>(l == 0 ? (const void*)A_->in[0] : (const void*)WSP(bf16_t, WS_X1), A_->in[2], A_->in[6] + l * DM, WSP(float, WS_MOD) + (size_t)l * 9 * 12288, WSP(bf16_t, WS_HX), wv_, ln_, bid, G); }
        xcd_barrier(bar);
        { IDS(); pg8::Gemm g{WSP(bf16_t, WS_HX), WSP(bf16_t, WS_WIN) + (size_t)l * INW * DM, NROW, INW, DM, 0}; pg8::EpiP E{WSP(bf16_t, WS_P), INW, 0, WSP(float, WS_ROPE), WSP(bf16_t, WS_QKV)}; pg8::PrunedOrder S; S.init(l == 0 ? NROW : NLAT, INW, G, bid, l == 0 ? 0 : NB);
          pg8::gemm_phase<pg8::EpiP, pg8::PrunedOrder, true, true>(lds, g, S, E, wave0); }
        if constexpr (l == 0) { TAIL_TRANSPOSE((NROW / 256) * (INW / 256), TR_IL + TR_P0, TR_IL + TR_P1); }
        xcd_barrier(bar);
        { IDS(); ph_rglru(WSP(bf16_t, WS_P), A_->in[12] + l * 4096, A_->in[13] + l * 1024, A_->in[14] + (size_t)l * 2 * 16 * 4096, A_->in[15] + l * 2048, A_->in[16] + (size_t)l * 2 * 16 * 4096, A_->in[17] + l * 2048, A_->in[18] + l * 2048, WSP(bf16_t, WS_HH), lds, t_, bid, G); }
        { IDS(); ph_attn(WSP(bf16_t, WS_P), WSP(bf16_t, WS_QKV), WSP(bf16_t, WS_MG), A_->in[10] + l * 128, A_->in[11] + (size_t)l * 12 * 15 * 31, WSP(float, WS_LAM) + l, l == 0, lds, wave0, bid, G); }
        xcd_barrier(bar);
        { IDS(); ph_mergeC(WSP(bf16_t, WS_P), WSP(bf16_t, WS_HH), WSP(bf16_t, WS_MG), l == 0 ? NROW : NLAT, t_, bid, G); }
        xcd_barrier(bar);
        { IDS(); const int M = l == 0 ? NROW : NLAT; pg8::Gemm g{WSP(bf16_t, WS_MG), WSP(bf16_t, WS_WOUT) + (size_t)l * DM * DM, M, DM, DM, 0};
          pg8::EpiRes2<l != 0> E{l == 0 ? (const void*)A_->in[0] : (const void*)WSP(bf16_t, WS_X1), A_->in[2], l == 0 ? WSP(bf16_t, WS_X1) : WSP(bf16_t, WS_HX), WSP(float, WS_MOD) + (size_t)l * 9 * 12288 + 8192, NLAT, 0}; pg8::StaticOrder S; S.init(M, DM, G, bid);
          pg8::gemm_phase<pg8::EpiRes2<l != 0>, pg8::StaticOrder, true, true>(lds, g, S, E, wave0); }
        if constexpr (l == 0) { TAIL_TRANSPOSE((NROW / 256) * (DM / 256), TR_IL + TR_P1, 2 * TR_IL); }
        xcd_barrier(bar);
    }
__global__ void __launch_bounds__(512, 2) fwd(Args a) {
    extern __shared__ __attribute__((aligned(16))) unsigned char lds_raw[];
    LAS unsigned char* lds = (LAS unsigned char*)lds_raw;
    const int tid = threadIdx.x, G = gridDim.x, bid = blockIdx.x, wave0 = __builtin_amdgcn_readfirstlane(tid >> 6);
    volatile LAS unsigned* MISC = (volatile LAS unsigned*)(lds + MISC_OFF);
    if (tid < 32) MISC[tid] = 0u;
    __syncthreads();
    XcdBarrier bar = xcd_barrier_post((unsigned*)(a.ws + WS_CTL) + CW_BAR, MISC + 8);
    if (bid == 0) { IDS(); ph_small(A_->in[9], WSP(float, WS_ROPE), WSP(float, WS_LAM), t_); }
    { IDS(); ph_mod(A_->in[1], A_->in[3], A_->in[4], A_->in[5], WSP(float, WS_MOD), lds, t_, bid, G); }
    { IDS(); ph_transpose(A_->in[7], A_->in[8], WSP(bf16_t, WS_WIN), WSP(bf16_t, WS_WOUT), lds, wv_, ln_, 0, TR_IL + TR_P0, bid * 8 + wv_, G * 8); }
    xcd_barrier(bar);
    layer<0>(bar, lds, wave0, bid, G);
    layer<1>(bar, lds, wave0, bid, G);
    { IDS(); ph_final(A_->out, WSP(bf16_t, WS_HX), A_->in[19], wv_, ln_, bid, G); }
}

extern "C" void kernel_launch(void* const* d_in, const int* in_sizes, int n_in, void* d_out, int out_size, void* d_ws, size_t ws_size, hipStream_t stream) {
    static int grid = 0;
    if (grid == 0) {
        if (n_in != 20 || in_sizes[0] != NLAT * DM || out_size != NLAT * DM || ws_size < WS_END) { fprintf(stderr, "kernel_launch: shape/workspace mismatch: n_in %d in0 %d out %d ws %zu (need %zu)\n", n_in, n_in > 0 ? in_sizes[0] : -1, out_size, ws_size, (size_t)WS_END); grid = -1; return; }
        int dev = 0, cus = 0, per_cu = 0;
        if (hipGetDevice(&dev) != hipSuccess || hipDeviceGetAttribute(&cus, hipDeviceAttributeMultiprocessorCount, dev) != hipSuccess) { fprintf(stderr, "kernel_launch: device query failed\n"); grid = -1; return; }
        if (hipFuncSetAttribute((const void*)fwd, hipFuncAttributeMaxDynamicSharedMemorySize, LDS_BYTES) != hipSuccess) { fprintf(stderr, "kernel_launch: hipFuncSetAttribute failed\n"); grid = -1; return; }
        if (hipOccupancyMaxActiveBlocksPerMultiprocessor(&per_cu, (const void*)fwd, 512, LDS_BYTES) != hipSuccess || per_cu < 1) { fprintf(stderr, "kernel_launch: occupancy query says %d blocks per CU; nothing launched\n", per_cu); (void)hipGetLastError(); grid = -1; return; }
        grid = cus;
    }
    if (grid < 0) return;
    if (hipMemsetAsync((char*)d_ws + WS_CTL, 0, CTL_ZERO_BYTES, stream) != hipSuccess) { fprintf(stderr, "kernel_launch: memset failed\n"); return; }
    Args a{};
    for (int i = 0; i < 20; ++i) a.in[i] = (const float*)d_in[i];
    a.out = (float*)d_out; a.ws = (unsigned char*)d_ws;
    hipLaunchKernelGGL(fwd, dim3(grid), dim3(512), LDS_BYTES, stream, a);
    const hipError_t le = hipPeekAtLastError();
    if (le != hipSuccess) fprintf(stderr, "kernel_launch: launch failed: %s\n", hipGetErrorName(le));
}
```

```cpp
#include <hip/hip_runtime.h>
#include <cstdio>
#include <cstdint>
#include <cmath>
namespace pg8 {
#define PG8_LAS __attribute__((address_space(3)))
typedef unsigned short bf16_t;
typedef short bf16x8 __attribute__((ext_vector_type(8)));
typedef float f32x4 __attribute__((ext_vector_type(4)));
typedef unsigned u32x4 __attribute__((ext_vector_type(4)));
constexpr int BM = 256, BK = 64, HALF = 128, HTB = HALF * BK * 2  , STAGE_BYTES = 8 * HTB, NXCD = 8, WGM = 8;

__host__ __device__ __forceinline__ int lds_byte(int r, int c) { const int st = (r >> 4) * 2 + (c >> 5), rr = r & 15, cc = c & 31, ob = rr * 64 + cc * 2; return st * 1024 + (ob ^ (((ob >> 9) & 1) << 5)); }
__host__ __device__ __forceinline__ void stage_rc(int b, int& R, int& C) { const int st = b / 1024, sb = b % 1024, swz = sb ^ (((sb >> 9) & 1) << 5); R = (st >> 1) * 16 + swz / 64; C = (st & 1) * 32 + (swz % 64) / 2; }
__host__ __device__ __forceinline__ int perm32(int rho) { const int n = rho >> 4, i = rho & 15; return 8 * (i >> 2) + 4 * n + (i & 3); }

struct Unit { int pm, pn; };
struct Gemm { const bf16_t* A; const bf16_t* Bt; int M, N, K, pad; };

struct StaticOrder {
    int nM, nN, nwg, G, c;
    __host__ __device__ void init(int M, int N, int G_, int c_) { nM = M / BM; nN = N / BM; nwg = nM * nN; G = G_; c = c_; }
    __host__ __device__ bool next(int i, Unit& u) const {
        const long L = (long)i * G + c; if (L >= nwg) return false;
        int wgid = (int)L; { const int q = nwg / NXCD, r = nwg % NXCD, xcd = wgid % NXCD, off = wgid / NXCD; wgid = (xcd < r ? xcd * (q + 1) : r * (q + 1) + (xcd - r) * q) + off; }
        const int nig = WGM * nN, gid = wgid / nig, fm = gid * WGM, gsz = (nM - fm) < WGM ? (nM - fm) : WGM;
        u.pm = fm + ((wgid % nig) % gsz); u.pn = (wgid % nig) / gsz; return true;
    }
    __device__ __forceinline__ void a_ready(const Unit&) const {}
    __device__ __forceinline__ void done(const Unit&) const {}
};

struct PrunedOrder {
    StaticOrder S; int n_main, n_x;
    __host__ __device__ void init(int M_main, int N, int G_, int c_, int n_x_) { S.init(M_main, N, G_, c_); n_main = S.nwg; n_x = n_x_; }
    __host__ __device__ bool next(int i, Unit& u) const {
        const long L = (long)i * S.G + S.c;
        if (L < n_main) return S.next(i, u);
        const int k = (int)(L - n_main); if (k >= n_x * 28) return false;
        const int idx = k % 28; u.pm = S.nM + k / 28; u.pn = idx < 12 ? 6 + idx : (idx < 24 ? 30 + (idx - 12) : 48 + (idx - 24)); return true;
    }
    __device__ __forceinline__ void a_ready(const Unit&) const {}
    __device__ __forceinline__ void done(const Unit&) const {}
};
__device__ __forceinline__ unsigned cvt_pk_bf16(float lo, float hi) { unsigned r; asm volatile("v_cvt_pk_bf16_f32 %0, %1, %2" : "=v"(r) : "v"(lo), "v"(hi)); return r; }

struct EpiP {
    static constexpr bool PERM = true, AFTER_DRAIN = false; static constexpr int NVM = 16;
    bf16_t* O; int ldc, pad; const float* rope;
    bf16_t* QKV;
    __device__ __forceinline__ void operator()(const f32x4 (&acc)[2][2][4][2], const Unit& u, int wr, int wc, int fr_, int fq_) const {
        int lid; asm volatile("v_mbcnt_lo_u32_b32 %0, -1, 0\n\tv_mbcnt_hi_u32_b32 %0, -1, %0" : "=v"(lid)); const int fr = lid & 15, fq = lid >> 4;
        const int rowt = u.pm * BM, colt = u.pn * BM;
        const int row0 = rowt + wr * 64 + fr, col0 = colt + wc * 32 + 8 * fq;
        const bool do_rope = (rowt < 16384) && (colt < 3072);
        const bool hm = (colt < 4608) || (colt >= 6144 && colt < 10752); const int th0 = colt < 4608 ? colt / 128 : 36 + (colt - 6144) / 128; const size_t bjs = hm ? (size_t)18432 * 128 : (size_t)HALF;
        const float sgn = (fq < 2) ? -1.f : 1.f;
        const int ln = fr + 16 * fq, sfr = ln >> 2, sfq = ln & 3, ssrc = (sfr + 16 * sfq) * 4;
        const int srow0 = rowt + wr * 64 + sfr;
#pragma unroll
        for (int ai = 0; ai < 2; ++ai)
#pragma unroll
            for (int m = 0; m < 4; ++m) { const int row = row0 + ai * HALF + m * 16; const int srow = srow0 + ai * HALF + m * 16;
                bf16_t* rowp = hm ? QKV + ((size_t)th0 * 18432 + srow) * 128 + wc * 32 + 8 * sfq : O + (size_t)srow * ldc + colt + wc * 32 + 8 * sfq;
                f32x4 cs[4] = {};
                if (do_rope) { const int pos = (wc & 1) ? (row & 63) : ((row & 2047) >> 6); const f32x4* tp = (const f32x4*)(rope + (pos * 16 + 8 * (fq & 1)) * 2);
#pragma unroll
                    for (int e = 0; e < 4; ++e) cs[e] = tp[e]; }
#pragma unroll
                for (int bj = 0; bj < 2; ++bj) { f32x4 v0 = acc[ai][bj][m][0], v1 = acc[ai][bj][m][1];
                    if (do_rope) {
                        f32x4 o0, o1;
#pragma unroll
                        for (int e = 0; e < 4; ++e) { o0[e] = __shfl_xor(v0[e], 32); o1[e] = __shfl_xor(v1[e], 32); }
                        v0[0] = v0[0] * cs[0][0] + sgn * o0[0] * cs[0][1]; v0[1] = v0[1] * cs[0][2] + sgn * o0[1] * cs[0][3];
                        v0[2] = v0[2] * cs[1][0] + sgn * o0[2] * cs[1][1]; v0[3] = v0[3] * cs[1][2] + sgn * o0[3] * cs[1][3];
                        v1[0] = v1[0] * cs[2][0] + sgn * o1[0] * cs[2][1]; v1[1] = v1[1] * cs[2][2] + sgn * o1[1] * cs[2][3];
                        v1[2] = v1[2] * cs[3][0] + sgn * o1[2] * cs[3][1]; v1[3] = v1[3] * cs[3][2] + sgn * o1[3] * cs[3][3];
                    }
                    u32x4 w; w.x = cvt_pk_bf16(v0[0], v0[1]); w.y = cvt_pk_bf16(v0[2], v0[3]); w.z = cvt_pk_bf16(v1[0], v1[1]); w.w = cvt_pk_bf16(v1[2], v1[3]);
                    u32x4 ws; ws.x = (unsigned)__builtin_amdgcn_ds_bpermute(ssrc, (int)w.x); ws.y = (unsigned)__builtin_amdgcn_ds_bpermute(ssrc, (int)w.y);
                    ws.z = (unsigned)__builtin_amdgcn_ds_bpermute(ssrc, (int)w.z); ws.w = (unsigned)__builtin_amdgcn_ds_bpermute(ssrc, (int)w.w);
                    *(u32x4*)(rowp + bj * bjs) = ws; } }
    }
};
struct EpiRes {
    static constexpr bool PERM = false, AFTER_DRAIN = false; static constexpr int NVM = 32;
    const float* res_lat; const float* res_ctx; float* out_lat; float* out_ctx; const float* gate; int nlat, pad;
    __device__ __forceinline__ void operator()(const f32x4 (&acc)[2][2][4][2], const Unit& u, int wr, int wc, int fr_, int fq_) const {
        int lid; asm volatile("v_mbcnt_lo_u32_b32 %0, -1, 0\n\tv_mbcnt_hi_u32_b32 %0, -1, %0" : "=v"(lid)); const int fr = lid & 15, fq = lid >> 4;
        const int rowt = u.pm * BM; const bool isctx = rowt >= nlat; const int gr = isctx ? 8 : (rowt >> 11);
        const float* res = isctx ? res_ctx : res_lat; float* out = isctx ? out_ctx : out_lat;
        const int lrow0 = (isctx ? rowt - nlat : rowt) + wr * 64 + fr, col0 = u.pn * BM + wc * 32 + 4 * fq;
        f32x4 gv[2][2];
#pragma unroll
        for (int bj = 0; bj < 2; ++bj)
#pragma unroll
            for (int n = 0; n < 2; ++n) gv[bj][n] = *(const f32x4*)(gate + (size_t)gr * 12288 + col0 + bj * HALF + n * 16);
#pragma unroll
        for (int ai = 0; ai < 2; ++ai)
#pragma unroll
            for (int m = 0; m < 4; ++m) { const size_t off = (size_t)(lrow0 + ai * HALF + m * 16) * 4096 + col0;
#pragma unroll
                for (int bj = 0; bj < 2; ++bj)
#pragma unroll
                    for (int n = 0; n < 2; ++n) { const f32x4 rs = *(const f32x4*)(res + off + bj * HALF + n * 16);
                        *(f32x4*)(out + off + bj * HALF + n * 16) = rs + gv[bj][n] * acc[ai][bj][m][n]; } }
    }
};
template <bool RB> struct EpiRes2 {
    static constexpr bool PERM = true, AFTER_DRAIN = false; static constexpr int NVM = 0;
    const void* res_lat; const float* res_ctx; bf16_t* out; const float* gate; int nlat, pad;
    __device__ __forceinline__ void operator()(const f32x4 (&acc)[2][2][4][2], const Unit& u, int wr, int wc, int fr_, int fq_) const {
        int lid; asm volatile("v_mbcnt_lo_u32_b32 %0, -1, 0\n\tv_mbcnt_hi_u32_b32 %0, -1, %0" : "=v"(lid)); const int fr = lid & 15, fq = lid >> 4;
        const int rowt = u.pm * BM, colt = u.pn * BM; const bool isctx = rowt >= nlat; const int gr = isctx ? 8 : (rowt >> 11);
        const int col0 = colt + wc * 32 + 8 * fq, row0 = rowt + wr * 64 + fr;
        const int sfr = lid >> 2, sfq = lid & 3, ssrc = (sfr + 16 * sfq) * 4, srow0 = rowt + wr * 64 + sfr, scol0 = colt + wc * 32 + 8 * sfq;
#pragma unroll
        for (int bj = 0; bj < 2; ++bj) {
            const f32x4 g0 = *(const f32x4*)(gate + (size_t)gr * 12288 + col0 + bj * HALF), g1 = *(const f32x4*)(gate + (size_t)gr * 12288 + col0 + bj * HALF + 4);
#pragma unroll
            for (int ai = 0; ai < 2; ++ai)
#pragma unroll
                for (int m = 0; m < 4; ++m) { const int row = row0 + ai * HALF + m * 16, srow = srow0 + ai * HALF + m * 16; f32x4 r0, r1;
                    if constexpr (RB) { const u32x4 rb = *(const u32x4*)((const bf16_t*)res_lat + (size_t)row * 4096 + col0 + bj * HALF);
                        r0 = (f32x4){__uint_as_float(rb.x << 16), __uint_as_float(rb.x & 0xffff0000u), __uint_as_float(rb.y << 16), __uint_as_float(rb.y & 0xffff0000u)};
                        r1 = (f32x4){__uint_as_float(rb.z << 16), __uint_as_float(rb.z & 0xffff0000u), __uint_as_float(rb.w << 16), __uint_as_float(rb.w & 0xffff0000u)}; }
                    else { const float* rp = (isctx ? res_ctx + (size_t)(row - nlat) * 4096 : (const float*)res_lat + (size_t)row * 4096) + col0 + bj * HALF; r0 = *(const f32x4*)rp; r1 = *(const f32x4*)(rp + 4); }
                    const f32x4 v0 = r0 + g0 * acc[ai][bj][m][0], v1 = r1 + g1 * acc[ai][bj][m][1];
                    u32x4 w; w.x = cvt_pk_bf16(v0[0], v0[1]); w.y = cvt_pk_bf16(v0[2], v0[3]); w.z = cvt_pk_bf16(v1[0], v1[1]); w.w = cvt_pk_bf16(v1[2], v1[3]);
                    u32x4 ws; ws.x = (unsigned)__builtin_amdgcn_ds_bpermute(ssrc, (int)w.x); ws.y = (unsigned)__builtin_amdgcn_ds_bpermute(ssrc, (int)w.y);
                    ws.z = (unsigned)__builtin_amdgcn_ds_bpermute(ssrc, (int)w.z); ws.w = (unsigned)__builtin_amdgcn_ds_bpermute(ssrc, (int)w.w);
                    *(u32x4*)(out + (size_t)srow * 4096 + scol0 + bj * HALF) = ws;
                }
        }
    }
};
template <class Epi, class Sched, bool ALIGN_EPI = false, bool SP2 = false>
__device__ __forceinline__ void gemm_phase(PG8_LAS unsigned char* lds, const Gemm g, const Sched& S, const Epi& E, int wave0) {
    int tid; asm volatile("v_mbcnt_lo_u32_b32 %0, -1, 0\n\tv_mbcnt_hi_u32_b32 %0, -1, %0" : "=v"(tid)); tid |= (wave0 << 6);
    const int wid = __builtin_amdgcn_readfirstlane(tid >> 6), lane = tid & 63, wr = wid >> 2, wc = wid & 3, fr = lane & 15, fq = lane >> 4;
    const int K = g.K, nt = K / BK;
    unsigned voffA[2], voffB[2];
#pragma unroll
    for (int i = 0; i < 2; ++i) { int R, C; stage_rc(tid * 16 + i * 8192, R, C); const int Rb = Epi::PERM ? ((R & ~31) + perm32(R & 31)) : R;
        voffA[i] = (unsigned)(R * K + C) * 2u; voffB[i] = (unsigned)(Rb * K + C) * 2u; }
    const size_t kstep = (size_t)(BK * 2);
    const size_t hstep = (size_t)HALF * K * 2;
    const size_t tstep = 2 * hstep;
    const unsigned ldsw = (unsigned)wid * 1024u;
    const int aoff = lds_byte(wr * 64 + fr, fq * 8), boff = lds_byte(wc * 32 + fr, fq * 8);
#define PG8_SA(b, h) (((b) * 2 + (h)) * HTB)
#define PG8_SB(b, h) ((4 + (b) * 2 + (h)) * HTB)
#define PG8_STAGE(bufoff, gbase, voff) do { _Pragma("unroll") for (int _i = 0; _i < 2; ++_i) \
        __builtin_amdgcn_global_load_lds((const unsigned*)((const char*)(gbase) + (voff)[_i]), (PG8_LAS unsigned*)(lds + (bufoff) + ldsw + _i * 8192), 16, 0, 0); } while (0)
#define PG8_LDA(dst, b, h) do { _Pragma("unroll") for (int m = 0; m < 4; ++m) _Pragma("unroll") for (int k = 0; k < 2; ++k) dst[m][k] = *(const PG8_LAS bf16x8*)(lds + PG8_SA(b, h) + aoff + m * 2048 + k * 1024); } while (0)
#define PG8_LDB(dst, b, h) do { _Pragma("unroll") for (int n = 0; n < 2; ++n) _Pragma("unroll") for (int k = 0; k < 2; ++k) dst[n][k] = *(const PG8_LAS bf16x8*)(lds + PG8_SB(b, h) + boff + n * 2048 + k * 1024); } while (0)
#define PG8_MMA(ai, bj, At, Bt) do { __builtin_amdgcn_s_setprio(1); _Pragma("unroll") for (int m = 0; m < 4; ++m) _Pragma("unroll") for (int n = 0; n < 2; ++n) _Pragma("unroll") for (int k = 0; k < 2; ++k) \
        acc[ai][bj][m][n] = __builtin_amdgcn_mfma_f32_16x16x32_bf16(Bt[n][k], At[m][k], acc[ai][bj][m][n], 0, 0, 0); __builtin_amdgcn_s_setprio(0); } while (0)
#define PG8_WAIT_V(n) asm volatile("s_waitcnt vmcnt(" #n ")" ::: "memory")
#define PG8_WAIT_L(n) asm volatile("s_waitcnt lgkmcnt(" #n ")" ::: "memory")
#define PG8_BAR __builtin_amdgcn_s_barrier()
#define PG8_SCHED __builtin_amdgcn_sched_barrier(0)
    Unit cur, nxt; int ui = 0;
    if (!S.next(0, cur)) return;
    f32x4 acc[2][2][4][2];
#pragma unroll
    for (int a = 0; a < 2; ++a)
#pragma unroll
        for (int b = 0; b < 2; ++b)
#pragma unroll
            for (int m = 0; m < 4; ++m)
#pragma unroll
                for (int n = 0; n < 2; ++n) acc[a][b][m][n] = (f32x4){0.f, 0.f, 0.f, 0.f};
    bf16x8 At[4][2], B0[2][2], B1[2][2];
    const char* cA = (const char*)g.A + (size_t)cur.pm * tstep; const char* cB = (const char*)g.Bt + (size_t)cur.pn * tstep;
    S.a_ready(cur);
    {
        PG8_STAGE(PG8_SB(0, 0), cB, voffB); PG8_STAGE(PG8_SB(0, 1), cB + hstep, voffB); PG8_STAGE(PG8_SA(0, 0), cA, voffA); PG8_STAGE(PG8_SA(0, 1), cA + hstep, voffA);
        PG8_STAGE(PG8_SB(1, 0), cB + kstep, voffB); PG8_STAGE(PG8_SA(1, 0), cA + kstep, voffA); PG8_STAGE(PG8_SB(1, 1), cB + hstep + kstep, voffB); PG8_STAGE(PG8_SA(1, 1), cA + hstep + kstep, voffA);
        if (wr == 1) PG8_BAR;
        PG8_WAIT_V(0); PG8_BAR; PG8_BAR;
    }
    for (;;) {
        const bool has_next = S.next(ui + 1, nxt);
        const char* nA = has_next ? (const char*)g.A + (size_t)nxt.pm * tstep : cA; const char* nB = has_next ? (const char*)g.Bt + (size_t)nxt.pn * tstep : cB;
#define PG8_ITER(t, W, L2) do { \
            const bool last = (L2) && ((t) == nt - 2); \
            const char* a1 = cA + (size_t)((t) + 1) * kstep; \
            const char* a2 = last ? nA : cA + (size_t)((t) + 2) * kstep; const char* b2 = last ? nB : cB + (size_t)((t) + 2) * kstep; \
            const char* a3 = a2 + kstep; const char* b3 = b2 + kstep; \
            if (last && has_next) S.a_ready(nxt); \
            PG8_LDB(B0, 0, 0); PG8_LDB(B1, 0, 1); PG8_SCHED; PG8_LDA(At, 0, 0); if (L2) PG8_STAGE(PG8_SA(1, 1), a1 + hstep, voffA); \
            PG8_WAIT_V(W); PG8_WAIT_L(0); PG8_BAR; PG8_MMA(0, 0, At, B0); PG8_MMA(0, 1, At, B1); PG8_BAR; PG8_SCHED; \
            PG8_LDA(At, 0, 1); PG8_STAGE(PG8_SB(0, 0), b2, voffB); PG8_STAGE(PG8_SB(0, 1), b2 + hstep, voffB); PG8_STAGE(PG8_SA(0, 0), a2, voffA); \
            PG8_WAIT_V(W); PG8_WAIT_L(0); PG8_BAR; PG8_MMA(1, 0, At, B0); PG8_MMA(1, 1, At, B1); PG8_BAR; PG8_SCHED; \
            PG8_LDB(B0, 1, 0); PG8_LDB(B1, 1, 1); PG8_SCHED; PG8_LDA(At, 1, 0); PG8_STAGE(PG8_SA(0, 1), a2 + hstep, voffA); \
            PG8_WAIT_V(W); PG8_WAIT_L(0); PG8_BAR; PG8_MMA(0, 0, At, B0); PG8_MMA(0, 1, At, B1); PG8_BAR; PG8_SCHED; \
            PG8_LDA(At, 1, 1); PG8_STAGE(PG8_SB(1, 0), b3, voffB); PG8_STAGE(PG8_SB(1, 1), b3 + hstep, voffB); PG8_STAGE(PG8_SA(1, 0), a3, voffA); \
            PG8_WAIT_V(8); PG8_WAIT_L(0); PG8_BAR; PG8_MMA(1, 0, At, B0); PG8_MMA(1, 1, At, B1); PG8_BAR; PG8_SCHED; } while (0)
        static_assert(SP2, "only the super-phase schedule is kept");
        if constexpr (Epi::NVM == 16) PG8_ITER(0, 24, 0); else if constexpr (Epi::NVM == 32) PG8_ITER(0, 40, 0);
        for (int t = (Epi::NVM ? 2 : 0); t < nt; t += 2) PG8_ITER(t, 8, 1);
        if constexpr (Epi::NVM != 0) { if (has_next) PG8_STAGE(PG8_SA(1, 1), nA + kstep + hstep, voffA); }
        if constexpr (ALIGN_EPI) { if (wr == 0) PG8_BAR; }
        if constexpr (!Epi::AFTER_DRAIN) { E(acc, cur, wr, wc, fr, fq); S.done(cur); }
        if (!has_next) break;
#pragma unroll
        for (int a = 0; a < 2; ++a)
#pragma unroll
            for (int b = 0; b < 2; ++b)
#pragma unroll
                for (int m = 0; m < 4; ++m)
#pragma unroll
                    for (int n = 0; n < 2; ++n) acc[a][b][m][n] = (f32x4){0.f, 0.f, 0.f, 0.f};
        cur = nxt; cA = nA; cB = nB; ++ui;
        if constexpr (ALIGN_EPI) { if (wr == 1) PG8_BAR; }
    }
    PG8_WAIT_V(0);
    if constexpr (!ALIGN_EPI) { if (wr == 0) PG8_BAR; }
    PG8_BAR;
    if constexpr (Epi::AFTER_DRAIN) { E.fused(acc, cur, wr, wc, fr, fq, lds, wid, lane); S.done(cur); }
#undef PG8_SA
#undef PG8_SB
#undef PG8_STAGE
#undef PG8_LDA
#undef PG8_LDB
#undef PG8_MMA
#undef PG8_WAIT_V
#undef PG8_WAIT_L
#undef PG8_BAR
#undef PG8_SCHED
#undef PG8_ITER
}
}

constexpr int DM = 4096, NB = 8, SEQ = 2048, NCTX = 256, INW = 14336, NLAT = NB * SEQ, NROW = NLAT + NB * NCTX;
constexpr int HEADS = 12;
constexpr int C_QA = 0, C_KA = 1536, C_VA = 3072, C_GA = 4608, C_QB = 6144, C_KB = 7680, C_VB = 9216, C_GB = 10752, C_XC = 12288, C_GC = 13312;
constexpr size_t MiB = 1u << 20;
constexpr size_t WS_CTL = 0, WS_MOD = 1 * MiB, WS_ROPE = 2 * MiB, WS_LAM = 2 * MiB + 65536, WS_WIN = 4 * MiB, WS_WOUT = 228 * MiB, WS_HX = 292 * MiB, WS_P = 436 * MiB,
                 WS_MG = 940 * MiB, WS_CTXRES = 1084 * MiB, WS_HH = 1116 * MiB, WS_QKV = 1260 * MiB, WS_X1 = 1584 * MiB  , WS_END = 1728 * MiB;
constexpr size_t CTL_ZERO_BYTES = 1 * MiB;
constexpr int CW_BAR = 4096;
typedef unsigned short bf16_t;
typedef float f32x4 __attribute__((ext_vector_type(4)));
#define GAS __attribute__((address_space(1)))
typedef unsigned v4u __attribute__((ext_vector_type(4)));
#define LDS_WAIT() asm volatile("s_waitcnt lgkmcnt(0)" ::: "memory")

__device__ __forceinline__ float bf2f(bf16_t b) { return __uint_as_float(((unsigned)b) << 16); }
__device__ __forceinline__ unsigned pk2(float lo, float hi) { unsigned r; asm("v_cvt_pk_bf16_f32 %0, %1, %2" : "=v"(r) : "v"(lo), "v"(hi)); return r; }
__device__ __forceinline__ unsigned f2bf(float f) { return pk2(f, f); }

__device__ __forceinline__ float wave_sum(float v) {
#pragma unroll
    for (int o = 1; o < 64; o <<= 1) v += __shfl_xor(v, o);
    return v;
}
__device__ __forceinline__ float wave_max(float v) {
#pragma unroll
    for (int o = 1; o < 64; o <<= 1) v = fmaxf(v, __shfl_xor(v, o));
    return v;
}
__device__ __forceinline__ float silu_f(float v) { return v / (1.f + expf(-v)); }
__device__ __forceinline__ float sigmoid_f(float v) { return 1.f / (1.f + expf(-v)); }
__device__ __forceinline__ float silu_fast(float v) { return v * __builtin_amdgcn_rcpf(1.f + __builtin_amdgcn_exp2f(-1.4426950408889634f * v)); }
__device__ __forceinline__ float silu_e2(float v) { return v / (1.f + __builtin_amdgcn_exp2f(-1.4426950408889634f * v)); }
#define XB_TMO      128
#define XB_XCNT(j)  (256  + 64 * (j))
#define XB_XSUB(j)  (1280 + 64 * (j))
#define XB_XGEN(j)  (2304 + 64 * (j))
#define XB_TOP      3328
#define XB_TOPGEN   3392
#define XCD_BAR_WORDS 3456
#define XB_SPIN_CAP (1u << 18)
#define LAS __attribute__((address_space(3)))

__device__ __forceinline__ unsigned xb_ld(unsigned* p)              { return __hip_atomic_load(p, __ATOMIC_RELAXED, __HIP_MEMORY_SCOPE_AGENT); }
__device__ __forceinline__ unsigned xb_add(unsigned* p, unsigned v) { return __hip_atomic_fetch_add(p, v, __ATOMIC_RELAXED, __HIP_MEMORY_SCOPE_AGENT); }
__device__ __forceinline__ unsigned xb_xcc_id() { return (unsigned)__builtin_amdgcn_s_getreg((3 << 11) | 20) & 0xFu; }
#define XB_SPIN(cond, bar) do { unsigned _sp = 0; while (cond) { __builtin_amdgcn_s_sleep(1); \
    if ((++_sp & 255u) == 0u) { if (xb_ld(&(bar)[XB_TMO])) break; if (_sp > XB_SPIN_CAP) { atomicAdd(&(bar)[XB_TMO], 1u); break; } } } } while (0)

struct XcdBarrier {
    unsigned* bar; unsigned x;
    volatile LAS unsigned* st;
};

__device__ __forceinline__ XcdBarrier xcd_barrier_post(unsigned* bar, volatile LAS unsigned* st) {
    XcdBarrier b; b.bar = bar; b.x = xb_xcc_id(); b.st = st;
    if (threadIdx.x == 0) (void)xb_add(&bar[XB_XCNT(b.x)], 1u);
    return b;
}
__device__ __forceinline__ void xcd_barrier_complete(unsigned* bar, unsigned x, unsigned& nloc, unsigned& nx) {
    const unsigned G = gridDim.x * gridDim.y * gridDim.z;
    unsigned sum, cnt, mine, sp = 0u;
    for (;;) {
        sum = 0u; cnt = 0u; mine = 0u;
#pragma unroll
        for (unsigned j = 0; j < 16; ++j) { const unsigned c = xb_ld(&bar[XB_XCNT(j)]); sum += c; cnt += (c > 0u) ? 1u : 0u; mine = (j == x) ? c : mine; }
        if (sum == G) break;
        __builtin_amdgcn_s_sleep(1);
        if ((++sp & 255u) == 0u) { if (xb_ld(&bar[XB_TMO])) break; if (sp > XB_SPIN_CAP) { atomicAdd(&bar[XB_TMO], 1u); break; } }
    }
    nloc = mine > 0u ? mine : 1u; nx = cnt > 0u ? cnt : 1u;
}

__device__ __forceinline__ void xcd_barrier(const XcdBarrier& b) {
    asm volatile("s_waitcnt vmcnt(0)" ::: "memory");
    __syncthreads();
    if (threadIdx.x == 0) {
        unsigned* bar = b.bar;
        __builtin_amdgcn_s_waitcnt(0);
        unsigned nloc = b.st[0], nx = b.st[1];
        if (nloc == 0u) { xcd_barrier_complete(bar, b.x, nloc, nx); b.st[0] = nloc; b.st[1] = nx; }
        const unsigned old = xb_add(&bar[XB_XSUB(b.x)], 1u);
        const unsigned gen = old / nloc;
        if (old + 1u == (gen + 1u) * nloc) {
            __builtin_amdgcn_fence(__ATOMIC_RELEASE, "agent");
            asm volatile("s_waitcnt vmcnt(0)" ::: "memory");
            const unsigned og = xb_add(&bar[XB_TOP], 1u);
            const unsigned tg = og / nx;
            if (og + 1u == (tg + 1u) * nx) xb_add(&bar[XB_TOPGEN], 1u);
            else XB_SPIN(xb_ld(&bar[XB_TOPGEN]) == tg, bar);
            __builtin_amdgcn_fence(__ATOMIC_ACQUIRE, "agent");
            xb_add(&bar[XB_XGEN(b.x)], 1u);
            asm volatile("s_waitcnt vmcnt(0)" ::: "memory");
        } else {
            XB_SPIN(xb_ld(&bar[XB_XGEN(b.x)]) == gen, bar);
            __builtin_amdgcn_fence(__ATOMIC_ACQUIRE, "agent");
            asm volatile("s_waitcnt vmcnt(0)" ::: "memory");
        }
    }
    __syncthreads();
}
#define LAS __attribute__((address_space(3)))
constexpr int RING_BYTES = 131072, MISC_OFF = 143360, LDS_BYTES = 147456;

__device__ __forceinline__ void p0_transpose_item(const float* W, int K, int N, bf16_t* WT, int row_off, LAS float* scr, int item, int lane) {
    const int nblk = N / 32, kb = item / nblk, nb = item % nblk, k0 = 64 * kb, n0 = 32 * nb;
    float v[32];
#pragma unroll
    for (int i = 0; i < 32; ++i) v[i] = W[(size_t)(k0 + 2 * i + (lane >> 5)) * N + n0 + (lane & 31)];
#pragma unroll
    for (int i = 0; i < 32; ++i) scr[(2 * i + (lane >> 5)) * 33 + (lane & 31)] = v[i];
    LDS_WAIT(); asm volatile("" ::: "memory");
    const int c = lane & 7;
#pragma unroll
    for (int j = 0; j < 4; ++j) { const int n = (lane >> 3) + 8 * j; const LAS float* s = scr + (8 * c) * 33 + n;
        v4u o; o.x = pk2(s[0 * 33], s[1 * 33]); o.y = pk2(s[2 * 33], s[3 * 33]); o.z = pk2(s[4 * 33], s[5 * 33]); o.w = pk2(s[6 * 33], s[7 * 33]);
        *(GAS v4u*)(WT + (size_t)(row_off + n0 + n) * K + k0 + 8 * c) = o; }
    LDS_WAIT(); asm volatile("" ::: "memory");
}
constexpr int TR_IL = (DM / 64) * (INW / 32) + (DM / 64) * (DM / 32);
__device__ __forceinline__ void ph_transpose(const float* w_in, const float* w_out, bf16_t* WinT, bf16_t* WoutT, LAS unsigned char* lds, int wave, int lane, int lo, int hi, int gw, int NGW) {
    LAS float* scr = (LAS float*)lds + wave * 64 * 33;
    constexpr int I_IN = (DM / 64) * (INW / 32), I_OUT = (DM / 64) * (DM / 32), I_L = I_IN + I_OUT;
    for (int it = lo + gw; it < hi; it += NGW) {
        const int l = it / I_L, r = it % I_L;
        if (r < I_IN) p0_transpose_item(w_in + (size_t)l * DM * INW, DM, INW, WinT + (size_t)l * INW * DM, 0, scr, r, lane);
        else p0_transpose_item(w_out + (size_t)l * DM * DM, DM, DM, WoutT + (size_t)l * DM * DM, 0, scr, r - I_IN, lane);
    }
}
__device__ __forceinline__ void ph_small(const float* lambda_qk, float* rope, float* lam, int tid) {
    for (int i = tid; i < 1024; i += 512) { const int pos = i >> 4, f = i & 15; const float fr = exp2f(-(float)f * (13.287712379549449f / 16.f)), ang = (float)pos * fr; float sn, cs; sincosf(ang, &sn, &cs); rope[2 * i] = cs; rope[2 * i + 1] = sn; }
    if (tid < 2) { const float* lq = lambda_qk + tid * 256; float s01 = 0.f, s23 = 0.f; for (int d = 0; d < 64; ++d) { s01 += lq[d] * lq[64 + d]; s23 += lq[128 + d] * lq[192 + d]; }
        const float lam_init = 0.8f - 0.6f * expf(-0.3f * (float)tid); lam[tid] = expf(s01) - expf(s23) + lam_init; lam[2 + tid] = 1.f - lam_init; }
}
__device__ __forceinline__ void ph_mod(const float* c, const float* c_ctx, const float* ada_w, const float* ada_b, float* mod, LAS unsigned char* lds, int tid, int bid, int G) {
    LAS float* sl = (LAS float*)lds; LAS float* red = (LAS float*)(lds + 9 * 1024 * 4);
    const int kg = tid >> 5, cj = tid & 31;
    for (int item = bid; item < 2 * 128; item += G) {
        const int l = item / 128, j0 = (item % 128) * 96;
        float acc[3][9];
#pragma unroll
        for (int cc = 0; cc < 3; ++cc)
#pragma unroll
            for (int r = 0; r < 9; ++r) acc[cc][r] = 0.f;
        const float* W = ada_w + (size_t)l * DM * 12288 + j0 + cj;
        for (int ch = 0; ch < 4; ++ch) {
            __syncthreads();
            for (int idx = tid; idx < 9 * 1024; idx += 512) { const int r = idx >> 10, kk = idx & 1023; const float v = (r < 8) ? c[r * DM + ch * 1024 + kk] : c_ctx[ch * 1024 + kk]; sl[idx] = silu_f(v); }
            __syncthreads();
#pragma unroll 1
            for (int i0 = 0; i0 < 64; i0 += 8) { float w[3][8]; const int kb = kg * 64 + i0;
#pragma unroll
                for (int u = 0; u < 8; ++u)
#pragma unroll
                    for (int cc = 0; cc < 3; ++cc) w[cc][u] = W[(size_t)(ch * 1024 + kb + u) * 12288 + 32 * cc];
#pragma unroll
                for (int r = 0; r < 9; ++r)
#pragma unroll
                    for (int q = 0; q < 2; ++q) { const f32x4 s4 = *(const LAS f32x4*)(sl + r * 1024 + kb + 4 * q);
#pragma unroll
                        for (int cc = 0; cc < 3; ++cc) acc[cc][r] += (s4.x * w[cc][4 * q] + s4.y * w[cc][4 * q + 1]) + (s4.z * w[cc][4 * q + 2] + s4.w * w[cc][4 * q + 3]); } }
        }
#pragma unroll
        for (int cc = 0; cc < 3; ++cc)
#pragma unroll
            for (int r = 0; r < 9; ++r) red[(kg * 27 + cc * 9 + r) * 32 + cj] = acc[cc][r];
        __syncthreads();
        for (int o = tid; o < 27 * 32; o += 512) { const int c9 = o >> 5, c2 = o & 31, cc = c9 / 9, r = c9 % 9; float s = ada_b[l * 12288 + j0 + 32 * cc + c2];
            for (int g = 0; g < 16; ++g) s += red[(g * 27 + c9) * 32 + c2];
            mod[(size_t)(l * 9 + r) * 12288 + j0 + 32 * cc + c2] = s; }
    }
    __syncthreads();
}
template <bool BF> __device__ __forceinline__ void ph_norm(const void* xlat, const float* xctx, const float* norm_w, const float* mod, bf16_t* HX, int wave, int lane, int bid, int G) {
    const int gw = bid * 8 + wave, NGW = G * 8;
    for (int row = gw; row < NROW; row += NGW) {
        const bool isctx = row >= NLAT; const int r = isctx ? 8 : (row >> 11);
        f32x4 v[16]; float s = 0.f;
        if constexpr (BF) { const unsigned long long* xr = (const unsigned long long*)((const bf16_t*)xlat + (size_t)row * DM) + lane;
#pragma unroll
            for (int j = 0; j < 16; ++j) { const unsigned long long q = xr[64 * j]; const unsigned lo = (unsigned)q, hi = (unsigned)(q >> 32);
                v[j] = (f32x4){__uint_as_float(lo << 16), __uint_as_float(lo & 0xffff0000u), __uint_as_float(hi << 16), __uint_as_float(hi & 0xffff0000u)}; }
        } else { const f32x4* xr = (const f32x4*)(isctx ? xctx + (size_t)(row - NLAT) * DM : (const float*)xlat + (size_t)row * DM) + lane;
#pragma unroll
            for (int j = 0; j < 16; ++j) v[j] = xr[64 * j]; }
#pragma unroll
        for (int j = 0; j < 16; ++j) s += (v[j].x * v[j].x + v[j].y * v[j].y) + (v[j].z * v[j].z + v[j].w * v[j].w);
        const float rstd = 1.f / sqrtf(wave_sum(s) * (1.f / DM) + 1e-6f);
        const f32x4* nw = (const f32x4*)norm_w + lane; const f32x4* sh = (const f32x4*)(mod + (size_t)r * 12288) + lane; const f32x4* sc = (const f32x4*)(mod + (size_t)r * 12288 + 4096) + lane;
        unsigned long long* o8 = (unsigned long long*)(HX + (size_t)row * DM) + lane;
#pragma unroll
        for (int j = 0; j < 16; ++j) { const f32x4 w = nw[64 * j], a = sc[64 * j], b = sh[64 * j]; const f32x4 y = v[j] * rstd * w; const f32x4 o = y * (a + 1.f) + b;
            o8[64 * j] = (unsigned long long)pk2(o.x, o.y) | ((unsigned long long)pk2(o.z, o.w) << 32); }
    }
}
namespace att {
using bf16x8 = __attribute__((ext_vector_type(8))) short;
using s16x4  = __attribute__((ext_vector_type(4))) short;
using f32x16 = __attribute__((ext_vector_type(16))) float;
using u32x4  = __attribute__((ext_vector_type(4))) unsigned;
constexpr int SHM_V = 16384, SHM_K = 16384, OFF_K = 2 * SHM_V, OFF_BIAS = OFF_K + 2 * SHM_K, ATT_LDS = OFF_BIAS + 2048;
#define KSWZ(row, colB) ((row) * 256 + ((colB) ^ (((row) & 7) << 4)))
#define SBAR() __builtin_amdgcn_sched_barrier(0)
__device__ __forceinline__ int crow(int r, int hi) { return (r & 3) + 8 * (r >> 2) + 4 * hi; }
__device__ __forceinline__ unsigned cvtpk(float lo, float hi) { unsigned r; asm("v_cvt_pk_bf16_f32 %0, %1, %2" : "=v"(r) : "v"(lo), "v"(hi)); return r; }
__device__ __forceinline__ int v_st(int k, int c) { const int kk = (k & ~0xC) | ((k & 4) << 1) | ((k & 8) >> 1); return ((kk >> 3) * 4 + (c >> 5)) * 512 + ((kk & 7) * 32 + (c & 31)) * 2; }
__device__ __forceinline__ int v_rd_base(int lane) { return ((lane & 3) << 3) | (((lane >> 2) & 3) << 6) | (((lane >> 4) & 1) << 5) | (((lane >> 5) & 1) << 8); }
constexpr int v_rd_off(int d0, int ks, int half) { return d0 * 512 + ks * 4096 + half * 2048; }
template <int OFF> __device__ __forceinline__ s16x4 tr_read(int vb) { return __builtin_amdgcn_ds_read_tr16_b64_v4i16((LAS s16x4*)(unsigned)(vb + OFF)); }
template <int D0> __device__ __forceinline__ void pv_one(f32x16& od, int vb, bf16x8 pa0, bf16x8 pa1, bf16x8 pa2, bf16x8 pa3) {
  s16x4 l0 = tr_read<v_rd_off(D0, 0, 0)>(vb), h0 = tr_read<v_rd_off(D0, 0, 1)>(vb), l1 = tr_read<v_rd_off(D0, 1, 0)>(vb), h1 = tr_read<v_rd_off(D0, 1, 1)>(vb);
  s16x4 l2 = tr_read<v_rd_off(D0, 2, 0)>(vb), h2 = tr_read<v_rd_off(D0, 2, 1)>(vb), l3 = tr_read<v_rd_off(D0, 3, 0)>(vb), h3 = tr_read<v_rd_off(D0, 3, 1)>(vb);
#define PK(L, H) (bf16x8){L[0], L[1], L[2], L[3], H[0], H[1], H[2], H[3]}
  od = __builtin_amdgcn_mfma_f32_32x32x16_bf16(pa0, PK(l0, h0), od, 0, 0, 0);
  od = __builtin_amdgcn_mfma_f32_32x32x16_bf16(pa1, PK(l1, h1), od, 0, 0, 0);
  od = __builtin_amdgcn_mfma_f32_32x32x16_bf16(pa2, PK(l2, h2), od, 0, 0, 0);
  od = __builtin_amdgcn_mfma_f32_32x32x16_bf16(pa3, PK(l3, h3), od, 0, 0, 0);
#undef PK
}
__device__ __forceinline__ void pv_d0(f32x16* o, int vb, bf16x8 pa0, bf16x8 pa1, bf16x8 pa2, bf16x8 pa3) {
  pv_one<0>(o[0], vb, pa0, pa1, pa2, pa3); pv_one<1>(o[1], vb, pa0, pa1, pa2, pa3); pv_one<2>(o[2], vb, pa0, pa1, pa2, pa3); pv_one<3>(o[3], vb, pa0, pa1, pa2, pa3);
}
#define PK4(P, BASE, OUT) do { unsigned a0 = cvtpk(P[BASE + 0], P[BASE + 1]), a1 = cvtpk(P[BASE + 2], P[BASE + 3]);   \
    unsigned b0 = cvtpk(P[BASE + 4], P[BASE + 5]), b1 = cvtpk(P[BASE + 6], P[BASE + 7]);                              \
    auto r0 = __builtin_amdgcn_permlane32_swap(a0, b0, false, false); auto r1 = __builtin_amdgcn_permlane32_swap(a1, b1, false, false); \
    u32x4 w = {r0[0], r1[0], r0[1], r1[1]}; OUT = *reinterpret_cast<bf16x8*>(&w); } while (0)
template <int D_LO, int D_HI> __device__ __forceinline__ void qkt(f32x16& x0, f32x16& x1, const LAS unsigned char* Ks, const bf16x8* qr, int r32, int hi) {
  x0 = f32x16{}; x1 = f32x16{};
#pragma unroll
  for (int d0 = D_LO; d0 < D_HI; ++d0) { const int cb = (d0 * 16 + hi * 8) * 2;
    const bf16x8 b0 = *reinterpret_cast<const LAS bf16x8*>(Ks + KSWZ(r32, cb));
    const bf16x8 b1 = *reinterpret_cast<const LAS bf16x8*>(Ks + KSWZ(32 + r32, cb));
    x0 = __builtin_amdgcn_mfma_f32_32x32x16_bf16(b0, qr[d0], x0, 0, 0, 0);
    x1 = __builtin_amdgcn_mfma_f32_32x32x16_bf16(b1, qr[d0], x1, 0, 0, 0); }
}
struct UnitDesc {
  int qrow0;
  int krow_ctx;
  int krow_lat;
  int lt0, nlt;
  int tq, tk, tv;
  int cg, co;
  int na;
};
constexpr float LOG2E = 1.4426950408889634f;
template <bool DIFF>
__device__ __forceinline__ void attn_unit(const bf16_t* __restrict__ P, const bf16_t* __restrict__ QKV, bf16_t* __restrict__ MG, LAS unsigned char* lds, int tid, const UnitDesc u,
                                          float lam, float oml, const float* __restrict__ subln_w, const float* __restrict__ rpb_h) {
  asm volatile("" : "+v"(tid));
  const int wid = __builtin_amdgcn_readfirstlane(tid >> 6), lane = tid & 63, r32 = lane & 31, hi = lane >> 5;
  LAS unsigned char* V_lds = lds; LAS unsigned char* K_lds = lds + OFF_K; LAS float* bias_l = (LAS float*)(lds + OFF_BIAS);
  constexpr float CS = (DIFF ? 0.125f : 0.08838834764831845f) * LOG2E;
  bf16x8 qr[8];
  { const bf16_t* Qw = QKV + ((size_t)u.tq * NROW + u.qrow0 + wid * 32 + r32) * 128 + hi * 8;
#pragma unroll
    for (int d0 = 0; d0 < 8; ++d0) qr[d0] = *reinterpret_cast<const bf16x8*>(Qw + d0 * 16); }
  const int grow = ((u.qrow0 & 2047) >> 6) + (wid >> 1), cqx = 32 * (wid & 1) + r32;
  const int r0 = min(max(grow - 4, 0), 24), c0 = min(max(cqx - 8, 0), 48);
  if (!DIFF && u.na) { __syncthreads(); if (tid < 465) bias_l[tid] = rpb_h[tid] * LOG2E; }
  const int sr = tid >> 4, sc = (tid & 15) * 8, vst0 = v_st(sr, sc), vst1 = v_st(32 + sr, sc), kst0 = KSWZ(sr, sc * 2), kst1 = KSWZ(32 + sr, sc * 2);
  const int vb0 = (int)(uintptr_t)V_lds + v_rd_base(lane);
  const int NT = 4 + u.nlt;
  bf16x8 ks0, ks1, vs0, vs1;
#define TROW(j) ((j) < 4 ? u.krow_ctx + 64 * (j) : u.krow_lat + 64 * (u.lt0 + (j) - 4))
#define KLOAD(j) do { const bf16_t* kp_ = QKV + ((size_t)u.tk * NROW + TROW(j) + sr) * 128 + sc; ks0 = *reinterpret_cast<const bf16x8*>(kp_); ks1 = *reinterpret_cast<const bf16x8*>(kp_ + 32 * 128); } while (0)
#define VLOAD(j) do { const bf16_t* vp_ = QKV + ((size_t)u.tv * NROW + TROW(j) + sr) * 128 + sc; vs0 = *reinterpret_cast<const bf16x8*>(vp_); vs1 = *reinterpret_cast<const bf16x8*>(vp_ + 32 * 128); } while (0)
#define KWRITE(b) do { *reinterpret_cast<LAS bf16x8*>(K_lds + (b) * SHM_K + kst0) = ks0; *reinterpret_cast<LAS bf16x8*>(K_lds + (b) * SHM_K + kst1) = ks1; } while (0)
#define VWRITE(b) do { *reinterpret_cast<LAS bf16x8*>(V_lds + (b) * SHM_V + vst0) = vs0; *reinterpret_cast<LAS bf16x8*>(V_lds + (b) * SHM_V + vst1) = vs1; } while (0)
#define NA_FIX(X0, X1, j) do { if (!DIFF && u.na && (j) >= 4) { const int R_ = u.lt0 + (j) - 4; const int bb_ = (R_ - grow + 7) * 31 + 15 - cqx; \
    _Pragma("unroll") for (int r = 0; r < 16; ++r) { const int ck0_ = crow(r, hi), ck1_ = 32 + ck0_; \
      const bool v0_ = (ck0_ >= c0) && (ck0_ < c0 + 16), v1_ = (ck1_ >= c0) && (ck1_ < c0 + 16); \
      const float b0_ = bias_l[v0_ ? bb_ + ck0_ : 0], b1_ = bias_l[v1_ ? bb_ + ck1_ : 0]; \
      X0[r] = v0_ ? X0[r] * CS + b0_ : -1e30f; X1[r] = v1_ ? X1[r] * CS + b1_ : -1e30f; } } \
    else { _Pragma("unroll") for (int r = 0; r < 16; ++r) { X0[r] *= CS; X1[r] *= CS; } } } while (0)
#define PART(j) (DIFF || !u.na || (j) < 4 || ((u.lt0 + (j) - 4) >= r0 && (u.lt0 + (j) - 4) < r0 + 8))
  float m0 = -1e30f, l0 = 0.f, m1 = -1e30f, l1 = 0.f;
  __syncthreads();
  KLOAD(0); KWRITE(0);
  __syncthreads();
  for (int j = 0; j < NT; ++j) {
    const LAS unsigned char* Kb = K_lds + (j & 1) * SHM_K;
    if (j + 1 < NT) KLOAD(j + 1);
    if (PART(j)) {
      f32x16 sx0, sx1;
      if (DIFF) {
        qkt<0, 4>(sx0, sx1, Kb, qr, r32, hi);
        { float tm = -1e30f;
#pragma unroll
          for (int r = 0; r < 16; ++r) { sx0[r] *= CS; sx1[r] *= CS; tm = fmaxf(tm, fmaxf(sx0[r], sx1[r])); }
          const float mn = fmaxf(m0, tm); float s = 0.f;
#pragma unroll
          for (int r = 0; r < 16; ++r) s += __builtin_amdgcn_exp2f(sx0[r] - mn) + __builtin_amdgcn_exp2f(sx1[r] - mn);
          l0 = l0 * __builtin_amdgcn_exp2f(m0 - mn) + s; m0 = mn; }
        qkt<4, 8>(sx0, sx1, Kb, qr, r32, hi);
        { float tm = -1e30f;
#pragma unroll
          for (int r = 0; r < 16; ++r) { sx0[r] *= CS; sx1[r] *= CS; tm = fmaxf(tm, fmaxf(sx0[r], sx1[r])); }
          const float mn = fmaxf(m1, tm); float s = 0.f;
#pragma unroll
          for (int r = 0; r < 16; ++r) s += __builtin_amdgcn_exp2f(sx0[r] - mn) + __builtin_amdgcn_exp2f(sx1[r] - mn);
          l1 = l1 * __builtin_amdgcn_exp2f(m1 - mn) + s; m1 = mn; }
      } else {
        qkt<0, 8>(sx0, sx1, Kb, qr, r32, hi);
        NA_FIX(sx0, sx1, j);
        float tm = -1e30f;
#pragma unroll
        for (int r = 0; r < 16; ++r) tm = fmaxf(tm, fmaxf(sx0[r], sx1[r]));
        const float mn = fmaxf(m0, tm); float s = 0.f;
#pragma unroll
        for (int r = 0; r < 16; ++r) s += __builtin_amdgcn_exp2f(sx0[r] - mn) + __builtin_amdgcn_exp2f(sx1[r] - mn);
        l0 = l0 * __builtin_amdgcn_exp2f(m0 - mn) + s; m0 = mn;
      }
    }
    if (j + 1 < NT) KWRITE((j + 1) & 1);
    __syncthreads();
  }
  float K0, K1 = 0.f, c1 = 0.f;
  { const float mo = __shfl_xor(m0, 32), lo = __shfl_xor(l0, 32), M = fmaxf(m0, mo), L = l0 * __builtin_amdgcn_exp2f(m0 - M) + lo * __builtin_amdgcn_exp2f(mo - M); K0 = M + __builtin_amdgcn_logf(L); }
  if (DIFF) { const float mo = __shfl_xor(m1, 32), lo = __shfl_xor(l1, 32), M = fmaxf(m1, mo), L = l1 * __builtin_amdgcn_exp2f(m1 - M) + lo * __builtin_amdgcn_exp2f(mo - M); K1 = M; c1 = lam * __builtin_amdgcn_rcpf(L); }
  f32x16 o[4] = {};
  KLOAD(0); VLOAD(0); KWRITE(0); VWRITE(0);
  __syncthreads();
  for (int j = 0; j < NT; ++j) {
    const LAS unsigned char* Kb = K_lds + (j & 1) * SHM_K;
    if (j + 1 < NT) { KLOAD(j + 1); VLOAD(j + 1); }
    if (PART(j)) {
      f32x16 sx0, sx1; bf16x8 pa0, pa1, pa2, pa3;
      if (DIFF) {
        f32x16 sy0, sy1;
        qkt<0, 4>(sx0, sx1, Kb, qr, r32, hi);
        qkt<4, 8>(sy0, sy1, Kb, qr, r32, hi);
#pragma unroll
        for (int r = 0; r < 16; ++r) {
          const float e0 = __builtin_amdgcn_exp2f(sx0[r] * CS - K0), e1 = __builtin_amdgcn_exp2f(sx1[r] * CS - K0);
          const float f0 = __builtin_amdgcn_exp2f(sy0[r] * CS - K1), f1 = __builtin_amdgcn_exp2f(sy1[r] * CS - K1);
          sx0[r] = e0 - c1 * f0; sx1[r] = e1 - c1 * f1; }
      } else {
        qkt<0, 8>(sx0, sx1, Kb, qr, r32, hi);
        NA_FIX(sx0, sx1, j);
#pragma unroll
        for (int r = 0; r < 16; ++r) { sx0[r] = __builtin_amdgcn_exp2f(sx0[r] - K0); sx1[r] = __builtin_amdgcn_exp2f(sx1[r] - K0); }
      }
      PK4(sx0, 0, pa0); PK4(sx0, 8, pa1); PK4(sx1, 0, pa2); PK4(sx1, 8, pa3);
      pv_d0(o, vb0 + (j & 1) * SHM_V, pa0, pa1, pa2, pa3);
    }
    if (j + 1 < NT) { KWRITE((j + 1) & 1); VWRITE((j + 1) & 1); }
    __syncthreads();
  }
  const int orow0 = u.qrow0 + wid * 32;
  float sw[4];
#pragma unroll
  for (int d0 = 0; d0 < 4; ++d0) sw[d0] = DIFF ? subln_w[32 * d0 + r32] * oml : 1.f;
#pragma unroll
  for (int r = 0; r < 16; ++r) {
    const int row = orow0 + crow(r, hi);
    float rn = 1.f;
    if (DIFF) { float ss = (o[0][r] * o[0][r] + o[1][r] * o[1][r]) + (o[2][r] * o[2][r] + o[3][r] * o[3][r]);
      ss += __shfl_xor(ss, 1); ss += __shfl_xor(ss, 2); ss += __shfl_xor(ss, 4); ss += __shfl_xor(ss, 8); ss += __shfl_xor(ss, 16);
      rn = __builtin_amdgcn_rsqf(ss * (1.f / 128.f) + 1e-5f); }
#pragma unroll
    for (int d0 = 0; d0 < 4; ++d0) {
      const float g = bf2f(P[(size_t)row * INW + u.cg + 32 * d0 + r32]);
      MG[(size_t)row * DM + u.co + 32 * d0 + r32] = (bf16_t)f2bf(o[d0][r] * rn * sw[d0] * silu_e2(g)); }
  }
#undef TROW
#undef KLOAD
#undef VLOAD
#undef KWRITE
#undef VWRITE
#undef NA_FIX
#undef PART
}

constexpr float DIFF_THR = 8.f;
__device__ __forceinline__ void attn_unit_diff1p(const bf16_t* __restrict__ P, const bf16_t* __restrict__ QKV, bf16_t* __restrict__ MG, LAS unsigned char* lds, int tid, const UnitDesc u,
                                                 const float* __restrict__ lamp, const float* __restrict__ subln_w) {
  asm volatile("" : "+v"(tid));
  const int wid = __builtin_amdgcn_readfirstlane(tid >> 6), lane = tid & 63, r32 = lane & 31, hi = lane >> 5, sub = wid & 1, rb = wid >> 1;
  LAS unsigned char* V_lds = lds; LAS unsigned char* K_lds = lds + 2 * SHM_V;
  LAS float* sc_l = (LAS float*)(lds + 4 * SHM_V) + wid * 64;
  constexpr float CS = 0.125f * LOG2E;
  bf16x8 qr[2][4];
#pragma unroll
  for (int a_ = 0; a_ < 2; ++a_) { const bf16_t* Qw = QKV + ((size_t)u.tq * NROW + u.qrow0 + rb * 64 + a_ * 32 + r32) * 128 + sub * 64 + hi * 8;
#pragma unroll
    for (int d = 0; d < 4; ++d) qr[a_][d] = *reinterpret_cast<const bf16x8*>(Qw + d * 16); }
  const int vb0 = (int)(uintptr_t)V_lds + v_rd_base(lane);
  const int NT = 4 + u.nlt;
  unsigned gk[2], gv[2];
#pragma unroll
  for (int i = 0; i < 2; ++i) { const int q = 64 * wid + 512 * i + lane, row = q >> 4, cx_ = (q & 15) ^ (row & 7); gk[i] = (unsigned)(row * 128 + cx_ * 8) * 2u;
    const int st = q >> 5, kk = 8 * (st >> 2) + ((q & 31) >> 2), c = 32 * (st & 3) + 8 * (q & 3), k = (kk & ~0xC) | ((kk & 4) << 1) | ((kk & 8) >> 1); gv[i] = (unsigned)(k * 128 + c) * 2u; }
#define TROW(j) ((j) < 4 ? u.krow_ctx + 64 * (j) : u.krow_lat + 64 * (u.lt0 + (j) - 4))
#define KVDMA(j, b) do { const char* kb_ = (const char*)(QKV + ((size_t)u.tk * NROW + TROW(j)) * 128); const char* vb_ = (const char*)(QKV + ((size_t)u.tv * NROW + TROW(j)) * 128); _Pragma("unroll") for (int i = 0; i < 2; ++i) { \
    __builtin_amdgcn_global_load_lds((const unsigned*)(kb_ + gk[i]), (LAS unsigned*)(K_lds + (b) * SHM_K + wid * 1024 + i * 8192), 16, 0, 0); \
    __builtin_amdgcn_global_load_lds((const unsigned*)(vb_ + gv[i]), (LAS unsigned*)(V_lds + (b) * SHM_V + wid * 1024 + i * 8192), 16, 0, 0); } } while (0)
#define DMA_WAIT_BAR() do { asm volatile("s_waitcnt vmcnt(0)" ::: "memory"); __syncthreads(); } while (0)
  f32x16 o[2][4] = {};
  float mrun[2] = {-1e30f, -1e30f}, lsum[2] = {0.f, 0.f};
  __syncthreads();
  KVDMA(0, 0);
  DMA_WAIT_BAR();
  for (int j = 0; j < NT; ++j) {
    if (j + 1 < NT) KVDMA(j + 1, (j + 1) & 1);
    const LAS unsigned char* Kb = K_lds + (j & 1) * SHM_K;
    const int vb = vb0 + (j & 1) * SHM_V;
#pragma unroll
    for (int hf = 0; hf < 2; ++hf) {
      f32x16 s0 = {}, s1 = {};
#pragma unroll
      for (int d = 0; d < 4; ++d) { const bf16x8 kf = *reinterpret_cast<const LAS bf16x8*>(Kb + KSWZ(32 * hf + r32, sub * 128 + (d * 16 + hi * 8) * 2));
        s0 = __builtin_amdgcn_mfma_f32_32x32x16_bf16(kf, qr[0][d], s0, 0, 0, 0);
        s1 = __builtin_amdgcn_mfma_f32_32x32x16_bf16(kf, qr[1][d], s1, 0, 0, 0); }
      bf16x8 pl0, ph0, pl1, ph1;
#define SOFTMAX(S, A, PL, PH) do { float tm_ = S[0]; _Pragma("unroll") for (int r = 1; r < 16; ++r) tm_ = fmaxf(tm_, S[r]); tm_ *= CS; \
      { const auto sw_ = __builtin_amdgcn_permlane32_swap(__float_as_uint(tm_), __float_as_uint(tm_), false, false); tm_ = fmaxf(__uint_as_float(sw_[0]), __uint_as_float(sw_[1])); } \
      if (__builtin_expect(__any(tm_ > mrun[A] + DIFF_THR), 0)) { const float mn_ = fmaxf(mrun[A], tm_), al_ = __builtin_amdgcn_exp2f(mrun[A] - mn_); mrun[A] = mn_; lsum[A] *= al_; \
        if (hi == 0) sc_l[r32] = al_; asm volatile("s_waitcnt lgkmcnt(0)" ::: "memory"); \
        _Pragma("unroll") for (int rq = 0; rq < 4; ++rq) { _Pragma("unroll") for (int ri = 0; ri < 4; ++ri) { const float f_ = sc_l[crow(4 * rq + ri, hi)]; _Pragma("unroll") for (int d0 = 0; d0 < 4; ++d0) o[A][d0][4 * rq + ri] *= f_; } \
          asm volatile("" ::: "memory"); } } \
      { const float nm_ = -mrun[A]; float su_ = 0.f; _Pragma("unroll") for (int r = 0; r < 16; ++r) { S[r] = __builtin_amdgcn_exp2f(fmaf(S[r], CS, nm_)); su_ += S[r]; } lsum[A] += su_; } \
      PK4(S, 0, PL); PK4(S, 8, PH); } while (0)
      SOFTMAX(s0, 0, pl0, ph0);
      SOFTMAX(s1, 1, pl1, ph1);
#pragma unroll
      for (int d0 = 0; d0 < 4; ++d0) {
        const s16x4 l0 = __builtin_amdgcn_ds_read_tr16_b64_v4i16((LAS s16x4*)(unsigned)(vb + d0 * 512 + (2 * hf) * 4096)), h0 = __builtin_amdgcn_ds_read_tr16_b64_v4i16((LAS s16x4*)(unsigned)(vb + d0 * 512 + (2 * hf) * 4096 + 2048));
        const s16x4 l1 = __builtin_amdgcn_ds_read_tr16_b64_v4i16((LAS s16x4*)(unsigned)(vb + d0 * 512 + (2 * hf + 1) * 4096)), h1 = __builtin_amdgcn_ds_read_tr16_b64_v4i16((LAS s16x4*)(unsigned)(vb + d0 * 512 + (2 * hf + 1) * 4096 + 2048));
        const bf16x8 v0 = (bf16x8){l0[0], l0[1], l0[2], l0[3], h0[0], h0[1], h0[2], h0[3]}, v1 = (bf16x8){l1[0], l1[1], l1[2], l1[3], h1[0], h1[1], h1[2], h1[3]};
        o[0][d0] = __builtin_amdgcn_mfma_f32_32x32x16_bf16(pl0, v0, o[0][d0], 0, 0, 0); o[1][d0] = __builtin_amdgcn_mfma_f32_32x32x16_bf16(pl1, v0, o[1][d0], 0, 0, 0);
        o[0][d0] = __builtin_amdgcn_mfma_f32_32x32x16_bf16(ph0, v1, o[0][d0], 0, 0, 0); o[1][d0] = __builtin_amdgcn_mfma_f32_32x32x16_bf16(ph1, v1, o[1][d0], 0, 0, 0);
      }
#undef SOFTMAX
    }
    DMA_WAIT_BAR();
  }
  const float lamv = sub ? lamp[0] : 1.f;
#pragma unroll
  for (int a_ = 0; a_ < 2; ++a_) { const float lt = lsum[a_] + __shfl_xor(lsum[a_], 32), f = lamv * __builtin_amdgcn_rcpf(lt);
    if (hi == 0) sc_l[r32] = f; asm volatile("s_waitcnt lgkmcnt(0)" ::: "memory");
#pragma unroll
    for (int rq = 0; rq < 4; ++rq) {
#pragma unroll
      for (int ri = 0; ri < 4; ++ri) { const float f_ = sc_l[crow(4 * rq + ri, hi)];
#pragma unroll
        for (int d0 = 0; d0 < 4; ++d0) o[a_][d0][4 * rq + ri] *= f_; }
      asm volatile("" ::: "memory"); }
    asm volatile("s_waitcnt lgkmcnt(0)" ::: "memory"); }
  LAS float* xs = (LAS float*)lds;
  __syncthreads();
#pragma unroll
  for (int d0 = 0; d0 < 4; ++d0)
#pragma unroll
    for (int r = 0; r < 16; ++r) xs[wid * 4096 + (d0 * 16 + r) * 64 + lane] = sub ? o[0][d0][r] : o[1][d0][r];
  __syncthreads();
  f32x16 fo[4];
#pragma unroll
  for (int d0 = 0; d0 < 4; ++d0)
#pragma unroll
    for (int r = 0; r < 16; ++r) { const float pv_ = xs[(wid ^ 1) * 4096 + (d0 * 16 + r) * 64 + lane]; fo[d0][r] = sub ? (pv_ - o[1][d0][r]) : (o[0][d0][r] - pv_); }
  __syncthreads();
  int tid2 = tid; asm volatile("" : "+v"(tid2));
  const int lane2 = tid2 & 63, c32 = lane2 & 31, h2 = lane2 >> 5;
  const int orow0 = u.qrow0 + rb * 64 + sub * 32;
  float sw[4]; const float oml = lamp[2];
#pragma unroll
  for (int d0 = 0; d0 < 4; ++d0) sw[d0] = subln_w[32 * d0 + c32] * oml;
#pragma unroll
  for (int r = 0; r < 16; ++r) {
    const int row = orow0 + crow(r, h2);
    float ss = (fo[0][r] * fo[0][r] + fo[1][r] * fo[1][r]) + (fo[2][r] * fo[2][r] + fo[3][r] * fo[3][r]);
    ss += __shfl_xor(ss, 1); ss += __shfl_xor(ss, 2); ss += __shfl_xor(ss, 4); ss += __shfl_xor(ss, 8); ss += __shfl_xor(ss, 16);
    const float rn = __builtin_amdgcn_rsqf(ss * (1.f / 128.f) + 1e-5f);
#pragma unroll
    for (int d0 = 0; d0 < 4; ++d0) {
      const float g = bf2f(P[(size_t)row * INW + u.cg + 32 * d0 + c32]);
      MG[(size_t)row * DM + u.co + 32 * d0 + c32] = (bf16_t)f2bf(fo[d0][r] * rn * sw[d0] * silu_e2(g)); }
  }
#undef TROW
#undef KVDMA
#undef DMA_WAIT_BAR
}

__device__ __forceinline__ void attn_unit_na1p(const bf16_t* __restrict__ P, const bf16_t* __restrict__ QKV, bf16_t* __restrict__ MG, LAS unsigned char* lds, int tid, const UnitDesc u,
                                               const float* __restrict__ rpb_h) {
  asm volatile("" : "+v"(tid));
  const int wid = __builtin_amdgcn_readfirstlane(tid >> 6), lane = tid & 63, r32 = lane & 31, hi = lane >> 5;
  LAS unsigned char* V_lds = lds; LAS unsigned char* K_lds = lds + 2 * SHM_V; LAS float* bias_l = (LAS float*)(lds + 4 * SHM_V);
  LAS float* sc_l = (LAS float*)(lds + 4 * SHM_V + 2048) + wid * 64;
  constexpr float CS = 0.08838834764831845f * LOG2E;
  bf16x8 qr[8];
  { const bf16_t* Qw = QKV + ((size_t)u.tq * NROW + u.qrow0 + wid * 32 + r32) * 128 + hi * 8;
#pragma unroll
    for (int d0 = 0; d0 < 8; ++d0) qr[d0] = *reinterpret_cast<const bf16x8*>(Qw + d0 * 16); }
  const int grow = ((u.qrow0 & 2047) >> 6) + (wid >> 1), cqx = 32 * (wid & 1) + r32;
  const int r0 = min(max(grow - 4, 0), 24), c0 = min(max(cqx - 8, 0), 48);
  const bool na = u.na != 0;
  __syncthreads();
  if (na && tid < 465) bias_l[tid] = rpb_h[tid] * LOG2E;
  const int vb0 = (int)(uintptr_t)V_lds + v_rd_base(lane);
  const int NT = 4 + u.nlt;
  unsigned gk[2], gv[2];
#pragma unroll
  for (int i = 0; i < 2; ++i) { const int q = 64 * wid + 512 * i + lane, row = q >> 4, cx_ = (q & 15) ^ (row & 7); gk[i] = (unsigned)(row * 128 + cx_ * 8) * 2u;
    const int st = q >> 5, kk = 8 * (st >> 2) + ((q & 31) >> 2), c = 32 * (st & 3) + 8 * (q & 3), k = (kk & ~0xC) | ((kk & 4) << 1) | ((kk & 8) >> 1); gv[i] = (unsigned)(k * 128 + c) * 2u; }
#define TROW(j) ((j) < 4 ? u.krow_ctx + 64 * (j) : u.krow_lat + 64 * (u.lt0 + (j) - 4))
#define KVDMA(j, b) do { const char* kb_ = (const char*)(QKV + ((size_t)u.tk * NROW + TROW(j)) * 128); const char* vb_ = (const char*)(QKV + ((size_t)u.tv * NROW + TROW(j)) * 128); _Pragma("unroll") for (int i = 0; i < 2; ++i) { \
    __builtin_amdgcn_global_load_lds((const unsigned*)(kb_ + gk[i]), (LAS unsigned*)(K_lds + (b) * SHM_K + wid * 1024 + i * 8192), 16, 0, 0); \
    __builtin_amdgcn_global_load_lds((const unsigned*)(vb_ + gv[i]), (LAS unsigned*)(V_lds + (b) * SHM_V + wid * 1024 + i * 8192), 16, 0, 0); } } while (0)
#define DMA_WAIT_BAR() do { asm volatile("s_waitcnt vmcnt(0)" ::: "memory"); __syncthreads(); } while (0)
  f32x16 o[4] = {};
  float mrun = -1e30f, lsum = 0.f;
  KVDMA(0, 0);
  DMA_WAIT_BAR();
  for (int j = 0; j < NT; ++j) {
    if (j + 1 < NT) KVDMA(j + 1, (j + 1) & 1);
    const int R = u.lt0 + j - 4;
    if (!na || j < 4 || (R >= r0 && R < r0 + 8)) {
      const LAS unsigned char* Kb = K_lds + (j & 1) * SHM_K; const int vb = vb0 + (j & 1) * SHM_V;
      f32x16 s0 = {}, s1 = {};
#pragma unroll
      for (int d0 = 0; d0 < 8; ++d0) { const int cb = (d0 * 16 + hi * 8) * 2;
        s0 = __builtin_amdgcn_mfma_f32_32x32x16_bf16(*reinterpret_cast<const LAS bf16x8*>(Kb + KSWZ(r32, cb)), qr[d0], s0, 0, 0, 0);
        s1 = __builtin_amdgcn_mfma_f32_32x32x16_bf16(*reinterpret_cast<const LAS bf16x8*>(Kb + KSWZ(32 + r32, cb)), qr[d0], s1, 0, 0, 0); }
      if (na && j >= 4) { const int bb = (R - grow + 7) * 31 + 15 - cqx;
#pragma unroll
        for (int r = 0; r < 16; ++r) { const int ck0 = crow(r, hi), ck1 = 32 + ck0; const bool v0 = (ck0 >= c0) && (ck0 < c0 + 16), v1 = (ck1 >= c0) && (ck1 < c0 + 16);
          const float b0 = bias_l[v0 ? bb + ck0 : 0], b1 = bias_l[v1 ? bb + ck1 : 0];
          s0[r] = v0 ? fmaf(s0[r], CS, b0) : -1e30f; s1[r] = v1 ? fmaf(s1[r], CS, b1) : -1e30f; } }
      else {
#pragma unroll
        for (int r = 0; r < 16; ++r) { s0[r] *= CS; s1[r] *= CS; } }
      float tm = s0[0];
#pragma unroll
      for (int r = 1; r < 16; ++r) tm = fmaxf(tm, s0[r]);
#pragma unroll
      for (int r = 0; r < 16; ++r) tm = fmaxf(tm, s1[r]);
      { const auto sw_ = __builtin_amdgcn_permlane32_swap(__float_as_uint(tm), __float_as_uint(tm), false, false); tm = fmaxf(__uint_as_float(sw_[0]), __uint_as_float(sw_[1])); }
      if (__builtin_expect(__any(tm > mrun + DIFF_THR), 0)) { const float mn = fmaxf(mrun, tm), al = __builtin_amdgcn_exp2f(mrun - mn); mrun = mn; lsum *= al;
        if (hi == 0) sc_l[r32] = al; asm volatile("s_waitcnt lgkmcnt(0)" ::: "memory");
#pragma unroll
        for (int rq = 0; rq < 4; ++rq) {
#pragma unroll
          for (int ri = 0; ri < 4; ++ri) { const float f_ = sc_l[crow(4 * rq + ri, hi)];
#pragma unroll
            for (int d0 = 0; d0 < 4; ++d0) o[d0][4 * rq + ri] *= f_; }
          asm volatile("" ::: "memory"); } }
      { float su = 0.f;
#pragma unroll
        for (int r = 0; r < 16; ++r) { s0[r] = __builtin_amdgcn_exp2f(s0[r] - mrun); s1[r] = __builtin_amdgcn_exp2f(s1[r] - mrun); su += s0[r] + s1[r]; }
        lsum += su; }
      bf16x8 pa0, pa1, pa2, pa3;
      PK4(s0, 0, pa0); PK4(s0, 8, pa1); PK4(s1, 0, pa2); PK4(s1, 8, pa3);
      pv_d0(o, vb, pa0, pa1, pa2, pa3);
    }
    DMA_WAIT_BAR();
  }
  { const float lt = lsum + __shfl_xor(lsum, 32), f = __builtin_amdgcn_rcpf(lt);
    if (hi == 0) sc_l[r32] = f; asm volatile("s_waitcnt lgkmcnt(0)" ::: "memory");
#pragma unroll
    for (int rq = 0; rq < 4; ++rq) {
#pragma unroll
      for (int ri = 0; ri < 4; ++ri) { const float f_ = sc_l[crow(4 * rq + ri, hi)];
#pragma unroll
        for (int d0 = 0; d0 < 4; ++d0) o[d0][4 * rq + ri] *= f_; }
      asm volatile("" ::: "memory"); } }
  int tid2 = tid; asm volatile("" : "+v"(tid2));
  const int lane2 = tid2 & 63, c32 = lane2 & 31, h2 = lane2 >> 5;
  const int orow0 = u.qrow0 + wid * 32;
#pragma unroll
  for (int r = 0; r < 16; ++r) {
    const int row = orow0 + crow(r, h2);
#pragma unroll
    for (int d0 = 0; d0 < 4; ++d0) {
      const float g = bf2f(P[(size_t)row * INW + u.cg + 32 * d0 + c32]);
      MG[(size_t)row * DM + u.co + 32 * d0 + c32] = (bf16_t)f2bf(o[d0][r] * silu_e2(g)); }
  }
#undef TROW
#undef KVDMA
#undef DMA_WAIT_BAR
}
}


__device__ __forceinline__ void ph_attn(const bf16_t* P, const bf16_t* QKV, bf16_t* MG, const float* subln_w, const float* rpb_l, const float* lamp, bool with_ctx, LAS unsigned char* lds, int wave0, int bid, int G) {
#define UNIT_TID() int tid; asm volatile("v_mbcnt_lo_u32_b32 %0, -1, 0\n\tv_mbcnt_hi_u32_b32 %0, -1, %0" : "=v"(tid)); tid |= (wave0 << 6)
    const int NU = with_ctx ? 864 : 768;
    for (int u = bid; u < NU; u += G) {
        att::UnitDesc d; int h;
        if (u < 768) { const int x = u & 7, j = (u >> 3) & 31, i = u >> 8, pl = (i * 32 + j) >> 3, p = pl * 8 + x, b = p / 12, qb = j & 7; h = p % 12;     d.qrow0 = b * SEQ + qb * 256; d.krow_ctx = NLAT + b * NCTX; d.krow_lat = b * SEQ; d.nlt = 32; }
        else { const int v = u - 768, b = v / 12; h = v % 12; d.qrow0 = NLAT + b * NCTX; d.krow_ctx = NLAT + b * NCTX; d.krow_lat = b * SEQ; d.nlt = 0; }
        d.lt0 = 0; d.tq = h; d.tk = 12 + h; d.tv = 24 + h; d.cg = C_GA + h * 128; d.co = h * 128; d.na = 0;
        UNIT_TID(); att::attn_unit_diff1p(P, QKV, MG, lds, tid, d, lamp, subln_w);
    }
    for (int u = bid; u < NU; u += G) {
        att::UnitDesc d; int h;
        if (u < 768) { const int x = u & 7, j = (u >> 3) & 31, i = u >> 8, pl = (i * 32 + j) >> 3, p = pl * 8 + x, b = p / 12, g = j & 7; h = p % 12; d.qrow0 = b * SEQ + g * 256; d.krow_ctx = NLAT + b * NCTX; d.krow_lat = b * SEQ;
                       d.lt0 = (g == 0) ? 0 : (g == 7 ? 24 : 4 * g - 4); d.nlt = (g == 0 || g == 7) ? 8 : 11; d.na = 1; }
        else { const int v = u - 768, b = v / 12; h = v % 12; d.qrow0 = NLAT + b * NCTX; d.krow_ctx = NLAT + b * NCTX; d.krow_lat = b * SEQ; d.lt0 = 0; d.nlt = 0; d.na = 0; }
        d.tq = 36 + h; d.tk = 48 + h; d.tv = 60 + h; d.cg = C_GB + h * 128; d.co = 1536 + h * 128;
        UNIT_TID(); att::attn_unit_na1p(P, QKV, MG, lds, tid, d, rpb_l + h * 465);
    }
    __syncthreads();
#undef UNIT_TID
}

__device__ __forceinline__ void ph_rglru(const bf16_t* __restrict__ P, const float* __restrict__ conv_w, const float* __restrict__ conv_b, const float* __restrict__ wa, const float* __restrict__ ba,
                                         const float* __restrict__ wx, const float* __restrict__ bx, const float* __restrict__ rlam, bf16_t* __restrict__ HH, LAS unsigned char* lds, int tid, int bid, int G) {
    using att::bf16x8; using att::f32x16;
    LAS float* U32 = (LAS float*)lds;
    LAS bf16_t* Ub = (LAS bf16_t*)(lds + 32768);
    LAS bf16_t* WTa = (LAS bf16_t*)(lds + 51200);
    LAS bf16_t* WTx = (LAS bf16_t*)(lds + 60416);
    LAS float* A_l = (LAS float*)(lds + 69632);
    LAS float* XP = (LAS float*)(lds + 102400);
    LAS float* XH = XP + 512;
    LAS float* CR = XH + 512;
    const int wid = __builtin_amdgcn_readfirstlane(tid >> 6), lane = tid & 63, r32 = lane & 31, hi = lane >> 5, ch = lane, rt = wid >> 1, ct = wid & 1;
    for (int it = bid; it < 256; it += G) {
        const int d = it & 1, n = (it >> 1) & 15, b = it >> 5;
        __syncthreads();
        { const float* wa_ = wa + (size_t)((d * 16 + n) * 64) * 64; const float* wx_ = wx + (size_t)((d * 16 + n) * 64) * 64;
          for (int e = tid; e < 4096; e += 512) { const int i = e >> 6, j = e & 63; WTa[j * 72 + i] = (bf16_t)f2bf(wa_[e]); WTx[j * 72 + i] = (bf16_t)f2bf(wx_[e]); } }
        if (tid < 64) CR[tid] = 0.f;
        const int cch = n * 64 + 32 * ct + r32;
        const float nbav = -1.4426950408889634f * ba[d * 1024 + cch], nbxv = -1.4426950408889634f * bx[d * 1024 + cch], xl = -rlam[d * 1024 + cch], ey = __builtin_amdgcn_exp2f(xl * 1.4426950408889634f), spv = xl > 20.f ? xl : (ey < 0.01f ? ey * (1.f + ey * (-0.5f + ey * 0.33333334f)) : __builtin_amdgcn_logf(1.f + ey) * 0.6931471805599453f);
        const float k1 = -8.f * 1.4426950408889634f * spv;
        const float cw0 = conv_w[n * 64 + ch], cw1 = conv_w[1024 + n * 64 + ch], cw2 = conv_w[2048 + n * 64 + ch], cw3 = conv_w[3072 + n * 64 + ch], cbv = conv_b[n * 64 + ch];
        unsigned short xr[19];
#define RG_GEOM(cc_) const bool isctx = (cc_) < 2; const int nch = isctx ? 2 : 16, ci = isctx ? (cc_) : (cc_) - 2, c = d ? nch - 1 - ci : ci; \
            const int len = isctx ? NCTX : SEQ, rowbase = isctx ? NLAT + b * NCTX : b * SEQ, t0 = c * 128
#define RG_LOADX(cc_) do { RG_GEOM(cc_); const int tb = t0 + 16 * wid; _Pragma("unroll") for (int k = 0; k < 19; ++k) { const int t = tb + k - 2; \
            xr[k] = (t >= 0 && t < len) ? P[(size_t)(rowbase + t) * INW + C_XC + n * 64 + ch] : (unsigned short)0; } } while (0)
        RG_LOADX(0);
        for (int cc = 0; cc < 18; ++cc) {
            RG_GEOM(cc); (void)len;
            {
                float xv[19];
#pragma unroll
                for (int k = 0; k < 19; ++k) xv[k] = bf2f(xr[k]);
                if (cc + 1 < 18) RG_LOADX(cc + 1);
#pragma unroll
                for (int i = 0; i < 16; ++i) { const float u = cbv + cw0 * xv[i] + cw1 * xv[i + 1] + cw2 * xv[i + 2] + cw3 * xv[i + 3];
                    U32[(16 * wid + i) * 64 + ch] = u; Ub[(16 * wid + i) * 72 + ch] = (bf16_t)f2bf(u); }
            }
            __syncthreads();
            {
                f32x16 pr = {}, pi = {};
#pragma unroll
                for (int kk = 0; kk < 4; ++kk) {
                    const bf16x8 af = *reinterpret_cast<const LAS bf16x8*>(Ub + (32 * rt + r32) * 72 + kk * 16 + hi * 8);
                    const bf16x8 wf = *reinterpret_cast<const LAS bf16x8*>(WTa + (32 * ct + r32) * 72 + kk * 16 + hi * 8);
                    const bf16x8 xf = *reinterpret_cast<const LAS bf16x8*>(WTx + (32 * ct + r32) * 72 + kk * 16 + hi * 8);
                    pr = __builtin_amdgcn_mfma_f32_32x32x16_bf16(af, wf, pr, 0, 0, 0);
                    pi = __builtin_amdgcn_mfma_f32_32x32x16_bf16(af, xf, pi, 0, 0, 0); }
#pragma unroll
                for (int r = 0; r < 16; ++r) { const int idx = (32 * rt + att::crow(r, hi)) * 64 + 32 * ct + r32; const float u = U32[idx];
                    const float rg = __builtin_amdgcn_rcpf(1.f + __builtin_amdgcn_exp2f(fmaf(pr[r], -1.4426950408889634f, nbav))), ig = __builtin_amdgcn_rcpf(1.f + __builtin_amdgcn_exp2f(fmaf(pi[r], -1.4426950408889634f, nbxv)));
                    const float t = rg * k1, a = __builtin_amdgcn_exp2f(t);
                    const float x2 = t * 1.3862943611198906f;
                    const float tay = x2 * (1.f + x2 * (0.5f + x2 * (0.16666667f + x2 * (0.041666668f + x2 * 0.0083333338f))));
                    const float em1 = (x2 > -0.125f) ? tay : fmaf(a, a, -1.f);
                    A_l[idx] = a; U32[idx] = __builtin_amdgcn_sqrtf(-em1) * (ig * u); }
            }
            __syncthreads();
            {
                float av[16], bv[16]; float ap = 1.f, hl = 0.f;
#pragma unroll
                for (int s = 0; s < 16; ++s) { const int sd = 16 * wid + s, tl = d ? 127 - sd : sd; av[s] = A_l[tl * 64 + ch]; bv[s] = U32[tl * 64 + ch]; hl = av[s] * hl + bv[s]; ap *= av[s]; }
                XP[wid * 64 + ch] = ap; XH[wid * 64 + ch] = hl;
                __syncthreads();
                float h = CR[ch];
                for (int s2 = 0; s2 < wid; ++s2) h = XP[s2 * 64 + ch] * h + XH[s2 * 64 + ch];
#pragma unroll
                for (int s = 0; s < 16; ++s) { h = av[s] * h + bv[s]; const int sd = 16 * wid + s, tl = d ? 127 - sd : sd;
                    HH[((size_t)d * NROW + rowbase + t0 + tl) * 1024 + n * 64 + ch] = f2bf(h); }
                __syncthreads();
                if (wid == 7) CR[ch] = h;
            }
        }
    }
    __syncthreads();
#undef RG_GEOM
#undef RG_LOADX
}
__device__ __forceinline__ void ph_mergeC(const bf16_t* P, const bf16_t* HH, bf16_t* MG, int nrow, int tid, int bid, int G) {
    for (size_t gid = (size_t)bid * 512 + tid; gid < (size_t)nrow * 128; gid += (size_t)G * 512) {
        const int row = (int)(gid >> 7), ch = (int)(gid & 127) * 8;
        const v4u a = *(const v4u*)(HH + (size_t)row * 1024 + ch), c = *(const v4u*)(HH + ((size_t)NROW + row) * 1024 + ch);
        const v4u gq = *(const v4u*)(P + (size_t)row * INW + C_GC + ch);
#define MC_LO(x) __uint_as_float((x) << 16)
#define MC_HI(x) __uint_as_float((x) & 0xffff0000u)
        v4u o;
        o.x = pk2((MC_LO(a.x) + MC_LO(c.x)) * silu_f(MC_LO(gq.x)), (MC_HI(a.x) + MC_HI(c.x)) * silu_f(MC_HI(gq.x)));
        o.y = pk2((MC_LO(a.y) + MC_LO(c.y)) * silu_f(MC_LO(gq.y)), (MC_HI(a.y) + MC_HI(c.y)) * silu_f(MC_HI(gq.y)));
        o.z = pk2((MC_LO(a.z) + MC_LO(c.z)) * silu_f(MC_LO(gq.z)), (MC_HI(a.z) + MC_HI(c.z)) * silu_f(MC_HI(gq.z)));
        o.w = pk2((MC_LO(a.w) + MC_LO(c.w)) * silu_f(MC_LO(gq.w)), (MC_HI(a.w) + MC_HI(c.w)) * silu_f(MC_HI(gq.w)));
#undef MC_LO
#undef MC_HI
        *(v4u*)(MG + (size_t)row * DM + 3072 + ch) = o;
    }
}
__device__ __forceinline__ void ph_final(float* X, const bf16_t* X2, const float* w, int wave, int lane, int bid, int G) {
    const int gw = bid * 8 + wave, NGW = G * 8;
    for (int row = gw; row < NLAT; row += NGW) {
        f32x4* xr = (f32x4*)(X + (size_t)row * DM) + lane; const unsigned long long* x2 = (const unsigned long long*)(X2 + (size_t)row * DM) + lane; f32x4 v[16]; float s = 0.f;
#pragma unroll
        for (int j = 0; j < 16; ++j) { const unsigned long long q = x2[64 * j]; const unsigned lo = (unsigned)q, hi = (unsigned)(q >> 32);
            v[j] = (f32x4){__uint_as_float(lo << 16), __uint_as_float(lo & 0xffff0000u), __uint_as_float(hi << 16), __uint_as_float(hi & 0xffff0000u)};
            s += (v[j].x * v[j].x + v[j].y * v[j].y) + (v[j].z * v[j].z + v[j].w * v[j].w); }
        const float rstd = 1.f / sqrtf(wave_sum(s) * (1.f / DM) + 1e-6f);
#pragma unroll
        for (int j = 0; j < 16; ++j) xr[64 * j] = v[j] * rstd * ((const f32x4*)w)[lane + 64 * j];
    }
}

struct Args { const float* in[20]; float* out; unsigned char* ws; };
#define IDS() int t_; asm volatile("v_mbcnt_lo_u32_b32 %0, -1, 0\n\tv_mbcnt_hi_u32_b32 %0, -1, %0" : "=v"(t_)); t_ |= (wave0 << 6); const int ln_ = t_ & 63, wv_ = __builtin_amdgcn_readfirstlane(t_ >> 6); (void)ln_; (void)wv_; \
    int z_ = 0; asm volatile("" : "+v"(z_)); z_ = __builtin_amdgcn_readfirstlane(z_); \
    typedef __attribute__((address_space(4))) const Args CArgs; CArgs* A_ = (CArgs*)((__attribute__((address_space(4))) const char*)__builtin_amdgcn_kernarg_segment_ptr() + z_); unsigned char* ws = A_->ws; (void)ws
#define WSP(T, off) ((T*)(ws + (off)))
constexpr int TR_P0 = 7168, TR_P1 = 16384;
#define TAIL_TRANSPOSE(nunits, lo, hi) do { const int first_idle_ = (nunits) - (((nunits) - 1) / G) * G, nidle_ = G - first_idle_; \
        if (nidle_ > 0 && bid >= first_idle_) { IDS(); ph_transpose(A_->in[7], A_->in[8], WSP(bf16_t, WS_WIN), WSP(bf16_t, WS_WOUT), lds, wv_, ln_, (lo), (hi), (bid - first_idle_) * 8 + wv_, nidle_ * 8); } \
        else if (nidle_ <= 0) { IDS(); ph_transpose(A_->in[7], A_->in[8], WSP(bf16_t, WS_WIN), WSP(bf16_t, WS_WOUT), lds, wv_, ln_, (lo), (hi), bid * 8 + wv_, G * 8); } } while (0)
template <int l> __device__ __forceinline__ void layer(const XcdBarrier& bar, LAS unsigned char* lds, int wave0, int bid, int G) {

        { IDS(); ph_norm<l != 0>(l == 0 ? (const void*)A_->in[0] : (const void*)WSP(bf16_t, WS_X1), A_->in[2], A_->in[6] + l * DM, WSP(float, WS_MOD) + (size_t)l * 9 * 12288, WSP(bf16_t, WS_HX), wv_, ln_, bid, G); }
        xcd_barrier(bar);
        { IDS(); pg8::Gemm g{WSP(bf16_t, WS_HX), WSP(bf16_t, WS_WIN) + (size_t)l * INW * DM, NROW, INW, DM, 0}; pg8::EpiP E{WSP(bf16_t, WS_P), INW, 0, WSP(float, WS_ROPE), WSP(bf16_t, WS_QKV)}; pg8::PrunedOrder S; S.init(l == 0 ? NROW : NLAT, INW, G, bid, l == 0 ? 0 : NB);
          pg8::gemm_phase<pg8::EpiP, pg8::PrunedOrder, true, true>(lds, g, S, E, wave0); }
        if constexpr (l == 0) { TAIL_TRANSPOSE((NROW / 256) * (INW / 256), TR_IL + TR_P0, TR_IL + TR_P1); }
        xcd_barrier(bar);
        { IDS(); ph_rglru(WSP(bf16_t, WS_P), A_->in[12] + l * 4096, A_->in[13] + l * 1024, A_->in[14] + (size_t)l * 2 * 16 * 4096, A_->in[15] + l * 2048, A_->in[16] + (size_t)l * 2 * 16 * 4096, A_->in[17] + l * 2048, A_->in[18] + l * 2048, WSP(bf16_t, WS_HH), lds, t_, bid, G); }
        { IDS(); ph_attn(WSP(bf16_t, WS_P), WSP(bf16_t, WS_QKV), WSP(bf16_t, WS_MG), A_->in[10] + l * 128, A_->in[11] + (size_t)l * 12 * 15 * 31, WSP(float, WS_LAM) + l, l == 0, lds, wave0, bid, G); }
        xcd_barrier(bar);
        { IDS(); ph_mergeC(WSP(bf16_t, WS_P), WSP(bf16_t, WS_HH), WSP(bf16_t, WS_MG), l == 0 ? NROW : NLAT, t_, bid, G); }
        xcd_barrier(bar);
        { IDS(); const int M = l == 0 ? NROW : NLAT; pg8::Gemm g{WSP(bf16_t, WS_MG), WSP(bf16_t, WS_WOUT) + (size_t)l * DM * DM, M, DM, DM, 0};
          pg8::EpiRes2<l != 0> E{l == 0 ? (const void*)A_->in[0] : (const void*)WSP(bf16_t, WS_X1), A_->in[2], l == 0 ? WSP(bf16_t, WS_X1) : WSP(bf16_t, WS_HX), WSP(float, WS_MOD) + (size_t)l * 9 * 12288 + 8192, NLAT, 0}; pg8::StaticOrder S; S.init(M, DM, G, bid);
          pg8::gemm_phase<pg8::EpiRes2<l != 0>, pg8::StaticOrder, true, true>(lds, g, S, E, wave0); }
        if constexpr (l == 0) { TAIL_TRANSPOSE((NROW / 256) * (DM / 256), TR_IL + TR_P1, 2 * TR_IL); }
        xcd_barrier(bar);
    }
__global__ void __launch_bounds__(512, 2) fwd(Args a) {
    extern __shared__ __attribute__((aligned(16))) unsigned char lds_raw[];
    LAS unsigned char* lds = (LAS unsigned char*)lds_raw;
    const int tid = threadIdx.x, G = gridDim.x, bid = blockIdx.x, wave0 = __builtin_amdgcn_readfirstlane(tid >> 6);
    volatile LAS unsigned* MISC = (volatile LAS unsigned*)(lds + MISC_OFF);
    if (tid < 32) MISC[tid] = 0u;
    __syncthreads();
    XcdBarrier bar = xcd_barrier_post((unsigned*)(a.ws + WS_CTL) + CW_BAR, MISC + 8);
    if (bid == 0) { IDS(); ph_small(A_->in[9], WSP(float, WS_ROPE), WSP(float, WS_LAM), t_); }
    { IDS(); ph_mod(A_->in[1], A_->in[3], A_->in[4], A_->in[5], WSP(float, WS_MOD), lds, t_, bid, G); }
    { IDS(); ph_transpose(A_->in[7], A_->in[8], WSP(bf16_t, WS_WIN), WSP(bf16_t, WS_WOUT), lds, wv_, ln_, 0, TR_IL + TR_P0, bid * 8 + wv_, G * 8); }
    xcd_barrier(bar);
    layer<0>(bar, lds, wave0, bid, G);
    layer<1>(bar, lds, wave0, bid, G);
    { IDS(); ph_final(A_->out, WSP(bf16_t, WS_HX), A_->in[19], wv_, ln_, bid, G); }
}

extern "C" void kernel_launch(void* const* d_in, const int* in_sizes, int n_in, void* d_out, int out_size, void* d_ws, size_t ws_size, hipStream_t stream) {
    static int grid = 0;
    if (grid == 0) {
        if (n_in != 20 || in_sizes[0] != NLAT * DM || out_size != NLAT * DM || ws_size < WS_END) { fprintf(stderr, "kernel_launch: shape/workspace mismatch: n_in %d in0 %d out %d ws %zu (need %zu)\n", n_in, n_in > 0 ? in_sizes[0] : -1, out_size, ws_size, (size_t)WS_END); grid = -1; return; }
        int dev = 0, cus = 0, per_cu = 0;
        if (hipGetDevice(&dev) != hipSuccess || hipDeviceGetAttribute(&cus, hipDeviceAttributeMultiprocessorCount, dev) != hipSuccess) { fprintf(stderr, "kernel_launch: device query failed\n"); grid = -1; return; }
        if (hipFuncSetAttribute((const void*)fwd, hipFuncAttributeMaxDynamicSharedMemorySize, LDS_BYTES) != hipSuccess) { fprintf(stderr, "kernel_launch: hipFuncSetAttribute failed\n"); grid = -1; return; }
        if (hipOccupancyMaxActiveBlocksPerMultiprocessor(&per_cu, (const void*)fwd, 512, LDS_BYTES) != hipSuccess || per_cu < 1) { fprintf(stderr, "kernel_launch: occupancy query says %d blocks per CU; nothing launched\n", per_cu); (void)hipGetLastError(); grid = -1; return; }
        grid = cus;
    }
    if (grid < 0) return;
    if (hipMemsetAsync((char*)d_ws + WS_CTL, 0, CTL_ZERO_BYTES, stream) != hipSuccess) { fprintf(stderr, "kernel_launch: memset failed\n"); return; }
    Args a{};
    for (int i = 0; i < 20; ++i) a.in[i] = (const float*)d_in[i];
    a.out = (float*)d_out; a.ws = (unsigned char*)d_ws;
    hipLaunchKernelGGL(fwd, dim3(grid), dim3(512), LDS_BYTES, stream, a);
    const hipError_t le = hipPeekAtLastError();
    if (le != hipSuccess) fprintf(stderr, "kernel_launch: launch failed: %s\n", hipGetErrorName(le));
}
```
